# Optimizing an MI355X kernel written in HIP

```python
import math
import jax, jax.numpy as jnp
from jax import lax
import numpy as np

D_MODEL = 2048
BATCH = 2
SEQ = 4096
DEPTH = 1

N_HEADS = 16
HEAD_DIM = 128
N_KV_HEADS = 4
KV_REP = N_HEADS // N_KV_HEADS
D_ATTN = N_HEADS * HEAD_DIM
D_KV = N_KV_HEADS * HEAD_DIM
IDX_HEADS = 8
IDX_DIM = 64
TOPK_MAX = 256
Q_BLOCK = 128
SGU_CHUNK = 128
SGU_GROUPS = 16
D_SGU = D_MODEL
SGU_GROUP_DIM = D_SGU // SGU_GROUPS
D_FF = 4 * D_MODEL
REL_BUCKETS = 32
REL_MAX_DIST = 128
EPS = 1e-6
N_BRANCHES = 2
COL_SIZES = (D_ATTN, D_KV, D_KV, IDX_HEADS * IDX_DIM, IDX_DIM, IDX_HEADS,
             D_SGU, D_SGU, D_MODEL, D_MODEL)
D_IN = 2 * D_ATTN // 2 + 2 * D_KV + IDX_HEADS * IDX_DIM + IDX_DIM + IDX_HEADS + 2 * D_SGU + N_BRANCHES * D_MODEL

kernel_name = "hybrid_dsa_sgu_gated_block"


def rms_norm(x, g):
    xf = x.astype(jnp.float32)
    y = xf * lax.rsqrt(jnp.mean(xf * xf, axis=-1, keepdims=True) + EPS)
    return (y * g.astype(jnp.float32)).astype(x.dtype)


def layer_norm(x, g, b):
    xf = x.astype(jnp.float32)
    mu = jnp.mean(xf, axis=-1, keepdims=True)
    var = jnp.mean(jnp.square(xf - mu), axis=-1, keepdims=True)
    y = (xf - mu) * lax.rsqrt(var + EPS)
    return (y * g.astype(jnp.float32) + b.astype(jnp.float32)).astype(x.dtype)


def rel_bucket(dist):
    n = jnp.maximum(dist, 0)
    max_exact = REL_BUCKETS // 2
    nf = jnp.maximum(n, 1).astype(jnp.float32)
    large = max_exact + (jnp.log(nf / max_exact) / math.log(REL_MAX_DIST / max_exact)
                         * (REL_BUCKETS - max_exact)).astype(jnp.int32)
    large = jnp.minimum(large, REL_BUCKETS - 1)
    return jnp.where(n < max_exact, n, large)


def sparse_attention(q, k, v, qi, ki, wi, rel_bias):
    B, T = q.shape[0], q.shape[1]
    L = k.shape[1]
    top_k = min(TOPK_MAX, L // 4)
    nb = T // Q_BLOCK

    def to_blocks(a):
        return a.reshape((B, nb, Q_BLOCK) + a.shape[2:]).swapaxes(0, 1)

    starts = jnp.arange(nb, dtype=jnp.int32) * Q_BLOCK
    key_pos = jnp.arange(L, dtype=jnp.int32)
    ki32 = ki.astype(jnp.float32)
    idx_scale = (IDX_HEADS ** -0.5) * (IDX_DIM ** -0.5)

    def block(args):
        qb, qib, wib, start = args
        q_pos = start + jnp.arange(Q_BLOCK, dtype=jnp.int32)
        s = jnp.einsum('bqhd,bsd->bqhs', qib.astype(jnp.float32), ki32)
        score = jnp.einsum('bqh,bqhs->bqs', wib.astype(jnp.float32) * idx_scale, jax.nn.relu(s))
        causal = key_pos[None, :] <= q_pos[:, None]
        score = jnp.where(causal[None], score, -jnp.inf)
        _, idx = lax.top_k(score, top_k)
        valid = idx <= q_pos[None, :, None]
        k_sel = jax.vmap(lambda kb, ib: kb[ib])(k, idx)
        v_sel = jax.vmap(lambda vb, ib: vb[ib])(v, idx)
        qg = qb.reshape(B, Q_BLOCK, N_KV_HEADS, KV_REP, HEAD_DIM)
        logits = jnp.einsum('bqgrd,bqngd->bqgrn', qg, k_sel).astype(jnp.float32) * (HEAD_DIM ** -0.5)
        bucket = rel_bucket(q_pos[None, :, None] - idx)
        bias = rel_bias[bucket].astype(jnp.float32)
        bias = bias.reshape(B, Q_BLOCK, top_k, N_KV_HEADS, KV_REP).transpose(0, 1, 3, 4, 2)
        logits = jnp.where(valid[:, :, None, None, :], logits + bias, -1e30)
        p = jax.nn.softmax(logits, axis=-1).astype(v.dtype)
        o = jnp.einsum('bqgrn,bqngd->bqgrd', p, v_sel)
        return o.reshape(B, Q_BLOCK, D_ATTN)

    out = lax.map(block, (to_blocks(q), to_blocks(qi), to_blocks(wi), starts))
    return out.swapaxes(0, 1).reshape(B, T, D_ATTN)


def spatial_gating(u, v, ln_g, ln_b, w_s, b_s):
    B, T = v.shape[0], v.shape[1]
    nc = T // SGU_CHUNK
    vn = layer_norm(v, ln_g, ln_b)
    vc = vn.reshape(B, nc, SGU_CHUNK, SGU_GROUPS, SGU_GROUP_DIM)
    mask = jnp.tril(jnp.ones((SGU_CHUNK, SGU_CHUNK), dtype=bool))
    ws = jnp.where(mask[None], w_s, jnp.zeros_like(w_s))
    mixed = jnp.einsum('gts,bcsgd->bctgd', ws, vc) + b_s.T[None, None, :, :, None]
    return u * mixed.reshape(B, T, D_SGU)


def setup_inputs(seed: int = 0) -> dict:
    key = jax.random.key(seed)
    ks = jax.random.split(key, 16)
    f32 = jnp.float32
    d_in = sum(COL_SIZES)
    x = jax.random.normal(ks[0], (BATCH, SEQ, D_MODEL), f32)
    rel_bias = 0.5 * jax.random.normal(ks[1], (REL_BUCKETS, N_HEADS), f32)
    norm1_g = 1.0 + 0.01 * jax.random.normal(ks[2], (DEPTH, D_MODEL), f32)
    w_in = jax.random.normal(ks[3], (DEPTH, D_MODEL, d_in), f32) * D_MODEL ** -0.5
    sgu_ln_g = 1.0 + 0.01 * jax.random.normal(ks[4], (DEPTH, D_SGU), f32)
    sgu_ln_b = 0.01 * jax.random.normal(ks[5], (DEPTH, D_SGU), f32)
    sgu_w = jax.random.normal(ks[6], (DEPTH, SGU_GROUPS, SGU_CHUNK, SGU_CHUNK), f32) * SGU_CHUNK ** -0.5
    sgu_b = 1.0 + 0.01 * jax.random.normal(ks[7], (DEPTH, SGU_GROUPS, SGU_CHUNK), f32)
    w_out = jax.random.normal(ks[8], (DEPTH, D_MODEL, D_MODEL), f32) * D_MODEL ** -0.5
    norm2_g = 1.0 + 0.01 * jax.random.normal(ks[9], (DEPTH, D_MODEL), f32)
    w_ff1 = jax.random.normal(ks[10], (DEPTH, D_MODEL, D_FF), f32) * D_MODEL ** -0.5
    w_ff2 = jax.random.normal(ks[11], (DEPTH, D_FF, D_MODEL), f32) * D_FF ** -0.5
    final_g = 1.0 + 0.01 * jax.random.normal(ks[12], (D_MODEL,), f32)
    return {"x": x, "rel_bias": rel_bias, "norm1_g": norm1_g, "w_in": w_in,
            "sgu_ln_g": sgu_ln_g, "sgu_ln_b": sgu_ln_b, "sgu_w": sgu_w, "sgu_b": sgu_b,
            "w_out": w_out, "norm2_g": norm2_g, "w_ff1": w_ff1, "w_ff2": w_ff2,
            "final_g": final_g}


def reference(x, rel_bias, norm1_g, w_in, sgu_ln_g, sgu_ln_b, sgu_w, sgu_b,
              w_out, norm2_g, w_ff1, w_ff2, final_g):
    B, T, _ = x.shape
    split_pts = [int(p) for p in np.cumsum(COL_SIZES)[:-1]]
    for l in range(DEPTH):
        h = rms_norm(x, norm1_g[l])
        proj = jnp.einsum('btd,dc->btc', h, w_in[l])
        q, k, v, qi, ki, wi, u_s, v_s, ga, gb = jnp.split(proj, split_pts, axis=-1)
        q = q.reshape(B, T, N_HEADS, HEAD_DIM)
        k = k.reshape(B, T, N_KV_HEADS, HEAD_DIM)
        v = v.reshape(B, T, N_KV_HEADS, HEAD_DIM)
        qi = qi.reshape(B, T, IDX_HEADS, IDX_DIM)
        attn = sparse_attention(q, k, v, qi, ki, wi, rel_bias)
        sgu = spatial_gating(jax.nn.gelu(u_s), jax.nn.gelu(v_s),
                             sgu_ln_g[l], sgu_ln_b[l], sgu_w[l], sgu_b[l])
        merged = jax.nn.sigmoid(ga) * attn + jax.nn.sigmoid(gb) * sgu
        x = x + jnp.einsum('btc,cd->btd', merged, w_out[l])
        h2 = rms_norm(x, norm2_g[l])
        ff = jnp.square(jax.nn.relu(jnp.einsum('btd,df->btf', h2, w_ff1[l])))
        x = x + jnp.einsum('btf,fd->btd', ff, w_ff2[l])
    return rms_norm(x, final_g)
```

```cpp
#include <hip/hip_runtime.h>
#include <hip/hip_bf16.h>
#include <cstdio>
#include <cstdint>
namespace pg8 {
#define PG8_LAS __attribute__((address_space(3)))
typedef unsigned short bf16_t;
typedef short bf16x8 __attribute__((ext_vector_type(8)));
typedef float f32x4 __attribute__((ext_vector_type(4)));
typedef unsigned u32x4 __attribute__((ext_vector_type(4)));
constexpr int BM = 256, BK = 64, HALF = 128, HTB = HALF * BK * 2  , STAGE_BYTES = 8 * HTB, NXCD = 8, WGM = 8;

__host__ __device__ __forceinline__ int lds_byte(int r, int c) { const int st = (r >> 4) * 2 + (c >> 5), rr = r & 15, cc = c & 31, ob = rr * 64 + cc * 2; return st * 1024 + (ob ^ (((ob >> 9) & 1) << 5)); }
__host__ __device__ __forceinline__ void stage_rc(int b, int& R, int& C) { const int st = b / 1024, sb = b % 1024, swz = sb ^ (((sb >> 9) & 1) << 5); R = (st >> 1) * 16 + swz / 64; C = (st & 1) * 32 + (swz % 64) / 2; }
__host__ __device__ __forceinline__ int perm32(int rho) { const int n = rho >> 4, i = rho & 15; return 8 * (i >> 2) + 4 * n + (i & 3); }

struct Unit { int pm, pn; };
struct Gemm { const bf16_t* A; const bf16_t* Bt; int M, N, K; };

struct StaticOrder {
    int nM, nN, nwg, G, c;
    __host__ __device__ void init(int M, int N, int G_, int c_) { nM = M / BM; nN = N / BM; nwg = nM * nN; G = G_; c = c_; }
    __host__ __device__ bool next(int i, Unit& u) const {
        const long L = (long)i * G + c; if (L >= nwg) return false;
        int wgid = (int)L; { const int q = nwg / NXCD, r = nwg % NXCD, xcd = wgid % NXCD, off = wgid / NXCD; wgid = (xcd < r ? xcd * (q + 1) : r * (q + 1) + (xcd - r) * q) + off; }
        const int nig = WGM * nN, gid = wgid / nig, fm = gid * WGM, gsz = (nM - fm) < WGM ? (nM - fm) : WGM;
        u.pm = fm + ((wgid % nig) % gsz); u.pn = (wgid % nig) / gsz; return true;
    }
    __device__ __forceinline__ void a_ready(const Unit&) const {}
    __device__ __forceinline__ void done(const Unit&) const {}
};

__device__ __forceinline__ unsigned cvt_pk_bf16(float lo, float hi) { unsigned r; asm volatile("v_cvt_pk_bf16_f32 %0, %1, %2" : "=v"(r) : "v"(lo), "v"(hi)); return r; }
typedef float f32x2 __attribute__((ext_vector_type(2)));
constexpr float LOG2E_F = 1.4426950408889634f;
__device__ __forceinline__ float gelu_tanh(float x) {
    const float u = x * (1.0f + 0.044715f * x * x);
    const float e = __builtin_amdgcn_exp2f(u * (-2.0f * 0.7978845608028654f * LOG2E_F));
    return x * __builtin_amdgcn_rcpf(1.0f + e);
}
__device__ __forceinline__ float sigmoid_f(float x) { return __builtin_amdgcn_rcpf(1.0f + __builtin_amdgcn_exp2f(-x * LOG2E_F)); }
__device__ __forceinline__ f32x2 gelu2(f32x2 x) {
    const f32x2 t = (x * x) * 0.044715f + 1.0f, u = (x * t) * (-2.0f * 0.7978845608028654f * LOG2E_F);
    f32x2 e; e.x = __builtin_amdgcn_exp2f(u.x); e.y = __builtin_amdgcn_exp2f(u.y); e = e + 1.0f;
    f32x2 r; r.x = __builtin_amdgcn_rcpf(e.x); r.y = __builtin_amdgcn_rcpf(e.y); return x * r;
}
__device__ __forceinline__ f32x2 sigmoid2(f32x2 x) {
    const f32x2 u = x * (-LOG2E_F); f32x2 e; e.x = __builtin_amdgcn_exp2f(u.x); e.y = __builtin_amdgcn_exp2f(u.y); e = e + 1.0f;
    f32x2 r; r.x = __builtin_amdgcn_rcpf(e.x); r.y = __builtin_amdgcn_rcpf(e.y); return r;
}
__device__ __forceinline__ void gelu4(f32x4& v) { const f32x2 a = gelu2((f32x2){v[0], v[1]}), b = gelu2((f32x2){v[2], v[3]}); v = (f32x4){a.x, a.y, b.x, b.y}; }
__device__ __forceinline__ void sigmoid4(f32x4& v) { const f32x2 a = sigmoid2((f32x2){v[0], v[1]}), b = sigmoid2((f32x2){v[2], v[3]}); v = (f32x4){a.x, a.y, b.x, b.y}; }
#ifndef WT_STORES
#define WT_STORES 0
#endif
__device__ __forceinline__ void st16_out(void* p, u32x4 w) {
#if WT_STORES
    asm volatile("global_store_dwordx4 %0, %1, off sc1\n\ts_nop 1" :: "v"(p), "v"(w) : "memory");
#else
    *(u32x4*)p = w;
#endif
}
__device__ __forceinline__ void st_bf16x8(bf16_t* p, f32x4 v0, f32x4 v1) { u32x4 w; w.x = cvt_pk_bf16(v0[0], v0[1]); w.y = cvt_pk_bf16(v0[2], v0[3]); w.z = cvt_pk_bf16(v1[0], v1[1]); w.w = cvt_pk_bf16(v1[2], v1[3]); st16_out(p, w); }
__device__ __forceinline__ void st_bf16x8_nt(bf16_t* p, f32x4 v0, f32x4 v1) { u32x4 w; w.x = cvt_pk_bf16(v0[0], v0[1]); w.y = cvt_pk_bf16(v0[2], v0[3]); w.z = cvt_pk_bf16(v1[0], v1[1]); w.w = cvt_pk_bf16(v1[2], v1[3]); __builtin_nontemporal_store(w, (u32x4*)p); }
__device__ __forceinline__ float hsum8(f32x4 a, f32x4 b) { return ((a[0] + a[1]) + (a[2] + a[3])) + ((b[0] + b[1]) + (b[2] + b[3])); }
__device__ __forceinline__ float hsq8(f32x4 a, f32x4 b) { return ((a[0] * a[0] + a[1] * a[1]) + (a[2] * a[2] + a[3] * a[3])) + ((b[0] * b[0] + b[1] * b[1]) + (b[2] * b[2] + b[3] * b[3])); }

__host__ __device__ __forceinline__ int proj_logical_tile(int pn) { const int g = pn >> 2, w = pn & 3; return (g % 3 == 2) ? (g / 3) * 4 + w : 15 + (g - g / 3) * 4 + w; }
struct EpiProj {
    static constexpr bool PERM = true, AFTER_DRAIN = false;
    const float* rs1; bf16_t *Q2, *K2, *V2, *QI, *KI, *GU, *GV, *SGA, *SGB; float* WI; float* VST; float qscale, iscale;
    __device__ __forceinline__ void operator()(const f32x4 (&acc)[2][2][4][2], const Unit& u, int wr, int wc, int fr, int fq) const {
        const int pn = proj_logical_tile(u.pn), row0 = u.pm * BM + wr * 64 + fr, cl0 = wc * 32 + 8 * fq;
#pragma unroll
        for (int ai = 0; ai < 2; ++ai)
#pragma unroll
            for (int m = 0; m < 4; ++m) {
                const int r = row0 + ai * HALF + m * 16; const int b = r >> 12, t = r & 4095;
                float ssum = 0.f, ssq = 0.f;
#pragma unroll
                for (int bj = 0; bj < 2; ++bj) {
                    f32x4 v0 = acc[ai][bj][m][0], v1 = acc[ai][bj][m][1];
                    if (pn < 8) { const int head = 2 * pn + bj, g = head >> 2, h = head & 3; v0 = v0 * qscale; v1 = v1 * qscale;
                        st_bf16x8_nt(Q2 + ((((size_t)(b * 4 + g) * 4096 + t) * 4 + h) * 128 + cl0), v0, v1); }
                    else if (pn < 10) { const int g = 2 * (pn - 8) + bj; st_bf16x8_nt(K2 + (((size_t)(b * 4 + g) * 4096 + t) * 128 + cl0), v0, v1); }
                    else if (pn < 12) { const int g = 2 * (pn - 10) + bj; st_bf16x8_nt(V2 + (((size_t)(b * 4 + g) * 4096 + t) * 128 + cl0), v0, v1); }
                    else if (pn < 14) { st_bf16x8(QI + ((size_t)r * 512 + 256 * (pn - 12) + 128 * bj + cl0), v0, v1); }
                    else if (pn == 14) { const int cl = 128 * bj + cl0;
                        if (cl < 64) st_bf16x8(KI + ((size_t)r * 64 + cl), v0, v1);
                        else if (cl == 64) { *(f32x4*)(WI + (size_t)r * 8) = v0 * iscale; *(f32x4*)(WI + (size_t)r * 8 + 4) = v1 * iscale; } }
                    else if (pn < 23) { gelu4(v0); gelu4(v1);
                        st_bf16x8(GU + ((size_t)r * 2048 + 256 * (pn - 15) + 128 * bj + cl0), v0, v1); }
                    else if (pn < 31) { gelu4(v0); gelu4(v1);
                        ssum += hsum8(v0, v1); ssq += hsq8(v0, v1);
                        st_bf16x8(GV + ((size_t)r * 2048 + 256 * (pn - 23) + 128 * bj + cl0), v0, v1); }
                    else if (pn < 39) { sigmoid4(v0); sigmoid4(v1);
                        st_bf16x8_nt(SGA + ((size_t)r * 2048 + 256 * (pn - 31) + 128 * bj + cl0), v0, v1); }
                    else { sigmoid4(v0); sigmoid4(v1);
                        st_bf16x8(SGB + ((size_t)r * 2048 + 256 * (pn - 39) + 128 * bj + cl0), v0, v1); }
                }
                if (pn >= 23 && pn < 31) {
                    ssum += __shfl_xor(ssum, 16); ssum += __shfl_xor(ssum, 32); ssq += __shfl_xor(ssq, 16); ssq += __shfl_xor(ssq, 32);
                    if (fq == 0) { f32x2 o = {ssum, ssq}; *(f32x2*)(VST + ((size_t)r * 32 + (pn - 23) * 4 + wc) * 2) = o; }
                }
            }
    }
};
template <bool H2, bool F32OUT, bool RESBF = false> struct EpiRes {
    static constexpr bool PERM = true, AFTER_DRAIN = false;
    const void* res; float* out; bf16_t* h2; float* ssq;
    __device__ __forceinline__ void operator()(const f32x4 (&acc)[2][2][4][2], const Unit& u, int wr, int wc, int fr, int fq) const {
        const int row0 = u.pm * BM + wr * 64 + fr, c00 = u.pn * BM + wc * 32 + 8 * fq;
#pragma unroll
        for (int ai = 0; ai < 2; ++ai)
#pragma unroll
            for (int m = 0; m < 4; ++m) {
                const int r = row0 + ai * HALF + m * 16; float q = 0.f;
#pragma unroll
                for (int bj = 0; bj < 2; ++bj) { const size_t off = (size_t)r * 2048 + c00 + 128 * bj; f32x4 r0, r1;
                    if (RESBF) { const u32x4 rw = *(const u32x4*)((const bf16_t*)res + off);
                        r0 = (f32x4){__uint_as_float(rw.x << 16), __uint_as_float(rw.x & 0xffff0000u), __uint_as_float(rw.y << 16), __uint_as_float(rw.y & 0xffff0000u)};
                        r1 = (f32x4){__uint_as_float(rw.z << 16), __uint_as_float(rw.z & 0xffff0000u), __uint_as_float(rw.w << 16), __uint_as_float(rw.w & 0xffff0000u)}; }
                    else { r0 = __builtin_nontemporal_load((const f32x4*)((const float*)res + off)); r1 = __builtin_nontemporal_load((const f32x4*)((const float*)res + off + 4)); }
                    const f32x4 v0 = acc[ai][bj][m][0] + r0, v1 = acc[ai][bj][m][1] + r1;
                    if (F32OUT) { *(f32x4*)(out + off) = v0; *(f32x4*)(out + off + 4) = v1; } q += hsq8(v0, v1);
                    if (H2) st_bf16x8(h2 + off, v0, v1); }
                q += __shfl_xor(q, 16); q += __shfl_xor(q, 32);
                if (fq == 0) ssq[(size_t)r * 32 + u.pn * 4 + wc] = q;
            }
    }
};
struct EpiFF1 {
    static constexpr bool PERM = true, AFTER_DRAIN = false;
    const float* ssq2; bf16_t* FF; float eps;
    __device__ __forceinline__ void operator()(const f32x4 (&acc)[2][2][4][2], const Unit& u, int wr, int wc, int fr, int fq) const {
        const int row0 = u.pm * BM + wr * 64 + fr, c00 = u.pn * BM + wc * 32 + 8 * fq;
#pragma unroll
        for (int ai = 0; ai < 2; ++ai)
#pragma unroll
            for (int m = 0; m < 4; ++m) {
                const int r = row0 + ai * HALF + m * 16;
                float s = hsum8(*(const f32x4*)(ssq2 + (size_t)r * 32 + 8 * fq), *(const f32x4*)(ssq2 + (size_t)r * 32 + 8 * fq + 4));
                s += __shfl_xor(s, 16); s += __shfl_xor(s, 32);
                const float rs = __builtin_amdgcn_rsqf(s * (1.0f / 2048.0f) + eps);
#pragma unroll
                for (int bj = 0; bj < 2; ++bj) { f32x4 v0 = acc[ai][bj][m][0] * rs, v1 = acc[ai][bj][m][1] * rs;
                    for (int e = 0; e < 4; ++e) { const float a = fmaxf(v0[e], 0.f), c = fmaxf(v1[e], 0.f); v0[e] = a * a; v1[e] = c * c; }
                    st_bf16x8(FF + ((size_t)r * 8192 + c00 + 128 * bj), v0, v1); }
            }
    }
};

template <class Hook> struct EpiResNorm {
    static constexpr bool PERM = true, AFTER_DRAIN = true;
    const bf16_t* res; float* out; float* ssq; const float* gain; float eps; Hook hook;
    __device__ __forceinline__ void fused(f32x4 (&acc)[2][2][4][2], const Unit& u, int wr, int wc, int fr, int fq, PG8_LAS unsigned char* lds, int wid, int lane) const {
        const int row0 = u.pm * BM + wr * 64 + fr, c00 = u.pn * BM + wc * 32 + 8 * fq;
#pragma unroll
        for (int ai = 0; ai < 2; ++ai)
#pragma unroll
            for (int m = 0; m < 4; ++m) {
                const int r = row0 + ai * HALF + m * 16; float q = 0.f;
#pragma unroll
                for (int bj = 0; bj < 2; ++bj) { const size_t off = (size_t)r * 2048 + c00 + 128 * bj;
                    const u32x4 rw = __builtin_nontemporal_load((const u32x4*)(res + off));
                    acc[ai][bj][m][0] += (f32x4){__uint_as_float(rw.x << 16), __uint_as_float(rw.x & 0xffff0000u), __uint_as_float(rw.y << 16), __uint_as_float(rw.y & 0xffff0000u)};
                    acc[ai][bj][m][1] += (f32x4){__uint_as_float(rw.z << 16), __uint_as_float(rw.z & 0xffff0000u), __uint_as_float(rw.w << 16), __uint_as_float(rw.w & 0xffff0000u)};
                    q += hsq8(acc[ai][bj][m][0], acc[ai][bj][m][1]); }
                q += __shfl_xor(q, 16); q += __shfl_xor(q, 32);
                if (fq == 0) ssq[(size_t)r * 32 + u.pn * 4 + wc] = q;
            }
        hook();
        f32x4 g0[2], g1[2];
#pragma unroll
        for (int bj = 0; bj < 2; ++bj) { g0[bj] = *(const f32x4*)(gain + c00 + 128 * bj); g1[bj] = *(const f32x4*)(gain + c00 + 128 * bj + 4); }
#pragma unroll
        for (int ai = 0; ai < 2; ++ai)
#pragma unroll
            for (int m = 0; m < 4; ++m) {
                const int r = row0 + ai * HALF + m * 16;
                float s = hsum8(*(const f32x4*)(ssq + (size_t)r * 32 + 8 * fq), *(const f32x4*)(ssq + (size_t)r * 32 + 8 * fq + 4));
                s += __shfl_xor(s, 16); s += __shfl_xor(s, 32);
                const float rs = 1.0f / sqrtf(s * (1.0f / 2048.0f) + eps);
#pragma unroll
                for (int bj = 0; bj < 2; ++bj) { const size_t off = (size_t)r * 2048 + c00 + 128 * bj;
                    *(f32x4*)(out + off) = acc[ai][bj][m][0] * rs * g0[bj]; *(f32x4*)(out + off + 4) = acc[ai][bj][m][1] * rs * g1[bj]; }
            }
    }
};
template <class Epi, class Sched, bool ALIGN_EPI = false, bool SP2 = false>
__device__ __forceinline__ void gemm_phase(PG8_LAS unsigned char* lds, const Gemm g, const Sched& S, const Epi& E) {
    const int tid = threadIdx.x, wid = __builtin_amdgcn_readfirstlane(tid >> 6), lane = tid & 63, wr = wid >> 2, wc = wid & 3, fr = lane & 15, fq = lane >> 4;
    const int K = g.K, nt = K / BK;
    unsigned voffA[2], voffB[2];
#pragma unroll
    for (int i = 0; i < 2; ++i) { int R, C; stage_rc(tid * 16 + i * 8192, R, C); const int Rb = Epi::PERM ? ((R & ~31) + perm32(R & 31)) : R;
        voffA[i] = (unsigned)(R * K + C) * 2u; voffB[i] = (unsigned)(Rb * K + C) * 2u; }
    const size_t kstep = (size_t)(BK * 2);
    const size_t hstep = (size_t)HALF * K * 2;
    const size_t tstep = 2 * hstep;
    const unsigned ldsw = (unsigned)wid * 1024u;
    const int aoff = lds_byte(wr * 64 + fr, fq * 8), boff = lds_byte(wc * 32 + fr, fq * 8);
#define PG8_SA(b, h) (((b) * 2 + (h)) * HTB)
#define PG8_SB(b, h) ((4 + (b) * 2 + (h)) * HTB)
#define PG8_STAGE(bufoff, gbase, voff) do { _Pragma("unroll") for (int _i = 0; _i < 2; ++_i) \
        __builtin_amdgcn_global_load_lds((const unsigned*)((const char*)(gbase) + (voff)[_i]), (PG8_LAS unsigned*)(lds + (bufoff) + ldsw + _i * 8192), 16, 0, 0); } while (0)
#define PG8_LDA(dst, b, h) do { _Pragma("unroll") for (int m = 0; m < 4; ++m) _Pragma("unroll") for (int k = 0; k < 2; ++k) dst[m][k] = *(const PG8_LAS bf16x8*)(lds + PG8_SA(b, h) + aoff + m * 2048 + k * 1024); } while (0)
#define PG8_LDB(dst, b, h) do { _Pragma("unroll") for (int n = 0; n < 2; ++n) _Pragma("unroll") for (int k = 0; k < 2; ++k) dst[n][k] = *(const PG8_LAS bf16x8*)(lds + PG8_SB(b, h) + boff + n * 2048 + k * 1024); } while (0)
#define PG8_MMA(ai, bj, At, Bt) do { __builtin_amdgcn_s_setprio(1); _Pragma("unroll") for (int m = 0; m < 4; ++m) _Pragma("unroll") for (int n = 0; n < 2; ++n) _Pragma("unroll") for (int k = 0; k < 2; ++k) \
        acc[ai][bj][m][n] = __builtin_amdgcn_mfma_f32_16x16x32_bf16(Bt[n][k], At[m][k], acc[ai][bj][m][n], 0, 0, 0); __builtin_amdgcn_s_setprio(0); } while (0)
#define PG8_WAIT_V(n) asm volatile("s_waitcnt vmcnt(" #n ")" ::: "memory")
#define PG8_WAIT_L(n) asm volatile("s_waitcnt lgkmcnt(" #n ")" ::: "memory")
#define PG8_BAR __builtin_amdgcn_s_barrier()
#define PG8_SCHED __builtin_amdgcn_sched_barrier(0)
    Unit cur, nxt; int ui = 0;
    if (!S.next(0, cur)) return;
    f32x4 acc[2][2][4][2];
#pragma unroll
    for (int a = 0; a < 2; ++a)
#pragma unroll
        for (int b = 0; b < 2; ++b)
#pragma unroll
            for (int m = 0; m < 4; ++m)
#pragma unroll
                for (int n = 0; n < 2; ++n) acc[a][b][m][n] = (f32x4){0.f, 0.f, 0.f, 0.f};
    bf16x8 At[4][2], B0[2][2], B1[2][2];
    const char* cA = (const char*)g.A + (size_t)cur.pm * tstep; const char* cB = (const char*)g.Bt + (size_t)cur.pn * tstep;
    S.a_ready(cur);
    if constexpr (SP2) {
        PG8_STAGE(PG8_SB(0, 0), cB, voffB); PG8_STAGE(PG8_SB(0, 1), cB + hstep, voffB); PG8_STAGE(PG8_SA(0, 0), cA, voffA); PG8_STAGE(PG8_SA(0, 1), cA + hstep, voffA);
        if (wr == 1) PG8_BAR;
        PG8_WAIT_V(2); PG8_BAR;
        PG8_STAGE(PG8_SB(1, 0), cB + kstep, voffB); PG8_STAGE(PG8_SA(1, 0), cA + kstep, voffA); PG8_STAGE(PG8_SB(1, 1), cB + hstep + kstep, voffB);
        PG8_WAIT_V(6); PG8_BAR;
    } else {
        PG8_STAGE(PG8_SB(0, 0), cB, voffB); PG8_STAGE(PG8_SA(0, 0), cA, voffA); PG8_STAGE(PG8_SB(0, 1), cB + hstep, voffB); PG8_STAGE(PG8_SA(0, 1), cA + hstep, voffA);
        if (wr == 1) PG8_BAR;
        PG8_WAIT_V(4); PG8_BAR;
        PG8_STAGE(PG8_SB(1, 0), cB + kstep, voffB); PG8_STAGE(PG8_SA(1, 0), cA + kstep, voffA); PG8_STAGE(PG8_SB(1, 1), cB + hstep + kstep, voffB);
        PG8_WAIT_V(6); PG8_BAR;
    }
    for (;;) {
        const bool has_next = S.next(ui + 1, nxt);
        const char* nA = has_next ? (const char*)g.A + (size_t)nxt.pm * tstep : cA; const char* nB = has_next ? (const char*)g.Bt + (size_t)nxt.pn * tstep : cB;
        for (int t = 0; t < nt; t += 2) {
            const bool last = (t == nt - 2);
            const char* a1 = cA + (size_t)(t + 1) * kstep;
            const char* a2 = last ? nA : cA + (size_t)(t + 2) * kstep; const char* b2 = last ? nB : cB + (size_t)(t + 2) * kstep;
            const char* a3 = a2 + kstep; const char* b3 = b2 + kstep;
            if (last && has_next) S.a_ready(nxt);
            if constexpr (SP2) {
            PG8_LDB(B0, 0, 0); PG8_LDB(B1, 0, 1); PG8_SCHED; PG8_LDA(At, 0, 0); PG8_STAGE(PG8_SA(1, 1), a1 + hstep, voffA);
            PG8_WAIT_V(8); PG8_WAIT_L(0); PG8_BAR; PG8_MMA(0, 0, At, B0); PG8_MMA(0, 1, At, B1); PG8_BAR; PG8_SCHED;
            PG8_LDA(At, 0, 1); PG8_STAGE(PG8_SB(0, 0), b2, voffB); PG8_STAGE(PG8_SB(0, 1), b2 + hstep, voffB); PG8_STAGE(PG8_SA(0, 0), a2, voffA);
            PG8_WAIT_V(8); PG8_WAIT_L(0); PG8_BAR; PG8_MMA(1, 0, At, B0); PG8_MMA(1, 1, At, B1); PG8_BAR; PG8_SCHED;
            PG8_LDB(B0, 1, 0); PG8_LDB(B1, 1, 1); PG8_SCHED; PG8_LDA(At, 1, 0); PG8_STAGE(PG8_SA(0, 1), a2 + hstep, voffA);
            PG8_WAIT_V(8); PG8_WAIT_L(0); PG8_BAR; PG8_MMA(0, 0, At, B0); PG8_MMA(0, 1, At, B1); PG8_BAR; PG8_SCHED;
            PG8_LDA(At, 1, 1); PG8_STAGE(PG8_SB(1, 0), b3, voffB); PG8_STAGE(PG8_SB(1, 1), b3 + hstep, voffB); PG8_STAGE(PG8_SA(1, 0), a3, voffA);
            PG8_WAIT_V(8); PG8_WAIT_L(0); PG8_BAR; PG8_MMA(1, 0, At, B0); PG8_MMA(1, 1, At, B1); PG8_BAR; PG8_SCHED;
            } else {
            PG8_LDB(B0, 0, 0); PG8_SCHED; PG8_LDA(At, 0, 0); PG8_STAGE(PG8_SA(1, 1), a1 + hstep, voffA);
            PG8_WAIT_L(8); PG8_BAR; PG8_WAIT_L(0); PG8_MMA(0, 0, At, B0); PG8_BAR; PG8_SCHED;
            PG8_LDB(B1, 0, 1); PG8_STAGE(PG8_SB(0, 0), b2, voffB);
            PG8_BAR; PG8_WAIT_L(0); PG8_MMA(0, 1, At, B1); PG8_BAR;
            PG8_LDA(At, 0, 1); PG8_STAGE(PG8_SA(0, 0), a2, voffA);
            PG8_BAR; PG8_WAIT_L(0); PG8_MMA(1, 0, At, B0); PG8_BAR; PG8_SCHED;
            PG8_STAGE(PG8_SB(0, 1), b2 + hstep, voffB);
            PG8_WAIT_V(6); PG8_BAR; PG8_MMA(1, 1, At, B1); PG8_BAR;
            PG8_LDB(B0, 1, 0); PG8_SCHED; PG8_LDA(At, 1, 0); PG8_STAGE(PG8_SA(0, 1), a2 + hstep, voffA);
            PG8_WAIT_L(8); PG8_BAR; PG8_WAIT_L(0); PG8_MMA(0, 0, At, B0); PG8_BAR; PG8_SCHED;
            PG8_LDB(B1, 1, 1); PG8_STAGE(PG8_SB(1, 0), b3, voffB);
            PG8_BAR; PG8_WAIT_L(0); PG8_MMA(0, 1, At, B1); PG8_BAR;
            PG8_LDA(At, 1, 1); PG8_STAGE(PG8_SA(1, 0), a3, voffA);
            PG8_BAR; PG8_WAIT_L(0); PG8_MMA(1, 0, At, B0); PG8_BAR; PG8_SCHED;
            PG8_STAGE(PG8_SB(1, 1), b3 + hstep, voffB);
            PG8_WAIT_V(6); PG8_BAR; PG8_MMA(1, 1, At, B1); PG8_BAR;
            }
        }
        if constexpr (ALIGN_EPI) { if (wr == 0) PG8_BAR; }
        if constexpr (!Epi::AFTER_DRAIN) { E(acc, cur, wr, wc, fr, fq); S.done(cur); }
        if (!has_next) break;
#pragma unroll
        for (int a = 0; a < 2; ++a)
#pragma unroll
            for (int b = 0; b < 2; ++b)
#pragma unroll
                for (int m = 0; m < 4; ++m)
#pragma unroll
                    for (int n = 0; n < 2; ++n) acc[a][b][m][n] = (f32x4){0.f, 0.f, 0.f, 0.f};
        cur = nxt; cA = nA; cB = nB; ++ui;
        if constexpr (ALIGN_EPI) { if (wr == 1) PG8_BAR; }
    }
    PG8_WAIT_V(0);
    if constexpr (!ALIGN_EPI) { if (wr == 0) PG8_BAR; }
    PG8_BAR;
    if constexpr (Epi::AFTER_DRAIN) { E.fused(acc, cur, wr, wc, fr, fq, lds, wid, lane); S.done(cur); }
#undef PG8_SA
#undef PG8_SB
#undef PG8_STAGE
#undef PG8_LDA
#undef PG8_LDB
#undef PG8_MMA
#undef PG8_WAIT_V
#undef PG8_WAIT_L
#undef PG8_BAR
#undef PG8_SCHED
}
}
#ifndef ATTN_MFMA
#define ATTN_MFMA 1
#endif
constexpr int NWAVES = 8;
constexpr int BATCH = 2, SEQ = 4096, DM = 2048, MTOK = BATCH * SEQ;
constexpr int NH = 16, HD = 128, NKV = 4;
constexpr int IH = 8, ID = 64, TOPK = 256;
constexpr int DFF = 8192, DIN = 11848, NP = 12032;
constexpr float EPS = 1e-6f;
constexpr float QSCALE = 0.08838834764831845f * 1.4426950408889634f;
constexpr float IDX_SCALE = 0.35355339059327373f * 0.125f;

constexpr size_t MiB = 1u << 20;
constexpr size_t WS_CTL = 0, CTL_ZERO_BYTES = 64 * 1024;
constexpr size_t WS_RS1 = 1 * MiB;
constexpr size_t WS_BTAB = 1 * MiB + 64 * 1024;
constexpr size_t WS_WI = 1 * MiB + 256 * 1024;
constexpr size_t WS_WSB = 1 * MiB + 512 * 1024;
constexpr size_t WS_VST = 2 * MiB;
constexpr size_t WS_SSQ2 = 4 * MiB, WS_SSQ3 = 5 * MiB;
constexpr size_t WS_KI = 6 * MiB;
constexpr size_t WS_WIN = 8 * MiB;
constexpr size_t WS_WOUT = 56 * MiB;
constexpr size_t WS_W1 = 64 * MiB;
constexpr size_t WS_W2 = 96 * MiB;
constexpr size_t WS_XB = 128 * MiB;
constexpr size_t WS_MASK = 160 * MiB;
constexpr size_t WS_Q2 = 164 * MiB;
constexpr size_t WS_K2 = 196 * MiB, WS_V2 = 204 * MiB;
constexpr size_t WS_QI = 212 * MiB;
constexpr size_t WS_GU = 220 * MiB, WS_GV = 252 * MiB, WS_SGA = 284 * MiB, WS_SGB = 316 * MiB;
constexpr size_t WS_MERGED = WS_XB;
constexpr size_t WS_H2 = 164 * MiB;
constexpr size_t WS_FF = 196 * MiB;
constexpr size_t WS_LM = 348 * MiB;
constexpr size_t WS_END = 364 * MiB;
static_assert(WS_WIN + (size_t)NP * DM * 2 <= WS_WOUT && WS_FF + (size_t)MTOK * DFF * 2 <= WS_END, "d_ws map");
constexpr int CW_BAR = 1024;

constexpr int RING_BYTES = 147456;
constexpr int LDSCTL_OFF = RING_BYTES, MISC_OFF = LDSCTL_OFF + 320;
constexpr int LDS_BYTES = RING_BYTES + 1024;

#define GAS __attribute__((address_space(1)))
#define LAS __attribute__((address_space(3)))
typedef unsigned short bf16;
typedef unsigned v4u __attribute__((ext_vector_type(4)));
typedef float f32x4 __attribute__((ext_vector_type(4)));
typedef float f32x2 __attribute__((ext_vector_type(2)));
typedef float f32x16 __attribute__((ext_vector_type(16)));
typedef short bf16x8 __attribute__((ext_vector_type(8)));
typedef GAS unsigned gu32;
#define LDS_WAIT() asm volatile("s_waitcnt lgkmcnt(0)" ::: "memory")
#define VM_WAIT() asm volatile("s_waitcnt vmcnt(0)" ::: "memory")
__device__ __forceinline__ unsigned f2bf(float f) { unsigned u = __builtin_bit_cast(unsigned, f); return (u + 0x7fffu + ((u >> 16) & 1u)) >> 16; }
__device__ __forceinline__ unsigned pk2(float lo, float hi) { unsigned r; asm("v_cvt_pk_bf16_f32 %0, %1, %2" : "=v"(r) : "v"(lo), "v"(hi)); return r; }
__device__ __forceinline__ float bf_lo(unsigned w) { return __uint_as_float(w << 16); }
__device__ __forceinline__ float bf_hi(unsigned w) { return __uint_as_float(w & 0xffff0000u); }
#define XB_TMO      128
#define XB_XCNT(j)  (256  + 64 * (j))
#define XB_XSUB(j)  (1280 + 64 * (j))
#define XB_XGEN(j)  (2304 + 64 * (j))
#define XB_TOP      3328
#define XB_TOPGEN   3392
#define XCD_BAR_WORDS 3456
#define XB_SPIN_CAP (1u << 18)

__device__ __forceinline__ unsigned xb_ld(unsigned* p)              { return __hip_atomic_load(p, __ATOMIC_RELAXED, __HIP_MEMORY_SCOPE_AGENT); }
__device__ __forceinline__ unsigned xb_add(unsigned* p, unsigned v) { return __hip_atomic_fetch_add(p, v, __ATOMIC_RELAXED, __HIP_MEMORY_SCOPE_AGENT); }
__device__ __forceinline__ unsigned xb_xcc_id() { return (unsigned)__builtin_amdgcn_s_getreg((3 << 11) | 20) & 0xFu; }
#define XB_SPIN(cond, bar) do { unsigned _sp = 0; while (cond) { __builtin_amdgcn_s_sleep(1); \
    if ((++_sp & 255u) == 0u) { if (xb_ld(&(bar)[XB_TMO])) break; if (_sp > XB_SPIN_CAP) { atomicAdd(&(bar)[XB_TMO], 1u); break; } } } } while (0)

struct XcdBarrier {
    unsigned* bar; unsigned x;
    volatile LAS unsigned* st;
};

__device__ __forceinline__ XcdBarrier xcd_barrier_post(unsigned* bar, volatile LAS unsigned* st) {
    XcdBarrier b; b.bar = bar; b.x = xb_xcc_id(); b.st = st;
    if (threadIdx.x == 0) (void)xb_add(&bar[XB_XCNT(b.x)], 1u);
    return b;
}
__device__ __forceinline__ void xcd_barrier_complete(unsigned* bar, unsigned x, unsigned& nloc, unsigned& nx) {
    const unsigned G = gridDim.x * gridDim.y * gridDim.z;
    unsigned sum, cnt, mine, sp = 0u;
    for (;;) {
        sum = 0u; cnt = 0u; mine = 0u;
#pragma unroll
        for (unsigned j = 0; j < 16; ++j) { const unsigned c = xb_ld(&bar[XB_XCNT(j)]); sum += c; cnt += (c > 0u) ? 1u : 0u; mine = (j == x) ? c : mine; }
        if (sum == G) break;
        __builtin_amdgcn_s_sleep(1);
        if ((++sp & 255u) == 0u) { if (xb_ld(&bar[XB_TMO])) break; if (sp > XB_SPIN_CAP) { atomicAdd(&bar[XB_TMO], 1u); break; } }
    }
    nloc = mine > 0u ? mine : 1u; nx = cnt > 0u ? cnt : 1u;
}

__device__ __forceinline__ void xcd_barrier(const XcdBarrier& b) {
    asm volatile("s_waitcnt vmcnt(0)" ::: "memory");
    __syncthreads();
    if (threadIdx.x == 0) {
        unsigned* bar = b.bar;
        __builtin_amdgcn_s_waitcnt(0);
        unsigned nloc = b.st[0], nx = b.st[1];
        if (nloc == 0u) { xcd_barrier_complete(bar, b.x, nloc, nx); b.st[0] = nloc; b.st[1] = nx; }
        const unsigned old = xb_add(&bar[XB_XSUB(b.x)], 1u);
        const unsigned gen = old / nloc;
        if (old + 1u == (gen + 1u) * nloc) {
            __builtin_amdgcn_fence(__ATOMIC_RELEASE, "agent");
            asm volatile("s_waitcnt vmcnt(0)" ::: "memory");
            const unsigned og = xb_add(&bar[XB_TOP], 1u);
            const unsigned tg = og / nx;
            if (og + 1u == (tg + 1u) * nx) xb_add(&bar[XB_TOPGEN], 1u);
            else XB_SPIN(xb_ld(&bar[XB_TOPGEN]) == tg, bar);
            __builtin_amdgcn_fence(__ATOMIC_ACQUIRE, "agent");
            xb_add(&bar[XB_XGEN(b.x)], 1u);
            asm volatile("s_waitcnt vmcnt(0)" ::: "memory");
        } else {
            XB_SPIN(xb_ld(&bar[XB_XGEN(b.x)]) == gen, bar);
            __builtin_amdgcn_fence(__ATOMIC_ACQUIRE, "agent");
            asm volatile("s_waitcnt vmcnt(0)" ::: "memory");
        }
    }
    __syncthreads();
}
struct Args { const float* in[13]; float* out; unsigned char* ws; int ph_lo, ph_hi; };
struct Frame {
    LAS unsigned char* lds; volatile LAS unsigned* MISC; gu32* ctl;
    int tid, lane, wave, vcu, G;
};
#define IN_X(A) ((A).in[0])
#define IN_RELB(A) ((A).in[1])
#define IN_N1G(A) ((A).in[2])
#define IN_WIN(A) ((A).in[3])
#define IN_LNG(A) ((A).in[4])
#define IN_LNB(A) ((A).in[5])
#define IN_SGUW(A) ((A).in[6])
#define IN_SGUB(A) ((A).in[7])
#define IN_WOUT(A) ((A).in[8])
#define IN_N2G(A) ((A).in[9])
#define IN_W1(A) ((A).in[10])
#define IN_W2(A) ((A).in[11])
#define IN_FING(A) ((A).in[12])
#define WSP(A, T, off) ((T*)((A).ws + (off)))
__device__ __forceinline__ float wave_sum(float v) {
#pragma unroll
    for (int o = 1; o < 64; o <<= 1) v += __shfl_xor(v, o);
    return v;
}
__device__ __forceinline__ float wave_max(float v) {
#pragma unroll
    for (int o = 1; o < 64; o <<= 1) v = fmaxf(v, __shfl_xor(v, o));
    return v;
}
struct CvItem { const float* W; const float* gk; bf16* WT; int K, N, nrow0, src0, nvalid, k0; };
__device__ __forceinline__ void cv_issue(float (&v)[32], const CvItem& it, int lane) {
    const bool ok = (lane & 31) < it.nvalid; const float* wp = it.W + (size_t)(it.k0 + (lane >> 5)) * it.N + it.src0 + (lane & 31);
#pragma unroll
    for (int i = 0; i < 32; ++i) v[i] = ok ? __builtin_nontemporal_load(wp + (size_t)(2 * i) * it.N) : 0.f;
}
__device__ __forceinline__ void cv_finish(float (&v)[32], const CvItem& it, LAS float* scr, int lane) {
    if (it.gk) { const float* gp = it.gk + it.k0 + (lane >> 5);
#pragma unroll
        for (int i = 0; i < 32; ++i) v[i] *= gp[2 * i]; }
#pragma unroll
    for (int i = 0; i < 32; ++i) scr[(2 * i + (lane >> 5)) * 33 + (lane & 31)] = v[i];
    LDS_WAIT(); asm volatile("" ::: "memory");
    const int c = lane & 7;
#pragma unroll
    for (int j = 0; j < 4; ++j) { const int n = (lane >> 3) + 8 * j; const LAS float* s = scr + (8 * c) * 33 + n;
        v4u o; o.x = pk2(s[0 * 33], s[1 * 33]); o.y = pk2(s[2 * 33], s[3 * 33]); o.z = pk2(s[4 * 33], s[5 * 33]); o.w = pk2(s[6 * 33], s[7 * 33]);
        *(GAS v4u*)(it.WT + (size_t)(it.nrow0 + n) * it.K + it.k0 + 8 * c) = o; }
    LDS_WAIT(); asm volatile("" ::: "memory");
}
constexpr int CV_KB2 = DM / 64, CV_KB8 = DFF / 64;
constexpr int CV_I_IN = CV_KB2 * (NP / 32), CV_I_OUT = CV_KB2 * (DM / 32), CV_I_1 = CV_KB2 * (DFF / 32), CV_I_2 = CV_KB8 * (DM / 32), CV_I_LATE = CV_I_OUT + CV_I_1 + CV_I_2;
__device__ __forceinline__ CvItem cv_item_in(const Args& A, int r) {
    const int nb = r / CV_KB2, kb = r % CV_KB2, nphys = nb * 32, n0 = pg8::proj_logical_tile(nphys >> 8) * 256 + (nphys & 255); int src0, nvalid;
    if (n0 < 3584) { src0 = n0; nvalid = 32; }
    else if (n0 < 3840) { const int j0 = n0 - 3584; src0 = 3584 + j0; nvalid = 72 - j0; nvalid = nvalid < 0 ? 0 : (nvalid > 32 ? 32 : nvalid); }
    else { src0 = n0 - 3840 + 3656; nvalid = 32; }
    return CvItem{IN_WIN(A), IN_N1G(A), WSP(A, bf16, WS_WIN), DM, DIN, nphys, src0, nvalid, kb * 64};
}
__device__ __forceinline__ CvItem cv_item_late(const Args& A, int r) {
    if (r < CV_I_OUT) { const int nb = r / CV_KB2, kb = r % CV_KB2; return CvItem{IN_WOUT(A), nullptr, WSP(A, bf16, WS_WOUT), DM, DM, nb * 32, nb * 32, 32, kb * 64}; }
    r -= CV_I_OUT;
    if (r < CV_I_1) { const int nb = r / CV_KB2, kb = r % CV_KB2; return CvItem{IN_W1(A), IN_N2G(A), WSP(A, bf16, WS_W1), DM, DFF, nb * 32, nb * 32, 32, kb * 64}; }
    r -= CV_I_1;
    { const int nb = r / CV_KB8, kb = r % CV_KB8; return CvItem{IN_W2(A), nullptr, WSP(A, bf16, WS_W2), DFF, DM, nb * 32, nb * 32, 32, kb * 64}; }
}
__device__ __forceinline__ void p0_prologue(Frame& F, const Args& A, bool late_in_prologue) {
    LAS float* scr = (LAS float*)(F.lds + F.wave * 18432);
    const int gw = F.vcu * NWAVES + F.wave, NGW = F.G * NWAVES, lane = F.lane;
    const int nitems = late_in_prologue ? CV_I_IN + CV_I_LATE : CV_I_IN;
    for (int it = gw; it < nitems; it += 2 * NGW) {
        const CvItem c0 = it < CV_I_IN ? cv_item_in(A, it) : cv_item_late(A, it - CV_I_IN); const int it1 = it + NGW; const bool two = it1 < nitems;
        const CvItem c1 = it1 < CV_I_IN ? cv_item_in(A, it1) : cv_item_late(A, (two ? it1 : it) - CV_I_IN);
        float v0[32], v1[32]; cv_issue(v0, c0, lane); if (two) cv_issue(v1, c1, lane);
        cv_finish(v0, c0, scr, lane); if (two) cv_finish(v1, c1, scr + 2112, lane);
    }
    for (int i = (F.vcu * NWAVES * 64 + F.tid); i < 16 * 128 * 128 / 4; i += F.G * NWAVES * 64) { const int e = i * 4, t = (e >> 7) & 127, s0 = e & 127;
        const f32x4 v = *(const f32x4*)(IN_SGUW(A) + e);
        const unsigned lo = pk2(s0 <= t ? v[0] : 0.f, s0 + 1 <= t ? v[1] : 0.f), hi2 = pk2(s0 + 2 <= t ? v[2] : 0.f, s0 + 3 <= t ? v[3] : 0.f);
        *(unsigned long long*)(WSP(A, bf16, WS_WSB) + e) = (unsigned long long)lo | ((unsigned long long)hi2 << 32); }
    for (int m = gw; m < MTOK; m += NGW) {
        const GAS f32x4* xr = (const GAS f32x4*)(IN_X(A) + (size_t)m * DM) + lane; f32x4 v[8]; float ss = 0.f;
#pragma unroll
        for (int j = 0; j < 8; ++j) { v[j] = __builtin_nontemporal_load(xr + 64 * j); ss += (v[j].x * v[j].x + v[j].y * v[j].y) + (v[j].z * v[j].z + v[j].w * v[j].w); }
        ss = wave_sum(ss);
        const float rs = 1.0f / sqrtf(ss * (1.0f / DM) + EPS);
        GAS unsigned long long* o8 = (GAS unsigned long long*)(WSP(A, bf16, WS_XB) + (size_t)m * DM) + lane;
#pragma unroll
        for (int j = 0; j < 8; ++j) o8[64 * j] = (unsigned long long)pk2(v[j].x * rs, v[j].y * rs) | ((unsigned long long)pk2(v[j].z * rs, v[j].w * rs) << 32);
    }
    if (blockIdx.x == 0) {
        for (int i = F.tid; i < 128 * 16; i += NWAVES * 64) { const int n = i >> 4, h = i & 15; int bk;
            if (n < 16) bk = n; else { bk = 16 + (int)(logf((float)n / 16.0f) / 2.0794415416798357f * 16.0f); bk = bk > 31 ? 31 : bk; }
            WSP(A, float, WS_BTAB)[i] = (IN_RELB(A)[bk * 16 + h] - IN_RELB(A)[31 * 16 + h]) * 1.4426950408889634f; }
    }
}
__device__ __forceinline__ unsigned fkey(float f) { const unsigned u = __float_as_uint(f); return (u & 0x80000000u) ? ~u : (u | 0x80000000u); }
__device__ __forceinline__ int mbcnt64(unsigned long long m) { return __builtin_amdgcn_mbcnt_hi((unsigned)(m >> 32), __builtin_amdgcn_mbcnt_lo((unsigned)m, 0u)); }
__device__ __forceinline__ int wave_sum_i(int x) {
    x += __builtin_amdgcn_update_dpp(0, x, 0xB1, 0xF, 0xF, true);
    x += __builtin_amdgcn_update_dpp(0, x, 0x4E, 0xF, 0xF, true);
    x += __builtin_amdgcn_update_dpp(0, x, 0x141, 0xF, 0xF, true);
    x += __builtin_amdgcn_update_dpp(0, x, 0x140, 0xF, 0xF, true);
    return __builtin_amdgcn_readlane(x, 0) + __builtin_amdgcn_readlane(x, 16) + __builtin_amdgcn_readlane(x, 32) + __builtin_amdgcn_readlane(x, 48);
}
template <int NJ> __device__ __forceinline__ unsigned long long select_query(const LAS unsigned* sk, int lane) {
    unsigned v[NJ];
#pragma unroll
    for (int j = 0; j < NJ; ++j) v[j] = sk[lane + 64 * j];
    unsigned prefix = 0u; bool exact = false;
    for (int bit = 31; bit >= 0; --bit) {
        const unsigned cand = __builtin_amdgcn_readfirstlane(prefix | (1u << bit)); int c0 = 0, c1 = 0, c2 = 0, c3 = 0;
#define CNT_GE8(j0) asm volatile( \
            "v_cmp_le_u32_e32 vcc, %4, %5\n\tv_addc_co_u32_e32 %0, vcc, 0, %0, vcc\n\tv_cmp_le_u32_e32 vcc, %4, %6\n\tv_addc_co_u32_e32 %1, vcc, 0, %1, vcc\n\t" \
            "v_cmp_le_u32_e32 vcc, %4, %7\n\tv_addc_co_u32_e32 %2, vcc, 0, %2, vcc\n\tv_cmp_le_u32_e32 vcc, %4, %8\n\tv_addc_co_u32_e32 %3, vcc, 0, %3, vcc\n\t" \
            "v_cmp_le_u32_e32 vcc, %4, %9\n\tv_addc_co_u32_e32 %0, vcc, 0, %0, vcc\n\tv_cmp_le_u32_e32 vcc, %4, %10\n\tv_addc_co_u32_e32 %1, vcc, 0, %1, vcc\n\t" \
            "v_cmp_le_u32_e32 vcc, %4, %11\n\tv_addc_co_u32_e32 %2, vcc, 0, %2, vcc\n\tv_cmp_le_u32_e32 vcc, %4, %12\n\tv_addc_co_u32_e32 %3, vcc, 0, %3, vcc" \
            : "+v"(c0), "+v"(c1), "+v"(c2), "+v"(c3) : "s"(cand), "v"(v[j0]), "v"(v[j0 + 1]), "v"(v[j0 + 2]), "v"(v[j0 + 3]), "v"(v[j0 + 4]), "v"(v[j0 + 5]), "v"(v[j0 + 6]), "v"(v[j0 + 7]) : "vcc")
#pragma unroll
        for (int j = 0; j < NJ; j += 8) CNT_GE8(j);
#undef CNT_GE8
        const int c = wave_sum_i((c0 + c1) + (c2 + c3));
        if (c >= TOPK) { prefix = cand; if (c == TOPK) { exact = true; break; } }
    }
    unsigned mlo = 0u, mhi = 0u;
    if (exact) {
#pragma unroll
        for (int j = 0; j < NJ; ++j) { const unsigned long long bsel = __ballot(v[j] >= prefix); if (lane == j) { mlo = (unsigned)bsel; mhi = (unsigned)(bsel >> 32); } asm volatile("" : "+v"(mlo), "+v"(mhi)); }
    } else {
        int g0 = 0, g1 = 0; const unsigned pfx = __builtin_amdgcn_readfirstlane(prefix);
#define CNT_GT(acc, val) asm volatile("v_cmp_lt_u32_e32 vcc, %1, %2\n\tv_addc_co_u32_e32 %0, vcc, 0, %0, vcc" : "+v"(acc) : "s"(pfx), "v"(val) : "vcc")
#pragma unroll
        for (int j = 0; j < NJ; j += 2) { CNT_GT(g0, v[j]); CNT_GT(g1, v[j + 1]); }
#undef CNT_GT
        int rem = TOPK - wave_sum_i(g0 + g1);
#pragma unroll
        for (int j = 0; j < NJ; ++j) { const unsigned long long eq = __ballot(v[j] == prefix);
            const bool take = (v[j] > prefix) || ((v[j] == prefix) && (mbcnt64(eq) < rem));
            const unsigned long long bsel = __ballot(take); rem -= __builtin_popcountll(eq); rem = rem < 0 ? 0 : rem;
            if (lane == j) { mlo = (unsigned)bsel; mhi = (unsigned)(bsel >> 32); } asm volatile("" : "+v"(mlo), "+v"(mhi)); }
    }
    return (unsigned long long)mlo | ((unsigned long long)mhi << 32);
}
struct IdxFrag { bf16x8 qa[2][4]; float w[2][2][8]; };
__device__ __forceinline__ void idx_load_frag_q(IdxFrag& f, Frame& F, const Args& A, int b, int t0) {
    const int lane = F.lane, rho = lane & 31, half = lane >> 5, blk = rho >> 2;
    const int q4 = (blk >> 2) + 2 * (blk & 1), hd = (rho & 3) + 4 * ((blk >> 1) & 1);
#pragma unroll
    for (int R = 0; R < 2; ++R)
#pragma unroll
        for (int ks = 0; ks < 4; ++ks) f.qa[R][ks] = *(const bf16x8*)(WSP(A, bf16, WS_QI) + ((size_t)(b * SEQ + t0 + 4 * R + q4) * 512 + hd * 64 + ks * 16 + half * 8));
}
__device__ __forceinline__ void idx_load_frag_w(IdxFrag& f, Frame& F, const Args& A, int b, int t0) {
    const int half = F.lane >> 5;
#pragma unroll
    for (int R = 0; R < 2; ++R)
#pragma unroll
        for (int lq = 0; lq < 2; ++lq) { const float* wp = WSP(A, float, WS_WI) + (size_t)(b * SEQ + t0 + 4 * R + 2 * half + lq) * 8; const f32x4 a = *(const f32x4*)wp, c = *(const f32x4*)(wp + 4);
            f.w[R][lq][0] = a[0]; f.w[R][lq][1] = a[1]; f.w[R][lq][2] = a[2]; f.w[R][lq][3] = a[3]; f.w[R][lq][4] = c[0]; f.w[R][lq][5] = c[1]; f.w[R][lq][6] = c[2]; f.w[R][lq][7] = c[3]; }
}
__device__ __forceinline__ void idx_load_frag(IdxFrag& f, Frame& F, const Args& A, int b, int t0) { idx_load_frag_q(f, F, A, b, t0); idx_load_frag_w(f, F, A, b, t0); }
__device__ __forceinline__ float relu1(float x) { const int i = __builtin_bit_cast(int, x); return __builtin_bit_cast(float, i > 0 ? i : 0); }
__device__ __forceinline__ void idx_scores(const IdxFrag& f, Frame& F, const Args& A, int b, int t0, int stride) {
    LAS unsigned* SK = (LAS unsigned*)F.lds;
    const int lane = F.lane, rho = lane & 31, half = lane >> 5;
    const int ntv = (t0 + 8 + 31) >> 5, nta = stride >> 5;
    const bf16* kbase = WSP(A, bf16, WS_KI) + (size_t)(b * SEQ + rho) * 64 + half * 8;
#define KLOAD(dst, kt_) do { const int kc_ = (kt_) < ntv ? (kt_) : ntv - 1; _Pragma("unroll") for (int ks = 0; ks < 4; ++ks) dst[ks] = *(const bf16x8*)(kbase + (size_t)kc_ * 32 * 64 + ks * 16); } while (0)
#define KMMA(a0, a1, kb_) do { _Pragma("unroll") for (int ks = 0; ks < 4; ++ks) { a0 = __builtin_amdgcn_mfma_f32_32x32x16_bf16(f.qa[0][ks], kb_[ks], a0, 0, 0, 0); a1 = __builtin_amdgcn_mfma_f32_32x32x16_bf16(f.qa[1][ks], kb_[ks], a1, 0, 0, 0); } } while (0)
#define KOUT(a0, a1, kt_) do { if ((kt_) < ntv) { const int key = (kt_) * 32 + rho; \
        _Pragma("unroll") for (int R = 0; R < 2; ++R) _Pragma("unroll") for (int lq = 0; lq < 2; ++lq) { float s = 0.f; \
            _Pragma("unroll") for (int h = 0; h < 8; ++h) s = fmaf(f.w[R][lq][h], relu1(R == 0 ? a0[lq * 8 + h] : a1[lq * 8 + h]), s); \
            const int ql = 4 * R + 2 * half + lq; SK[ql * stride + key] = (key <= t0 + ql) ? fkey(s) : 0u; } } } while (0)
    bf16x8 kA[4], kB[4], nA[4], nB[4];
    KLOAD(kA, F.wave); KLOAD(kB, F.wave + NWAVES);
    for (int kt = F.wave; kt < ntv; kt += 2 * NWAVES) {
        KLOAD(nA, kt + 2 * NWAVES); KLOAD(nB, kt + 3 * NWAVES);
        f32x16 a0 = {}, a1 = {}, c0 = {}, c1 = {};
        KMMA(a0, a1, kA); KMMA(c0, c1, kB);
        KOUT(a0, a1, kt); KOUT(c0, c1, kt + NWAVES);
#pragma unroll
        for (int ks = 0; ks < 4; ++ks) { kA[ks] = nA[ks]; kB[ks] = nB[ks]; }
    }
#undef KLOAD
#undef KMMA
#undef KOUT
    for (int kt = ntv + F.wave; kt < nta; kt += NWAVES) {
        const int key = kt * 32 + rho;
#pragma unroll
        for (int q = 0; q < 4; ++q) SK[(2 * half + (q & 1) + 4 * (q >> 1)) * stride + key] = 0u;
    }
}
constexpr int LM_OFF = 131072;
__device__ __forceinline__ void idx_unit(IdxFrag& fr, Frame& F, const Args& A, int b, int u, int nb_, int nu, int cvi) {
    const int t0 = 8 * u, lane = F.lane, t = t0 + F.wave;
    LAS unsigned long long* LM = (LAS unsigned long long*)(F.lds + LM_OFF);
    { LAS v4u* z = (LAS v4u*)(F.lds + LM_OFF); z[F.tid] = (v4u){0u, 0u, 0u, 0u}; z[F.tid + 512] = (v4u){0u, 0u, 0u, 0u}; }
    unsigned long long word; float cv0[32], cv1[32]; const int cvj = cvi + F.G * NWAVES;
    const bool cva = cvi >= 0 && cvi < CV_I_LATE, cvb = false && cvj < CV_I_LATE; const CvItem ci0 = cv_item_late(A, cva ? cvi : 0), ci1 = cv_item_late(A, cvb ? cvj : 0);
    if (t0 + 8 <= TOPK) {
        const int nb = t + 1 - 64 * lane; word = nb >= 64 ? ~0ull : (nb > 0 ? ((1ull << nb) - 1ull) : 0ull);
        if (nu >= 32) idx_load_frag_q(fr, F, A, nb_, 8 * nu);
        if (cva) cv_issue(cv0, ci0, lane); if (cvb) cv_issue(cv1, ci1, lane);
        __syncthreads();
    } else {
        const int njc = (t0 + 8 + 511) >> 9, stride = njc * 512;
        idx_scores(fr, F, A, b, t0, stride);
        __syncthreads();
        if (nu >= 32) idx_load_frag_q(fr, F, A, nb_, 8 * nu);
        if (cva) cv_issue(cv0, ci0, lane); if (cvb) cv_issue(cv1, ci1, lane);
        const LAS unsigned* sk = (const LAS unsigned*)F.lds + F.wave * stride;
        switch (njc) {
            case 1: word = select_query<8>(sk, lane); break;
            case 2: word = select_query<16>(sk, lane); break;
            case 3: word = select_query<24>(sk, lane); break;
            case 4: word = select_query<32>(sk, lane); break;
            case 5: word = select_query<40>(sk, lane); break;
            case 6: word = select_query<48>(sk, lane); break;
            case 7: word = select_query<56>(sk, lane); break;
            default: word = select_query<64>(sk, lane); break;
        }
    }
#if !ATTN_MFMA
    WSP(A, unsigned long long, WS_MASK)[(size_t)(b * SEQ + t) * 64 + lane] = word;
#endif
    const int jmax = (t0 + 7) >> 6;
    if (lane <= jmax) {
        const int sh = 4 * F.wave;
#pragma unroll
        for (int rp = 0; rp < 32; ++rp) { const int c = 32 * (rp >> 4) + (rp & 3) + 8 * ((rp & 15) >> 2);
            const unsigned long long v = (((word >> c) & 1ull) ? (0xFull << sh) : 0ull) | (((word >> (c + 4)) & 1ull) ? (0xFull << (32 + sh)) : 0ull);
            __hip_atomic_fetch_or(&LM[rp * 64 + lane], v, __ATOMIC_RELAXED, __HIP_MEMORY_SCOPE_WORKGROUP); }
    }
    __syncthreads();
    if (cva) cv_finish(cv0, ci0, (LAS float*)(F.lds + F.wave * 16384), lane);
    if (cvb) cv_finish(cv1, ci1, (LAS float*)(F.lds + F.wave * 16384) + 2112, lane);
    if (nu >= 32) idx_load_frag_w(fr, F, A, nb_, 8 * nu);
    { const int j = F.tid >> 3;
      if (j <= jmax) { const int rp0 = 4 * (F.tid & 7); const unsigned long long w0 = LM[rp0 * 64 + j], w1 = LM[(rp0 + 1) * 64 + j], w2 = LM[(rp0 + 2) * 64 + j], w3 = LM[(rp0 + 3) * 64 + j];
          v4u* d = (v4u*)(WSP(A, unsigned long long, WS_LM) + ((size_t)(b * 512 + u) * 64) * 32) + F.tid * 2;
          d[0] = (v4u){(unsigned)w0, (unsigned)(w0 >> 32), (unsigned)w1, (unsigned)(w1 >> 32)}; d[1] = (v4u){(unsigned)w2, (unsigned)(w2 >> 32), (unsigned)w3, (unsigned)(w3 >> 32)}; } }
    __syncthreads();
}
__device__ __forceinline__ void idx_unit_probe(Frame& F, const Args& A, int b, int u, int mode) {
    const int t0 = 8 * u, lane = F.lane;
    if (t0 + 8 <= TOPK) return;
    const int njc = (t0 + 8 + 511) >> 9, stride = njc * 512;
    IdxFrag fr; idx_load_frag(fr, F, A, b, t0); idx_scores(fr, F, A, b, t0, stride);
    __syncthreads();
    if (mode == 1) {
        const LAS unsigned* sk = (const LAS unsigned*)F.lds + F.wave * stride; unsigned long long word;
        switch (njc) {
            case 1: word = select_query<8>(sk, lane); break;
            case 2: word = select_query<16>(sk, lane); break;
            case 3: word = select_query<24>(sk, lane); break;
            case 4: word = select_query<32>(sk, lane); break;
            case 5: word = select_query<40>(sk, lane); break;
            case 6: word = select_query<48>(sk, lane); break;
            case 7: word = select_query<56>(sk, lane); break;
            default: word = select_query<64>(sk, lane); break;
        }
        if (word == 0x123456789abcdef1ull) WSP(A, unsigned long long, WS_MASK)[0] = word;
    }
    __syncthreads();
}
__device__ __forceinline__ void sgu_unit(Frame& F, const Args& A, int b, int c, int g) {
    LAS float* VN = (LAS float*)F.lds;
    LAS float* WT = (LAS float*)(F.lds + 65536);
    LAS float* ST = (LAS float*)(F.lds + 65536 + 66048);
    const int tid = F.tid, m0 = b * SEQ + c * 128, ch0 = g * 128;
    if (tid < 128) { const float* p = WSP(A, float, WS_VST) + (size_t)(m0 + tid) * 64; float s = 0.f, q = 0.f;
#pragma unroll
        for (int i = 0; i < 16; ++i) { const f32x4 v = *(const f32x4*)(p + 4 * i); s += v[0] + v[2]; q += v[1] + v[3]; }
        const float mean = s * (1.0f / 2048.0f), var = q * (1.0f / 2048.0f) - mean * mean;
        ST[2 * tid] = mean; ST[2 * tid + 1] = 1.0f / sqrtf(var + EPS); }
    { const float* Wg = IN_SGUW(A) + (size_t)g * 16384;
#pragma unroll
        for (int i = 0; i < 8; ++i) { const int idx = tid + 512 * i, t = idx >> 5, s0 = (idx & 31) * 4; const f32x4 v = *(const f32x4*)(Wg + t * 128 + s0);
#pragma unroll
            for (int e = 0; e < 4; ++e) WT[t * 129 + s0 + e] = (s0 + e <= t) ? v[e] : 0.f; } }
    __syncthreads();
#pragma unroll
    for (int i = 0; i < 4; ++i) { const int idx = tid + 512 * i, row = idx >> 4, cc = (idx & 15) * 8;
        const v4u raw = *(const v4u*)(WSP(A, bf16, WS_GV) + (size_t)(m0 + row) * 2048 + ch0 + cc);
        const float mean = ST[2 * row], rstd = ST[2 * row + 1];
        const f32x4 g0 = *(const f32x4*)(IN_LNG(A) + ch0 + cc), g1 = *(const f32x4*)(IN_LNG(A) + ch0 + cc + 4), b0 = *(const f32x4*)(IN_LNB(A) + ch0 + cc), b1 = *(const f32x4*)(IN_LNB(A) + ch0 + cc + 4);
        f32x4 o0, o1;
        o0[0] = (bf_lo(raw.x) - mean) * rstd * g0[0] + b0[0]; o0[1] = (bf_hi(raw.x) - mean) * rstd * g0[1] + b0[1];
        o0[2] = (bf_lo(raw.y) - mean) * rstd * g0[2] + b0[2]; o0[3] = (bf_hi(raw.y) - mean) * rstd * g0[3] + b0[3];
        o1[0] = (bf_lo(raw.z) - mean) * rstd * g1[0] + b1[0]; o1[1] = (bf_hi(raw.z) - mean) * rstd * g1[1] + b1[1];
        o1[2] = (bf_lo(raw.w) - mean) * rstd * g1[2] + b1[2]; o1[3] = (bf_hi(raw.w) - mean) * rstd * g1[3] + b1[3];
        *(LAS f32x4*)(VN + row * 128 + cc) = o0; *(LAS f32x4*)(VN + row * 128 + cc + 4) = o1; }
    __syncthreads();
    const int t = tid >> 2, dq = tid & 3, tmax = (F.wave * 16 + 15);
    f32x4 acc[8];
#pragma unroll
    for (int i = 0; i < 8; ++i) acc[i] = (f32x4){0.f, 0.f, 0.f, 0.f};
    for (int s = 0; s <= tmax; ++s) { const float w = WT[t * 129 + s];
#pragma unroll
        for (int i = 0; i < 8; ++i) acc[i] += w * *(const LAS f32x4*)(VN + s * 128 + dq * 32 + 4 * i); }
    const float bs = IN_SGUB(A)[g * 128 + t];
    const size_t off = (size_t)(m0 + t) * 2048 + ch0 + dq * 32;
#pragma unroll
    for (int i = 0; i < 4; ++i) { const v4u gu = *(const v4u*)(WSP(A, bf16, WS_GU) + off + 8 * i), sb = *(const v4u*)(WSP(A, bf16, WS_SGB) + off + 8 * i); const f32x4 a0 = acc[2 * i], a1 = acc[2 * i + 1]; v4u o;
        o.x = pk2(bf_lo(gu.x) * (a0[0] + bs) * bf_lo(sb.x), bf_hi(gu.x) * (a0[1] + bs) * bf_hi(sb.x));
        o.y = pk2(bf_lo(gu.y) * (a0[2] + bs) * bf_lo(sb.y), bf_hi(gu.y) * (a0[3] + bs) * bf_hi(sb.y));
        o.z = pk2(bf_lo(gu.z) * (a1[0] + bs) * bf_lo(sb.z), bf_hi(gu.z) * (a1[1] + bs) * bf_hi(sb.z));
        o.w = pk2(bf_lo(gu.w) * (a1[2] + bs) * bf_lo(sb.w), bf_hi(gu.w) * (a1[3] + bs) * bf_hi(sb.w));
        *(v4u*)(WSP(A, bf16, WS_GU) + off + 8 * i) = o; }
    __syncthreads();
}
__device__ __forceinline__ void attn_gather_phase(Frame& F, const Args& A) {
    asm volatile("; ATTN_BEGIN" ::: "memory");
    const int lane = F.lane, gw = F.vcu * NWAVES + F.wave, NGW = F.G * NWAVES;
    LAS unsigned char* wl = F.lds + F.wave * 8192;
    LAS unsigned short* IDX = (LAS unsigned short*)wl;
    LAS float* QF = (LAS float*)(wl + 512);
    LAS float* PB = (LAS float*)(wl + 2560);
    for (int task = gw; task < MTOK * 4; task += NGW) {
        const int m = task >> 2, g = task & 3, b = m >> 12, t = m & 4095;
        const unsigned long long word = WSP(A, unsigned long long, WS_MASK)[(size_t)m * 64 + lane];
        int cnt = 0;
        for (int j = 0; j <= (t >> 6); ++j) {
            const unsigned lo = __builtin_amdgcn_readlane((unsigned)word, j), hi = __builtin_amdgcn_readlane((unsigned)(word >> 32), j);
            const unsigned long long wj = ((unsigned long long)hi << 32) | lo;
            if ((wj >> lane) & 1ull) IDX[cnt + mbcnt64(wj)] = (unsigned short)(64 * j + lane);
            cnt += __builtin_popcountll(wj);
        }
        { const v4u raw = *(const v4u*)(WSP(A, bf16, WS_Q2) + (((size_t)(b * 4 + g) * SEQ + t) * 4) * 128 + lane * 8);
          f32x4 a = {bf_lo(raw.x), bf_hi(raw.x), bf_lo(raw.y), bf_hi(raw.y)}, c = {bf_lo(raw.z), bf_hi(raw.z), bf_lo(raw.w), bf_hi(raw.w)};
          *(LAS f32x4*)(QF + lane * 8) = a; *(LAS f32x4*)(QF + lane * 8 + 4) = c; }
        LDS_WAIT(); asm volatile("" ::: "memory");
        const bf16* Kg = WSP(A, bf16, WS_K2) + (size_t)(b * 4 + g) * SEQ * 128; const bf16* Vg = WSP(A, bf16, WS_V2) + (size_t)(b * 4 + g) * SEQ * 128;
        float mx[4] = {-3.0e38f, -3.0e38f, -3.0e38f, -3.0e38f};
        for (int i = 0; i < 4; ++i) { const int n = lane + 64 * i;
            if (n < cnt) { const int s = IDX[n]; const bf16* kr = Kg + (size_t)s * 128; float a4[4] = {0.f, 0.f, 0.f, 0.f};
                for (int dd = 0; dd < 16; ++dd) { const v4u kraw = *(const v4u*)(kr + dd * 8);
                    const float k8[8] = {bf_lo(kraw.x), bf_hi(kraw.x), bf_lo(kraw.y), bf_hi(kraw.y), bf_lo(kraw.z), bf_hi(kraw.z), bf_lo(kraw.w), bf_hi(kraw.w)};
#pragma unroll
                    for (int h = 0; h < 4; ++h) { const f32x4 q0 = *(const LAS f32x4*)(QF + h * 128 + dd * 8), q1 = *(const LAS f32x4*)(QF + h * 128 + dd * 8 + 4);
                        a4[h] += (q0[0] * k8[0] + q0[1] * k8[1]) + (q0[2] * k8[2] + q0[3] * k8[3]) + (q1[0] * k8[4] + q1[1] * k8[5]) + (q1[2] * k8[6] + q1[3] * k8[7]); } }
                const int dist = t - s; const float* bt = WSP(A, float, WS_BTAB) + (dist < 127 ? dist : 127) * 16 + g * 4;
#pragma unroll
                for (int h = 0; h < 4; ++h) { const float l = a4[h] + bt[h]; PB[h * 256 + n] = l; mx[h] = fmaxf(mx[h], l); } } }
        float li[4];
#pragma unroll
        for (int h = 0; h < 4; ++h) { mx[h] = wave_max(mx[h]); float sm = 0.f;
            for (int i = 0; i < 4; ++i) { const int n = lane + 64 * i; if (n < cnt) { const float p = __builtin_amdgcn_exp2f(PB[h * 256 + n] - mx[h]); PB[h * 256 + n] = p; sm += p; } }
            li[h] = 1.0f / wave_sum(sm); }
        LDS_WAIT(); asm volatile("" ::: "memory");
        float o[4][2] = {{0.f, 0.f}, {0.f, 0.f}, {0.f, 0.f}, {0.f, 0.f}};
        for (int n = 0; n < cnt; ++n) { const int s = IDX[n]; const unsigned vraw = *(const unsigned*)(Vg + (size_t)s * 128 + 2 * lane); const float v0 = bf_lo(vraw), v1 = bf_hi(vraw);
#pragma unroll
            for (int h = 0; h < 4; ++h) { const float p = PB[h * 256 + n]; o[h][0] += p * v0; o[h][1] += p * v1; } }
#pragma unroll
        for (int h = 0; h < 4; ++h) { const size_t off = (size_t)m * 2048 + (g * 4 + h) * 128 + 2 * lane;
            const unsigned ga = *(const unsigned*)(WSP(A, bf16, WS_SGA) + off), sp = *(const unsigned*)(WSP(A, bf16, WS_GU) + off);
            *(unsigned*)(WSP(A, bf16, WS_MERGED) + off) = pk2(bf_lo(ga) * (o[h][0] * li[h]) + bf_lo(sp), bf_hi(ga) * (o[h][1] * li[h]) + bf_hi(sp)); }
        LDS_WAIT(); asm volatile("" ::: "memory");
    }
    asm volatile("; ATTN_END" ::: "memory");
}
__device__ __forceinline__ void final_norm_phase(Frame& F, const Args& A) {
    const int lane = F.lane, gw = F.vcu * NWAVES + F.wave, NGW = F.G * NWAVES;
    for (int m = gw; m < MTOK; m += NGW) {
        float s = lane < 32 ? WSP(A, float, WS_SSQ3)[(size_t)m * 32 + lane] : 0.f; s = wave_sum(s);
        const float rs = 1.0f / sqrtf(s * (1.0f / DM) + EPS);
        GAS f32x4* xr = (GAS f32x4*)((A).out + (size_t)m * DM) + lane; const GAS f32x4* gr = (const GAS f32x4*)IN_FING(A) + lane;
#pragma unroll
        for (int j = 0; j < 8; ++j) { const f32x4 v = xr[64 * j], g = gr[64 * j]; xr[64 * j] = v * rs * g; }
    }
}
namespace att {
constexpr int D = 128, NW = 8, QBLK = 32, KVBLK = 64, QB = 256, SHM_V = 16384, SHM_K = 16384;
constexpr int NRING = 3;
constexpr int L_V = 0, L_K = NRING * SHM_V, L_WS = L_K + NRING * SHM_K, L_BT = L_WS + NW * 64 * 4, L_OST = L_BT + 2048, L_END = L_OST + NW * 4096;
constexpr int SG_V = 0, SG_WS = 65536, SG_OST = 69632;
constexpr float THR2 = 11.5f;
#define KSWZ(row, colB) ((row) * 256 + ((colB) ^ (((row) & 7) << 4)))
#define SBAR() __builtin_amdgcn_sched_barrier(0)
typedef short s16x4 __attribute__((ext_vector_type(4)));
__device__ __forceinline__ int v_st(int k, int c) { const int kk = (k & ~0xC) | ((k & 4) << 1) | ((k & 8) >> 1); return ((kk >> 3) * 4 + (c >> 5)) * 512 + ((kk & 7) * 32 + (c & 31)) * 2; }
__device__ __forceinline__ int v_rd_base(int lane) { return ((lane & 3) << 3) | (((lane >> 2) & 3) << 6) | (((lane >> 4) & 1) << 5) | (((lane >> 5) & 1) << 8); }
constexpr int v_rd_off(int d0, int ks, int half) { return d0 * 512 + ks * 4096 + half * 2048; }
__device__ __forceinline__ int crow(int r, int hi) { return (r & 3) + 8 * (r >> 2) + 4 * hi; }
__device__ __forceinline__ unsigned cvtpk(float lo, float hi) { unsigned r; asm volatile("v_cvt_pk_bf16_f32 %0, %1, %2" : "=v"(r) : "v"(lo), "v"(hi)); return r; }
typedef unsigned u32x16 __attribute__((ext_vector_type(16)));
template <int OFF> __device__ __forceinline__ u32x16 lm_load(const void* p) { u32x16 v; asm volatile("s_load_dwordx16 %0, %1, %2 glc" : "=&s"(v) : "s"(p), "i"(OFF)); return v; }
__device__ __forceinline__ void lm_wait(u32x16& a, u32x16& b) { asm volatile("s_waitcnt lgkmcnt(0)" : "+s"(a), "+s"(b)); }
__device__ __forceinline__ void lm_apply(f32x16& p, const u32x16& a, const u32x16& b, float neg) {
#pragma unroll
    for (int k = 0; k < 8; ++k) { const unsigned long long mk = (unsigned long long)a[2 * k] | ((unsigned long long)a[2 * k + 1] << 32);
        asm volatile("v_cndmask_b32_e64 %0, %1, %0, %2" : "+v"(p[k]) : "v"(neg), "s"(mk)); }
#pragma unroll
    for (int k = 0; k < 8; ++k) { const unsigned long long mk = (unsigned long long)b[2 * k] | ((unsigned long long)b[2 * k + 1] << 32);
        asm volatile("v_cndmask_b32_e64 %0, %1, %0, %2" : "+v"(p[8 + k]) : "v"(neg), "s"(mk)); }
}
__device__ __forceinline__ void band_bias(f32x16& p0, f32x16& p1, int dq, const LAS float* bt) {
#pragma unroll
    for (int r = 0; r < 16; ++r) { const int c = (r & 3) + 8 * (r >> 2); const unsigned d0 = (unsigned)(dq - c), d1 = (unsigned)(dq - c - 32);
        p0[r] += bt[(d0 < 127u ? d0 : 127u) * 4]; p1[r] += bt[(d1 < 127u ? d1 : 127u) * 4]; }
}
__device__ __forceinline__ float fadd_s(float x, float y) { float r; asm("v_add_f32_e32 %0, %1, %2" : "=v"(r) : "v"(x), "v"(y)); return r; }
__device__ __forceinline__ float fsub_s(float x, float y) { float r; asm("v_sub_f32_e32 %0, %1, %2" : "=v"(r) : "v"(x), "v"(y)); return r; }
__device__ __forceinline__ void partialSM(f32x16& p0, f32x16& p1, float& m_reg, float& mn, float& alpha) {
    float pmax = p0[0];
#pragma unroll
    for (int r = 1; r < 16; ++r) pmax = fmaxf(pmax, p0[r]);
#pragma unroll
    for (int r = 0; r < 16; ++r) pmax = fmaxf(pmax, p1[r]);
    { auto rr = __builtin_amdgcn_permlane32_swap(__float_as_uint(pmax), __float_as_uint(pmax), false, false);
      pmax = fmaxf(__uint_as_float(rr[0]), __uint_as_float(rr[1])); }
    if (__builtin_expect(__all((pmax - m_reg) <= THR2), 1)) { mn = m_reg; alpha = 1.f; }
    else { mn = fmaxf(m_reg, pmax); alpha = __builtin_amdgcn_exp2f(m_reg - mn); m_reg = mn; }
#pragma unroll
    for (int r = 0; r < 16; ++r) { p0[r] = fsub_s(p0[r], mn); p1[r] = fsub_s(p1[r], mn); }
#pragma unroll
    for (int r = 0; r < 16; ++r) p0[r] = __builtin_amdgcn_exp2f(p0[r]);
}
__device__ __forceinline__ void finishSM(f32x16& p0, f32x16& p1, float alpha, float& l_reg, bf16x8& pa0, bf16x8& pa1, bf16x8& pa2, bf16x8& pa3) {
#pragma unroll
    for (int r = 0; r < 16; ++r) p1[r] = __builtin_amdgcn_exp2f(p1[r]);
    float ps = fadd_s(p0[0], p0[1]), ps1 = fadd_s(p0[2], p0[3]), ps2 = fadd_s(p1[0], p1[1]), ps3 = fadd_s(p1[2], p1[3]);
#pragma unroll
    for (int r = 4; r < 16; r += 2) { ps = fadd_s(ps, p0[r]); ps1 = fadd_s(ps1, p0[r + 1]); ps2 = fadd_s(ps2, p1[r]); ps3 = fadd_s(ps3, p1[r + 1]); }
    ps = fadd_s(fadd_s(ps, ps1), fadd_s(ps2, ps3));
    { auto rr = __builtin_amdgcn_permlane32_swap(__float_as_uint(ps), __float_as_uint(ps), false, false);
      ps = __uint_as_float(rr[0]) + __uint_as_float(rr[1]); }
    l_reg = l_reg * alpha + ps;
#define PK4(P, B_, OUT) do { unsigned a0 = cvtpk(P[B_+0], P[B_+1]), a1 = cvtpk(P[B_+2], P[B_+3]);                          \
        unsigned b0 = cvtpk(P[B_+4], P[B_+5]), b1 = cvtpk(P[B_+6], P[B_+7]);                                             \
        auto r0 = __builtin_amdgcn_permlane32_swap(a0, b0, false, false); auto r1 = __builtin_amdgcn_permlane32_swap(a1, b1, false, false); \
        v4u w = {r0[0], r1[0], r0[1], r1[1]}; OUT = *reinterpret_cast<bf16x8*>(&w); } while (0)
    PK4(p0, 0, pa0); PK4(p0, 8, pa1); PK4(p1, 0, pa2); PK4(p1, 8, pa3);
#undef PK4
}
template <int KB>
__device__ __forceinline__ void qkt(f32x16& p0, f32x16& p1, const char* K_lds, int r32, int hi, const bf16x8* qr) {
    p0 = f32x16{}; p1 = f32x16{};
    const char* kb[4];
#pragma unroll
    for (int dd = 0; dd < 4; ++dd) kb[dd] = K_lds + KB * SHM_K + KSWZ(r32, (dd * 16 + hi * 8) * 2);
#pragma unroll
    for (int d0 = 0; d0 < 8; ++d0) { const char* a = kb[d0 & 3] + (d0 >> 2) * 128;
        bf16x8 b0 = *reinterpret_cast<const bf16x8*>(a);
        bf16x8 b1 = *reinterpret_cast<const bf16x8*>(a + 32 * 256);
        p0 = __builtin_amdgcn_mfma_f32_32x32x16_bf16(b0, qr[d0], p0, 0, 0, 0);
        p1 = __builtin_amdgcn_mfma_f32_32x32x16_bf16(b1, qr[d0], p1, 0, 0, 0); }
}
template <int VB>
__device__ __forceinline__ void pv_tile(f32x16* o, int vb0, bf16x8 pa0, bf16x8 pa1, bf16x8 pa2, bf16x8 pa3) {
#define TRRD(dst, off) asm volatile("ds_read_b64_tr_b16 %0, %1 offset:%2" : "=&v"(dst) : "v"(vb0), "i"(off) : "memory")
#define PV_D0(d0) do { s16x4 l0, l1, l2, l3, h0, h1, h2, h3; constexpr int b_ = VB * SHM_V + v_rd_off(d0, 0, 0); \
        TRRD(l0, b_); TRRD(h0, b_ + 2048); TRRD(l1, b_ + 4096); TRRD(h1, b_ + 6144); TRRD(l2, b_ + 8192); TRRD(h2, b_ + 10240); TRRD(l3, b_ + 12288); TRRD(h3, b_ + 14336); \
        asm volatile("s_waitcnt lgkmcnt(0)" ::: "memory"); SBAR();   \
        o[d0] = __builtin_amdgcn_mfma_f32_32x32x16_bf16(pa0, (bf16x8){l0[0], l0[1], l0[2], l0[3], h0[0], h0[1], h0[2], h0[3]}, o[d0], 0, 0, 0);   \
        o[d0] = __builtin_amdgcn_mfma_f32_32x32x16_bf16(pa1, (bf16x8){l1[0], l1[1], l1[2], l1[3], h1[0], h1[1], h1[2], h1[3]}, o[d0], 0, 0, 0);   \
        o[d0] = __builtin_amdgcn_mfma_f32_32x32x16_bf16(pa2, (bf16x8){l2[0], l2[1], l2[2], l2[3], h2[0], h2[1], h2[2], h2[3]}, o[d0], 0, 0, 0);   \
        o[d0] = __builtin_amdgcn_mfma_f32_32x32x16_bf16(pa3, (bf16x8){l3[0], l3[1], l3[2], l3[3], h3[0], h3[1], h3[2], h3[3]}, o[d0], 0, 0, 0); } while (0)
    PV_D0(0); PV_D0(1); PV_D0(2); PV_D0(3);
#undef PV_D0
#undef TRRD
}
struct BlockRef { const bf16* Q; const bf16* K; const bf16* V; const unsigned long long* LMB; int qb; int m0; };
__device__ __forceinline__ bf16x8 ld8(const bf16* p) { return *reinterpret_cast<const bf16x8*>(p); }
#define ROW(p, k0, rr) ((p) + (size_t)((k0) + (rr)) * D + sc)
#define VMW() asm volatile("s_waitcnt vmcnt(0)" ::: "memory")
#define SLOAD_H(Kp, Vp, k0) do { st_v0 = ld8(ROW(Vp, k0, sr)); st_v1 = ld8(ROW(Vp, k0, 32 + sr)); st_k0 = ld8(ROW(Kp, k0, sr)); st_k1 = ld8(ROW(Kp, k0, 32 + sr)); } while (0)
#define SWRITE_H(bf) do { *(bf16x8*)(V_lds + (bf) * SHM_V + vst0) = st_v0; *(bf16x8*)(V_lds + (bf) * SHM_V + vst1) = st_v1; \
                          *(bf16x8*)(K_lds + (bf) * SHM_K + kws) = st_k0; *(bf16x8*)(K_lds + (bf) * SHM_K + kws + 32 * 256) = st_k1; } while (0)
__device__ __forceinline__ void attn_block(const BlockRef& cur, char* lds, int g4, const bf16* SGA, const bf16* SP, bf16* MERGED) {
    const int tid = threadIdx.x, wid = __builtin_amdgcn_readfirstlane(tid >> 6), lane = tid & 63, r32 = lane & 31, hi = lane >> 5;
    const bool lag = wid >= 4;
    const int NT = cur.qb + 1;
    char* V_lds = lds + L_V; char* K_lds = lds + L_K;
    float* ws = (float*)(lds + L_WS) + wid * 64; float* li_l = ws, * al_l = ws + 32;
    const LAS float* bt = (const LAS float*)((LAS char*)(lds + L_BT)) + (r32 & 3);
    const int sr = tid >> 4, sc = (tid & 15) * 8, vst0 = v_st(sr, sc), vst1 = v_st(32 + sr, sc), kws = KSWZ(sr, sc * 2);
    const int vb0 = (int)(uintptr_t)V_lds + v_rd_base(lane);
    const bf16* Kh = cur.K; const bf16* Vh = cur.V;
    const char* lmw = (const char*)(cur.LMB + (size_t)wid * 64 * 32);
    const float NEGINF = -__builtin_inff();
    const int qpos = cur.qb * 64 + wid * 8 + (r32 >> 2);
    const int qlo = cur.qb * 64 + wid * 8;
    bf16x8 qr[8], st_v0, st_v1, st_k0, st_k1;
#pragma unroll
    for (int d0 = 0; d0 < 8; ++d0) qr[d0] = ld8(cur.Q + (size_t)(wid * QBLK + r32) * D + d0 * 16 + hi * 8);
    SLOAD_H(Kh, Vh, 0); VMW(); SWRITE_H(0);
    __syncthreads();
    float m_reg = -1e30f, l_reg = 0; f32x16 o[4] = {};
    bf16x8 pa0, pa1, pa2, pa3;
    u32x16 ma_ = lm_load<0>(lmw), mb_ = lm_load<64>(lmw), mc_ = lm_load<128>(lmw), md_ = lm_load<192>(lmw);
#define STEP(BUF, NBUF_, PBUF_, t) do {                                                                                       \
        if ((t) + 1 < NT) SLOAD_H(Kh, Vh, ((t) + 1) * KVBLK);                                                                 \
        SBAR(); if (lag && (t) > 0) { __builtin_amdgcn_s_setprio(1); pv_tile<PBUF_>(o, vb0, pa0, pa1, pa2, pa3); __builtin_amdgcn_s_setprio(0); } \
        SBAR(); f32x16 p0, p1; __builtin_amdgcn_s_setprio(1); qkt<BUF>(p0, p1, K_lds, r32, hi, qr); __builtin_amdgcn_s_setprio(0);     \
        asm volatile("s_nop 15\n\ts_nop 7" : "+v"(p0), "+v"(p1));     \
        lm_wait(ma_, mb_); lm_wait(mc_, md_); lm_apply(p0, ma_, mb_, NEGINF); lm_apply(p1, mc_, md_, NEGINF);                 \
        { const char* lmp_ = lmw + (size_t)((t) + 1 < NT ? (t) + 1 : (t)) * 256;     \
          ma_ = lm_load<0>(lmp_); mb_ = lm_load<64>(lmp_); mc_ = lm_load<128>(lmp_); md_ = lm_load<192>(lmp_); }                \
        if (qlo - ((t) * KVBLK + KVBLK - 1) < 113) band_bias(p0, p1, qpos - (t) * KVBLK - 4 * hi, bt);                        \
        float mn_, al_; partialSM(p0, p1, m_reg, mn_, al_);                                                                   \
        finishSM(p0, p1, al_, l_reg, pa0, pa1, pa2, pa3);                                                                     \
        if (__any(al_ < 1.f)) { if (hi == 0) al_l[r32] = al_; asm volatile("s_waitcnt lgkmcnt(0)" ::: "memory");              \
            for (int d_ = 0; d_ < 4; ++d_) for (int r = 0; r < 16; ++r) o[d_][r] *= al_l[crow(r, hi)]; }                      \
        SBAR(); if (!lag) { __builtin_amdgcn_s_setprio(1); pv_tile<BUF>(o, vb0, pa0, pa1, pa2, pa3); __builtin_amdgcn_s_setprio(0); } \
        SBAR(); if ((t) + 1 < NT) { VMW(); SWRITE_H(NBUF_); }                                                                 \
        __syncthreads(); } while (0)
    for (int t = 0; t < NT; t += 3) { STEP(0, 1, 2, t); if (t + 1 < NT) STEP(1, 2, 0, t + 1); if (t + 2 < NT) STEP(2, 0, 1, t + 2); }
#undef STEP
    if (lag) { const int lb = (NT - 1) % 3;
        if (lb == 0) pv_tile<0>(o, vb0, pa0, pa1, pa2, pa3); else if (lb == 1) pv_tile<1>(o, vb0, pa0, pa1, pa2, pa3); else pv_tile<2>(o, vb0, pa0, pa1, pa2, pa3); }
    if (hi == 0) li_l[r32] = l_reg; asm volatile("s_waitcnt lgkmcnt(0)" ::: "memory");
    float rli[16];
#pragma unroll
    for (int r = 0; r < 16; ++r) rli[r] = __builtin_amdgcn_rcpf(li_l[crow(r, hi)]);
    float* ost = (float*)(lds + L_OST) + wid * 1024;
#pragma unroll
    for (int d0 = 0; d0 < 4; ++d0) {
#pragma unroll
        for (int r = 0; r < 16; ++r) ost[crow(r, hi) * 32 + r32] = o[d0][r] * rli[r];
        asm volatile("s_waitcnt lgkmcnt(0)" ::: "memory");
#pragma unroll
        for (int i = 0; i < 2; ++i) { const int cid = lane + 64 * i, row = cid >> 2, c8 = (cid & 3) * 8;
            const f32x4 a = *(const f32x4*)(ost + row * 32 + c8), c = *(const f32x4*)(ost + row * 32 + c8 + 4);
            const size_t off = (size_t)(cur.m0 + wid * 8 + (row >> 2)) * 2048 + (g4 * 4 + (row & 3)) * 128 + d0 * 32 + c8;
            const v4u ga = __builtin_nontemporal_load((const v4u*)(SGA + off)), sp = __builtin_nontemporal_load((const v4u*)(SP + off)); v4u w;
            w.x = pk2(bf_lo(ga.x) * a[0] + bf_lo(sp.x), bf_hi(ga.x) * a[1] + bf_hi(sp.x)); w.y = pk2(bf_lo(ga.y) * a[2] + bf_lo(sp.y), bf_hi(ga.y) * a[3] + bf_hi(sp.y));
            w.z = pk2(bf_lo(ga.z) * c[0] + bf_lo(sp.z), bf_hi(ga.z) * c[1] + bf_hi(sp.z)); w.w = pk2(bf_lo(ga.w) * c[2] + bf_lo(sp.w), bf_hi(ga.w) * c[3] + bf_hi(sp.w));
            pg8::st16_out(MERGED + off, w); }
        asm volatile("s_waitcnt lgkmcnt(0)" ::: "memory");
    }
    __syncthreads();
}
#undef ROW
#undef VMW
#undef SLOAD_H
#undef SWRITE_H
#undef KSWZ
#undef SBAR
}

__device__ __forceinline__ void sgu_pair_unit(Frame& F, const Args& A, unsigned char* lds_generic, int b, int c, int gp, int cvi) {
    using namespace att;
    char* lds = (char*)lds_generic;
    const int tid = F.tid, wid = F.wave, lane = F.lane, r32 = lane & 31, hi = lane >> 5;
    const int m0 = b * SEQ + c * 128;
    LAS float* ST = (LAS float*)(F.lds + SG_WS);
    float cv0[32], cv1[32]; const int cvj = cvi + F.G * NWAVES; const bool cva = cvi >= 0 && cvi < CV_I_LATE, cvb = cvi >= 0 && cvj < CV_I_LATE;
    const CvItem ci0 = cv_item_late(A, cva ? cvi : 0), ci1 = cv_item_late(A, cvb ? cvj : 0);
    if (cva) cv_issue(cv0, ci0, lane); if (cvb) cv_issue(cv1, ci1, lane);
    v4u raw[8];
#pragma unroll
    for (int i = 0; i < 8; ++i) { const int id = tid + 512 * i, grp_ = id >> 11, s = (id >> 4) & 127, cc = (id & 15) * 8, ch = (2 * gp + grp_) * 128 + cc;
        raw[i] = __builtin_nontemporal_load((const v4u*)(WSP(A, bf16, WS_GV) + (size_t)(m0 + s) * 2048 + ch)); }
    const int grp = wid >> 2, w4 = wid & 3, g = 2 * gp + grp;
    const bf16* wrow = WSP(A, bf16, WS_WSB) + ((size_t)g * 128 + 32 * w4 + r32) * 128 + 8 * hi;
    bf16x8 wf[8];
#pragma unroll
    for (int i = 0; i < 8; ++i) wf[i] = (i < 4 || w4 >= 2) ? *(const bf16x8*)(wrow + 16 * i) : wf[0];
    if (tid < 128) { const float* p = WSP(A, float, WS_VST) + (size_t)(m0 + tid) * 64; float s = 0.f, q = 0.f;
#pragma unroll
        for (int i = 0; i < 16; ++i) { const f32x4 v = *(const f32x4*)(p + 4 * i); s += v[0] + v[2]; q += v[1] + v[3]; }
        const float mean = s * (1.0f / 2048.0f), var = q * (1.0f / 2048.0f) - mean * mean;
        ST[2 * tid] = mean; ST[2 * tid + 1] = 1.0f / sqrtf(var + EPS); }
    __syncthreads();
#pragma unroll
    for (int i = 0; i < 8; ++i) { const int id = tid + 512 * i, grp = id >> 11, s = (id >> 4) & 127, cc = (id & 15) * 8, ch = (2 * gp + grp) * 128 + cc;
        const float mean = ST[2 * s], rstd = ST[2 * s + 1];
        const f32x4 g0 = *(const f32x4*)(IN_LNG(A) + ch), g1 = *(const f32x4*)(IN_LNG(A) + ch + 4), b0 = *(const f32x4*)(IN_LNB(A) + ch), b1 = *(const f32x4*)(IN_LNB(A) + ch + 4);
        v4u o;
        o.x = pk2((bf_lo(raw[i].x) - mean) * rstd * g0[0] + b0[0], (bf_hi(raw[i].x) - mean) * rstd * g0[1] + b0[1]);
        o.y = pk2((bf_lo(raw[i].y) - mean) * rstd * g0[2] + b0[2], (bf_hi(raw[i].y) - mean) * rstd * g0[3] + b0[3]);
        o.z = pk2((bf_lo(raw[i].z) - mean) * rstd * g1[0] + b1[0], (bf_hi(raw[i].z) - mean) * rstd * g1[1] + b1[1]);
        o.w = pk2((bf_lo(raw[i].w) - mean) * rstd * g1[2] + b1[2], (bf_hi(raw[i].w) - mean) * rstd * g1[3] + b1[3]);
        *(v4u*)(lds + SG_V + (grp * 2 + (s >> 6)) * SHM_V + v_st(s & 63, cc)) = o; }
    if (cva) cv_finish(cv0, ci0, (LAS float*)(F.lds + SG_OST + wid * 9728), lane);
    __syncthreads();
    if (cvb) cv_finish(cv1, ci1, (LAS float*)(F.lds + SG_OST + wid * 9728), lane);
    bf16* GU = WSP(A, bf16, WS_GU); const bf16* SGB = WSP(A, bf16, WS_SGB);
    v4u gul[8], sbl[8];
#pragma unroll
    for (int q = 0; q < 4; ++q) { const int hf = q >> 2, i = q & 3, cid = lane + 64 * i, row = cid >> 3, c8 = (cid & 7) * 8, t = 32 * w4 + row;
        const size_t off = (size_t)(m0 + t) * 2048 + g * 128 + hf * 64 + c8;
        gul[q] = __builtin_nontemporal_load((const v4u*)(GU + off)); sbl[q] = __builtin_nontemporal_load((const v4u*)(SGB + off)); }
    const int vb0 = (int)(uintptr_t)(lds + SG_V) + v_rd_base(lane);
    f32x16 o[4] = {};
    if (grp == 0) pv_tile<0>(o, vb0, wf[0], wf[1], wf[2], wf[3]); else pv_tile<2>(o, vb0, wf[0], wf[1], wf[2], wf[3]);
    if (w4 >= 2) { if (grp == 0) pv_tile<1>(o, vb0, wf[4], wf[5], wf[6], wf[7]); else pv_tile<3>(o, vb0, wf[4], wf[5], wf[6], wf[7]); }
    float* ost = (float*)(lds + SG_OST + wid * 9728);
#pragma unroll
    for (int hf = 0; hf < 2; ++hf) {
#pragma unroll
        for (int r = 0; r < 16; ++r) { const int orow = crow(r, hi); ost[orow * 64 + r32] = o[2 * hf][r]; ost[orow * 64 + 32 + r32] = o[2 * hf + 1][r]; }
        asm volatile("s_waitcnt lgkmcnt(0)" ::: "memory");
        if (hf == 0) {
#pragma unroll
            for (int q = 4; q < 8; ++q) { const int i = q & 3, cid = lane + 64 * i, row = cid >> 3, c8 = (cid & 7) * 8, t = 32 * w4 + row;
                const size_t off = (size_t)(m0 + t) * 2048 + g * 128 + 64 + c8;
                gul[q] = __builtin_nontemporal_load((const v4u*)(GU + off)); sbl[q] = __builtin_nontemporal_load((const v4u*)(SGB + off)); }
        }
#pragma unroll
        for (int i = 0; i < 4; ++i) { const int cid = lane + 64 * i, row = cid >> 3, c8 = (cid & 7) * 8, t = 32 * w4 + row;
            const f32x4 a = *(const f32x4*)(ost + row * 64 + c8), cq = *(const f32x4*)(ost + row * 64 + c8 + 4);
            const float bs = IN_SGUB(A)[g * 128 + t];
            const size_t off = (size_t)(m0 + t) * 2048 + g * 128 + hf * 64 + c8;
            const v4u gu = gul[hf * 4 + i], sb = sbl[hf * 4 + i]; v4u w;
            w.x = pk2(bf_lo(gu.x) * (a[0] + bs) * bf_lo(sb.x), bf_hi(gu.x) * (a[1] + bs) * bf_hi(sb.x)); w.y = pk2(bf_lo(gu.y) * (a[2] + bs) * bf_lo(sb.y), bf_hi(gu.y) * (a[3] + bs) * bf_hi(sb.y));
            w.z = pk2(bf_lo(gu.z) * (cq[0] + bs) * bf_lo(sb.z), bf_hi(gu.z) * (cq[1] + bs) * bf_hi(sb.z)); w.w = pk2(bf_lo(gu.w) * (cq[2] + bs) * bf_lo(sb.w), bf_hi(gu.w) * (cq[3] + bs) * bf_hi(sb.w));
            pg8::st16_out(GU + off, w); }
        asm volatile("s_waitcnt lgkmcnt(0)" ::: "memory");
    }
    __syncthreads();
}
__device__ __forceinline__ void attn_mfma_phase(Frame& F, const Args& A, unsigned char* lds_generic) {
    char* lds = (char*)lds_generic;
    for (int item = F.vcu; item < 256; item += F.G) {
        const int bg = item >> 5, pi = item & 31, b = bg >> 2, g = bg & 3;
        { LAS float* BT = (LAS float*)(F.lds + att::L_BT); const float* src = WSP(A, float, WS_BTAB);
          if (F.tid < 512) BT[F.tid] = src[(F.tid >> 2) * 16 + g * 4 + (F.tid & 3)]; }
        const bf16* Qg = WSP(A, bf16, WS_Q2) + (size_t)bg * SEQ * 4 * 128; const bf16* Kg = WSP(A, bf16, WS_K2) + (size_t)bg * SEQ * 128; const bf16* Vg = WSP(A, bf16, WS_V2) + (size_t)bg * SEQ * 128;
        const unsigned long long* Lb = WSP(A, unsigned long long, WS_LM) + (size_t)b * 512 * 64 * 32;
        const int q1 = 63 - pi;
        att::BlockRef cur{Qg + (size_t)pi * 256 * 128, Kg, Vg, Lb + (size_t)pi * 8 * 64 * 32, pi, b * SEQ + pi * 64};
        const att::BlockRef r1{Qg + (size_t)q1 * 256 * 128, Kg, Vg, Lb + (size_t)q1 * 8 * 64 * 32, q1, b * SEQ + q1 * 64};
        for (int pass = 0; pass < 2; ++pass) {
            att::attn_block(cur, lds, g, WSP(A, bf16, WS_SGA), WSP(A, bf16, WS_GU), WSP(A, bf16, WS_MERGED));
            cur = r1;
        }
    }
}
#ifndef LATE_CONV
#define LATE_CONV 1
#endif
#ifndef SGU_MFMA
#define SGU_MFMA 1
#endif
#ifndef ATTN_MFMA
#define ATTN_MFMA 1
#endif
__global__ void __launch_bounds__(NWAVES * 64, 2) hybrid_fwd(const Args A) {
    extern __shared__ __attribute__((aligned(16))) unsigned char lds[];
    Frame F;
    F.lds = (LAS unsigned char*)lds;
    F.MISC = (volatile LAS unsigned*)(F.lds + MISC_OFF);
    F.tid = threadIdx.x; F.lane = F.tid & 63; F.wave = __builtin_amdgcn_readfirstlane(F.tid >> 6);
    F.G = gridDim.x; { const int bx = blockIdx.x; F.vcu = (F.G % 8 == 0) ? (bx % 8) * (F.G / 8) + bx / 8 : bx; }
    F.ctl = (gu32*)(A.ws + WS_CTL);
    for (int u = F.tid; u < (LDS_BYTES - LDSCTL_OFF) / 4; u += NWAVES * 64) ((LAS unsigned*)(F.lds + LDSCTL_OFF))[u] = 0u;
    __syncthreads();
    const int lo = A.ph_lo, hi = A.ph_hi;
    const bool one_launch = (hi - lo) > 1;
    XcdBarrier bar; bar.bar = (unsigned*)(F.ctl + CW_BAR); bar.x = 0; bar.st = nullptr;
    if (one_launch) bar = xcd_barrier_post((unsigned*)(F.ctl + CW_BAR), F.MISC + 8);
#define IN(k) (lo <= (k) && (k) < hi)
#define SEAM(k) do { if (IN(k) && IN((k) + 1)) xcd_barrier(bar); } while (0)

    if (IN(0)) { p0_prologue(F, A, !LATE_CONV); } SEAM(0);

    if (IN(1)) {
        pg8::Gemm g{WSP(A, bf16, WS_XB), WSP(A, bf16, WS_WIN), MTOK, NP, DM}; pg8::StaticOrder S; S.init(MTOK, NP, F.G, (int)blockIdx.x);
        pg8::EpiProj E{WSP(A, float, WS_RS1), WSP(A, bf16, WS_Q2), WSP(A, bf16, WS_K2), WSP(A, bf16, WS_V2), WSP(A, bf16, WS_QI), WSP(A, bf16, WS_KI), WSP(A, bf16, WS_GU), WSP(A, bf16, WS_GV), WSP(A, bf16, WS_SGA), WSP(A, bf16, WS_SGB), WSP(A, float, WS_WI), WSP(A, float, WS_VST), QSCALE, IDX_SCALE};
        pg8::gemm_phase<pg8::EpiProj, pg8::StaticOrder, true, true>(F.lds, g, S, E);
    } SEAM(1);

    if (IN(2)) {
        const int w = F.vcu;
        IdxFrag fr; const int nun = (F.G == 256) ? 4 : (1024 - w + F.G - 1) / F.G;
#define UNIT_B(i) ((F.G == 256) ? ((i) >> 1) : ((w + (i) * F.G) >> 9))
#define UNIT_U(i) ((F.G == 256) ? (((i) & 1) ? w : 511 - w) : ((w + (i) * F.G) & 511))
        if (UNIT_U(0) >= 32) idx_load_frag(fr, F, A, UNIT_B(0), 8 * UNIT_U(0));
        const int gwv = F.vcu * NWAVES + F.wave, NGWV = F.G * NWAVES;
        for (int i = 0; i < nun; ++i) idx_unit(fr, F, A, UNIT_B(i), UNIT_U(i), i + 1 < nun ? UNIT_B(i + 1) : 0, i + 1 < nun ? UNIT_U(i + 1) : -1, LATE_CONV ? gwv + i * NGWV : -1);
#undef UNIT_B
#undef UNIT_U
    }
#if SGU_MFMA
    if (IN(3)) { const int gwv = F.vcu * NWAVES + F.wave, NGWV = F.G * NWAVES, nun = (F.G == 256) ? 4 : (1024 - F.vcu + F.G - 1) / F.G; int k = 0;
        for (int i = F.vcu; i < 512; i += F.G, ++k) sgu_pair_unit(F, A, lds, i >> 8, (i >> 3) & 31, i & 7, LATE_CONV ? gwv + (nun + 2 * k) * NGWV : -1);
        if (LATE_CONV) { for (int it = gwv + (nun + 2 * k) * NGWV; it < CV_I_LATE; it += NGWV) { const CvItem ci = cv_item_late(A, it); float v[32]; cv_issue(v, ci, F.lane); cv_finish(v, ci, (LAS float*)(F.lds + F.wave * 16384), F.lane); } }
    } SEAM(3);
#else
    if (IN(3)) { for (int i = F.vcu; i < 1024; i += F.G) sgu_unit(F, A, i >> 9, (i >> 4) & 31, i & 15); } SEAM(3);
#endif

#if ATTN_MFMA
    if (IN(4)) { attn_mfma_phase(F, A, lds); } SEAM(4);
#else
    if (IN(4)) { attn_gather_phase(F, A); } SEAM(4);
#endif

    if (IN(5)) {
        pg8::Gemm g{WSP(A, bf16, WS_MERGED), WSP(A, bf16, WS_WOUT), MTOK, DM, DM}; pg8::StaticOrder S; S.init(MTOK, DM, F.G, (int)blockIdx.x);
        if (one_launch && F.G == 256) {
            pg8::EpiRes<true, false> E{IN_X(A), (A).out, WSP(A, bf16, WS_H2), WSP(A, float, WS_SSQ2)};
            pg8::gemm_phase<pg8::EpiRes<true, false>, pg8::StaticOrder, true, true>(F.lds, g, S, E);
        } else {
            pg8::EpiRes<true, true> E{IN_X(A), (A).out, WSP(A, bf16, WS_H2), WSP(A, float, WS_SSQ2)};
            pg8::gemm_phase<pg8::EpiRes<true, true>, pg8::StaticOrder, true, true>(F.lds, g, S, E);
        }
    } SEAM(5);

    if (IN(6)) {
        pg8::Gemm g{WSP(A, bf16, WS_H2), WSP(A, bf16, WS_W1), MTOK, DFF, DM}; pg8::StaticOrder S; S.init(MTOK, DFF, F.G, (int)blockIdx.x);
        pg8::EpiFF1 E{WSP(A, float, WS_SSQ2), WSP(A, bf16, WS_FF), EPS};
        pg8::gemm_phase<pg8::EpiFF1, pg8::StaticOrder, true, true>(F.lds, g, S, E);
    } SEAM(6);

    if (IN(7)) {
        pg8::Gemm g{WSP(A, bf16, WS_FF), WSP(A, bf16, WS_W2), MTOK, DM, DFF}; pg8::StaticOrder S; S.init(MTOK, DM, F.G, (int)blockIdx.x);
        if (one_launch && F.G == 256) {
            struct Hook { const XcdBarrier* b; __device__ __forceinline__ void operator()() const { xcd_barrier(*b); } };
            pg8::EpiResNorm<Hook> E{WSP(A, bf16, WS_H2), (A).out, WSP(A, float, WS_SSQ3), IN_FING(A), EPS, Hook{&bar}};
            pg8::gemm_phase<pg8::EpiResNorm<Hook>, pg8::StaticOrder, false, true>(F.lds, g, S, E);
        } else {
            pg8::EpiRes<false, true> E{(A).out, (A).out, nullptr, WSP(A, float, WS_SSQ3)};
            pg8::gemm_phase<pg8::EpiRes<false, true>, pg8::StaticOrder, true, true>(F.lds, g, S, E);
        }
    }
    if (!(one_launch && F.G == 256)) { SEAM(7); if (IN(8)) { final_norm_phase(F, A); } }
    if (IN(9) || IN(10)) { const int w = F.vcu, md = IN(10) ? 1 : 0; for (int i = 0; i < 4; ++i) idx_unit_probe(F, A, i >> 1, (i & 1) ? 511 - w : w, md); }
#undef IN
#undef SEAM
}

#ifndef MK_N_LAUNCHES
#define MK_N_LAUNCHES 1
#endif
constexpr int N_PHASES = 9;
#ifndef PROBE_DUP
#define PROBE_DUP (-1)
#endif
#ifndef PROBE_TAIL
#define PROBE_TAIL (-1)
#endif
extern "C" void kernel_launch(void* const* d_in, const int* in_sizes, int n_in, void* d_out, int out_size, void* d_ws, size_t ws_size, hipStream_t stream) {
    static int grid = 0;
    if (grid == 0) {
        if (n_in != 13 || in_sizes[0] != MTOK * DM || out_size != MTOK * DM || ws_size < WS_END) {
            fprintf(stderr, "kernel_launch: shape/workspace mismatch (n_in %d, in0 %d, out %d, ws %zu, need %zu); nothing launched\n", n_in, n_in > 0 ? in_sizes[0] : -1, out_size, ws_size, (size_t)WS_END); grid = -1; return; }
        int dev = 0, cus = 0, per_cu = 0;
        if (hipGetDevice(&dev) != hipSuccess || hipDeviceGetAttribute(&cus, hipDeviceAttributeMultiprocessorCount, dev) != hipSuccess) { fprintf(stderr, "kernel_launch: device query failed\n"); grid = -1; return; }
        if (hipFuncSetAttribute((const void*)hybrid_fwd, hipFuncAttributeMaxDynamicSharedMemorySize, LDS_BYTES) != hipSuccess) { fprintf(stderr, "kernel_launch: hipFuncSetAttribute failed\n"); grid = -1; return; }
        if (hipOccupancyMaxActiveBlocksPerMultiprocessor(&per_cu, (const void*)hybrid_fwd, NWAVES * 64, LDS_BYTES) != hipSuccess || per_cu < 1) { fprintf(stderr, "kernel_launch: occupancy query says %d blocks per CU\n", per_cu); }
        (void)hipGetLastError();
        grid = cus;
        fprintf(stderr, "kernel_launch: grid %d, occupancy %d, ws %zu\n", grid, per_cu, ws_size);
    }
    if (grid < 0) return;
    (void)hipMemsetAsync((char*)d_ws + WS_CTL, 0, CTL_ZERO_BYTES, stream);
    Args a{};
    for (int i = 0; i < 13; ++i) a.in[i] = (const float*)d_in[i];
    a.out = (float*)d_out; a.ws = (unsigned char*)d_ws;
    if (MK_N_LAUNCHES == 1) { a.ph_lo = 0; a.ph_hi = N_PHASES; hipLaunchKernelGGL(hybrid_fwd, dim3(grid), dim3(NWAVES * 64), LDS_BYTES, stream, a); }
    else { for (int p = 0; p < N_PHASES; ++p) { a.ph_lo = p; a.ph_hi = p + 1; for (int r = 0; r < (p == PROBE_DUP ? 2 : 1); ++r) hipLaunchKernelGGL(hybrid_fwd, dim3(grid), dim3(NWAVES * 64), LDS_BYTES, stream, a); }
           if (PROBE_DUP >= 9) { a.ph_lo = PROBE_DUP; a.ph_hi = PROBE_DUP + 1; hipLaunchKernelGGL(hybrid_fwd, dim3(grid), dim3(NWAVES * 64), LDS_BYTES, stream, a); }
           if (PROBE_TAIL >= 0) { a.ph_lo = PROBE_TAIL; a.ph_hi = PROBE_TAIL + 1; hipLaunchKernelGGL(hybrid_fwd, dim3(grid), dim3(NWAVES * 64), LDS_BYTES, stream, a); } }
}
```

```cpp
#include <hip/hip_runtime.h>
#include <hip/hip_bf16.h>
#include <cstdio>
#include <cstdint>
namespace pg8 {
#define PG8_LAS __attribute__((address_space(3)))
typedef unsigned short bf16_t;
typedef short bf16x8 __attribute__((ext_vector_type(8)));
typedef float f32x4 __attribute__((ext_vector_type(4)));
typedef unsigned u32x4 __attribute__((ext_vector_type(4)));
constexpr int BM = 256, BK = 64, HALF = 128, HTB = HALF * BK * 2  , STAGE_BYTES = 8 * HTB, NXCD = 8, WGM = 8;

__host__ __device__ __forceinline__ int lds_byte(int r, int c) { const int st = (r >> 4) * 2 + (c >> 5), rr = r & 15, cc = c & 31, ob = rr * 64 + cc * 2; return st * 1024 + (ob ^ (((ob >> 9) & 1) << 5)); }
__host__ __device__ __forceinline__ void stage_rc(int b, int& R, int& C) { const int st = b / 1024, sb = b % 1024, swz = sb ^ (((sb >> 9) & 1) << 5); R = (st >> 1) * 16 + swz / 64; C = (st & 1) * 32 + (swz % 64) / 2; }
__host__ __device__ __forceinline__ int perm32(int rho) { const int n = rho >> 4, i = rho & 15; return 8 * (i >> 2) + 4 * n + (i & 3); }

struct Unit { int pm, pn; };
struct Gemm { const bf16_t* A; const bf16_t* Bt; int M, N, K; };

struct StaticOrder {
    int nM, nN, nwg, G, c;
    __host__ __device__ void init(int M, int N, int G_, int c_) { nM = M / BM; nN = N / BM; nwg = nM * nN; G = G_; c = c_; }
    __host__ __device__ bool next(int i, Unit& u) const {
        const long L = (long)i * G + c; if (L >= nwg) return false;
        int wgid = (int)L; { const int q = nwg / NXCD, r = nwg % NXCD, xcd = wgid % NXCD, off = wgid / NXCD; wgid = (xcd < r ? xcd * (q + 1) : r * (q + 1) + (xcd - r) * q) + off; }
        const int nig = WGM * nN, gid = wgid / nig, fm = gid * WGM, gsz = (nM - fm) < WGM ? (nM - fm) : WGM;
        u.pm = fm + ((wgid % nig) % gsz); u.pn = (wgid % nig) / gsz; return true;
    }
    __device__ __forceinline__ void a_ready(const Unit&) const {}
    __device__ __forceinline__ void done(const Unit&) const {}
};

__device__ __forceinline__ unsigned cvt_pk_bf16(float lo, float hi) { unsigned r; asm volatile("v_cvt_pk_bf16_f32 %0, %1, %2" : "=v"(r) : "v"(lo), "v"(hi)); return r; }
typedef float f32x2 __attribute__((ext_vector_type(2)));
constexpr float LOG2E_F = 1.4426950408889634f;
__device__ __forceinline__ float gelu_tanh(float x) {
    const float u = x * (1.0f + 0.044715f * x * x);
    const float e = __builtin_amdgcn_exp2f(u * (-2.0f * 0.7978845608028654f * LOG2E_F));
    return x * __builtin_amdgcn_rcpf(1.0f + e);
}
__device__ __forceinline__ float sigmoid_f(float x) { return __builtin_amdgcn_rcpf(1.0f + __builtin_amdgcn_exp2f(-x * LOG2E_F)); }
__device__ __forceinline__ f32x2 gelu2(f32x2 x) {
    const f32x2 t = (x * x) * 0.044715f + 1.0f, u = (x * t) * (-2.0f * 0.7978845608028654f * LOG2E_F);
    f32x2 e; e.x = __builtin_amdgcn_exp2f(u.x); e.y = __builtin_amdgcn_exp2f(u.y); e = e + 1.0f;
    f32x2 r; r.x = __builtin_amdgcn_rcpf(e.x); r.y = __builtin_amdgcn_rcpf(e.y); return x * r;
}
__device__ __forceinline__ f32x2 sigmoid2(f32x2 x) {
    const f32x2 u = x * (-LOG2E_F); f32x2 e; e.x = __builtin_amdgcn_exp2f(u.x); e.y = __builtin_amdgcn_exp2f(u.y); e = e + 1.0f;
    f32x2 r; r.x = __builtin_amdgcn_rcpf(e.x); r.y = __builtin_amdgcn_rcpf(e.y); return r;
}
__device__ __forceinline__ void gelu4(f32x4& v) { const f32x2 a = gelu2((f32x2){v[0], v[1]}), b = gelu2((f32x2){v[2], v[3]}); v = (f32x4){a.x, a.y, b.x, b.y}; }
__device__ __forceinline__ void sigmoid4(f32x4& v) { const f32x2 a = sigmoid2((f32x2){v[0], v[1]}), b = sigmoid2((f32x2){v[2], v[3]}); v = (f32x4){a.x, a.y, b.x, b.y}; }
#ifndef WT_STORES
#define WT_STORES 0
#endif
__device__ __forceinline__ void st16_out(void* p, u32x4 w) {
#if WT_STORES
    asm volatile("global_store_dwordx4 %0, %1, off sc1\n\ts_nop 1" :: "v"(p), "v"(w) : "memory");
#else
    *(u32x4*)p = w;
#endif
}
__device__ __forceinline__ void st_bf16x8(bf16_t* p, f32x4 v0, f32x4 v1) { u32x4 w; w.x = cvt_pk_bf16(v0[0], v0[1]); w.y = cvt_pk_bf16(v0[2], v0[3]); w.z = cvt_pk_bf16(v1[0], v1[1]); w.w = cvt_pk_bf16(v1[2], v1[3]); st16_out(p, w); }
__device__ __forceinline__ void st_bf16x8_nt(bf16_t* p, f32x4 v0, f32x4 v1) { u32x4 w; w.x = cvt_pk_bf16(v0[0], v0[1]); w.y = cvt_pk_bf16(v0[2], v0[3]); w.z = cvt_pk_bf16(v1[0], v1[1]); w.w = cvt_pk_bf16(v1[2], v1[3]); __builtin_nontemporal_store(w, (u32x4*)p); }
__device__ __forceinline__ float hsum8(f32x4 a, f32x4 b) { return ((a[0] + a[1]) + (a[2] + a[3])) + ((b[0] + b[1]) + (b[2] + b[3])); }
__device__ __forceinline__ float hsq8(f32x4 a, f32x4 b) { return ((a[0] * a[0] + a[1] * a[1]) + (a[2] * a[2] + a[3] * a[3])) + ((b[0] * b[0] + b[1] * b[1]) + (b[2] * b[2] + b[3] * b[3])); }

__host__ __device__ __forceinline__ int proj_logical_tile(int pn) { const int g = pn >> 2, w = pn & 3; return (g % 3 == 2) ? (g / 3) * 4 + w : 15 + (g - g / 3) * 4 + w; }
struct EpiProj {
    static constexpr bool PERM = true, AFTER_DRAIN = false;
    const float* rs1; bf16_t *Q2, *K2, *V2, *QI, *KI, *GU, *GV, *SGA, *SGB; float* WI; float* VST; float qscale, iscale;
    __device__ __forceinline__ void operator()(const f32x4 (&acc)[2][2][4][2], const Unit& u, int wr, int wc, int fr, int fq) const {
        const int pn = proj_logical_tile(u.pn), row0 = u.pm * BM + wr * 64 + fr, cl0 = wc * 32 + 8 * fq;
#pragma unroll
        for (int ai = 0; ai < 2; ++ai)
#pragma unroll
            for (int m = 0; m < 4; ++m) {
                const int r = row0 + ai * HALF + m * 16; const int b = r >> 12, t = r & 4095;
                float ssum = 0.f, ssq = 0.f;
#pragma unroll
                for (int bj = 0; bj < 2; ++bj) {
                    f32x4 v0 = acc[ai][bj][m][0], v1 = acc[ai][bj][m][1];
                    if (pn < 8) { const int head = 2 * pn + bj, g = head >> 2, h = head & 3; v0 = v0 * qscale; v1 = v1 * qscale;
                        st_bf16x8_nt(Q2 + ((((size_t)(b * 4 + g) * 4096 + t) * 4 + h) * 128 + cl0), v0, v1); }
                    else if (pn < 10) { const int g = 2 * (pn - 8) + bj; st_bf16x8_nt(K2 + (((size_t)(b * 4 + g) * 4096 + t) * 128 + cl0), v0, v1); }
                    else if (pn < 12) { const int g = 2 * (pn - 10) + bj; st_bf16x8_nt(V2 + (((size_t)(b * 4 + g) * 4096 + t) * 128 + cl0), v0, v1); }
                    else if (pn < 14) { st_bf16x8(QI + ((size_t)r * 512 + 256 * (pn - 12) + 128 * bj + cl0), v0, v1); }
                    else if (pn == 14) { const int cl = 128 * bj + cl0;
                        if (cl < 64) st_bf16x8(KI + ((size_t)r * 64 + cl), v0, v1);
                        else if (cl == 64) { *(f32x4*)(WI + (size_t)r * 8) = v0 * iscale; *(f32x4*)(WI + (size_t)r * 8 + 4) = v1 * iscale; } }
                    else if (pn < 23) { gelu4(v0); gelu4(v1);
                        st_bf16x8(GU + ((size_t)r * 2048 + 256 * (pn - 15) + 128 * bj + cl0), v0, v1); }
                    else if (pn < 31) { gelu4(v0); gelu4(v1);
                        ssum += hsum8(v0, v1); ssq += hsq8(v0, v1);
                        st_bf16x8(GV + ((size_t)r * 2048 + 256 * (pn - 23) + 128 * bj + cl0), v0, v1); }
                    else if (pn < 39) { sigmoid4(v0); sigmoid4(v1);
                        st_bf16x8_nt(SGA + ((size_t)r * 2048 + 256 * (pn - 31) + 128 * bj + cl0), v0, v1); }
                    else { sigmoid4(v0); sigmoid4(v1);
                        st_bf16x8(SGB + ((size_t)r * 2048 + 256 * (pn - 39) + 128 * bj + cl0), v0, v1); }
                }
                if (pn >= 23 && pn < 31) {
                    ssum += __shfl_xor(ssum, 16); ssum += __shfl_xor(ssum, 32); ssq += __shfl_xor(ssq, 16); ssq += __shfl_xor(ssq, 32);
                    if (fq == 0) { f32x2 o = {ssum, ssq}; *(f32x2*)(VST + ((size_t)r * 32 + (pn - 23) * 4 + wc) * 2) = o; }
                }
            }
    }
};
template <bool H2, bool F32OUT, bool RESBF = false> struct EpiRes {
    static constexpr bool PERM = true, AFTER_DRAIN = false;
    const void* res; float* out; bf16_t* h2; float* ssq;
    __device__ __forceinline__ void operator()(const f32x4 (&acc)[2][2][4][2], const Unit& u, int wr, int wc, int fr, int fq) const {
        const int row0 = u.pm * BM + wr * 64 + fr, c00 = u.pn * BM + wc * 32 + 8 * fq;
#pragma unroll
        for (int ai = 0; ai < 2; ++ai)
#pragma unroll
            for (int m = 0; m < 4; ++m) {
                const int r = row0 + ai * HALF + m * 16; float q = 0.f;
#pragma unroll
                for (int bj = 0; bj < 2; ++bj) { const size_t off = (size_t)r * 2048 + c00 + 128 * bj; f32x4 r0, r1;
                    if (RESBF) { const u32x4 rw = *(const u32x4*)((const bf16_t*)res + off);
                        r0 = (f32x4){__uint_as_float(rw.x << 16), __uint_as_float(rw.x & 0xffff0000u), __uint_as_float(rw.y << 16), __uint_as_float(rw.y & 0xffff0000u)};
                        r1 = (f32x4){__uint_as_float(rw.z << 16), __uint_as_float(rw.z & 0xffff0000u), __uint_as_float(rw.w << 16), __uint_as_float(rw.w & 0xffff0000u)}; }
                    else { r0 = __builtin_nontemporal_load((const f32x4*)((const float*)res + off)); r1 = __builtin_nontemporal_load((const f32x4*)((const float*)res + off + 4)); }
                    const f32x4 v0 = acc[ai][bj][m][0] + r0, v1 = acc[ai][bj][m][1] + r1;
                    if (F32OUT) { *(f32x4*)(out + off) = v0; *(f32x4*)(out + off + 4) = v1; } q += hsq8(v0, v1);
                    if (H2) st_bf16x8(h2 + off, v0, v1); }
                q += __shfl_xor(q, 16); q += __shfl_xor(q, 32);
                if (fq == 0) ssq[(size_t)r * 32 + u.pn * 4 + wc] = q;
            }
    }
};
struct EpiFF1 {
    static constexpr bool PERM = true, AFTER_DRAIN = false;
    const float* ssq2; bf16_t* FF; float eps;
    __device__ __forceinline__ void operator()(const f32x4 (&acc)[2][2][4][2], const Unit& u, int wr, int wc, int fr, int fq) const {
        const int row0 = u.pm * BM + wr * 64 + fr, c00 = u.pn * BM + wc * 32 + 8 * fq;
#pragma unroll
        for (int ai = 0; ai < 2; ++ai)
#pragma unroll
            for (int m = 0; m < 4; ++m) {
                const int r = row0 + ai * HALF + m * 16;
                float s = hsum8(*(const f32x4*)(ssq2 + (size_t)r * 32 + 8 * fq), *(const f32x4*)(ssq2 + (size_t)r * 32 + 8 * fq + 4));
                s += __shfl_xor(s, 16); s += __shfl_xor(s, 32);
                const float rs = __builtin_amdgcn_rsqf(s * (1.0f / 2048.0f) + eps);
#pragma unroll
                for (int bj = 0; bj < 2; ++bj) { f32x4 v0 = acc[ai][bj][m][0] * rs, v1 = acc[ai][bj][m][1] * rs;
                    for (int e = 0; e < 4; ++e) { const float a = fmaxf(v0[e], 0.f), c = fmaxf(v1[e], 0.f); v0[e] = a * a; v1[e] = c * c; }
                    st_bf16x8(FF + ((size_t)r * 8192 + c00 + 128 * bj), v0, v1); }
            }
    }
};

template <class Hook> struct EpiResNorm {
    static constexpr bool PERM = true, AFTER_DRAIN = true;
    const bf16_t* res; float* out; float* ssq; const float* gain; float eps; Hook hook;
    __device__ __forceinline__ void fused(f32x4 (&acc)[2][2][4][2], const Unit& u, int wr, int wc, int fr, int fq, PG8_LAS unsigned char* lds, int wid, int lane) const {
        const int row0 = u.pm * BM + wr * 64 + fr, c00 = u.pn * BM + wc * 32 + 8 * fq;
#pragma unroll
        for (int ai = 0; ai < 2; ++ai)
#pragma unroll
            for (int m = 0; m < 4; ++m) {
                const int r = row0 + ai * HALF + m * 16; float q = 0.f;
#pragma unroll
                for (int bj = 0; bj < 2; ++bj) { const size_t off = (size_t)r * 2048 + c00 + 128 * bj;
                    const u32x4 rw = __builtin_nontemporal_load((const u32x4*)(res + off));
                    acc[ai][bj][m][0] += (f32x4){__uint_as_float(rw.x << 16), __uint_as_float(rw.x & 0xffff0000u), __uint_as_float(rw.y << 16), __uint_as_float(rw.y & 0xffff0000u)};
                    acc[ai][bj][m][1] += (f32x4){__uint_as_float(rw.z << 16), __uint_as_float(rw.z & 0xffff0000u), __uint_as_float(rw.w << 16), __uint_as_float(rw.w & 0xffff0000u)};
                    q += hsq8(acc[ai][bj][m][0], acc[ai][bj][m][1]); }
                q += __shfl_xor(q, 16); q += __shfl_xor(q, 32);
                if (fq == 0) ssq[(size_t)r * 32 + u.pn * 4 + wc] = q;
            }
        hook();
        f32x4 g0[2], g1[2];
#pragma unroll
        for (int bj = 0; bj < 2; ++bj) { g0[bj] = *(const f32x4*)(gain + c00 + 128 * bj); g1[bj] = *(const f32x4*)(gain + c00 + 128 * bj + 4); }
#pragma unroll
        for (int ai = 0; ai < 2; ++ai)
#pragma unroll
            for (int m = 0; m < 4; ++m) {
                const int r = row0 + ai * HALF + m * 16;
                float s = hsum8(*(const f32x4*)(ssq + (size_t)r * 32 + 8 * fq), *(const f32x4*)(ssq + (size_t)r * 32 + 8 * fq + 4));
                s += __shfl_xor(s, 16); s += __shfl_xor(s, 32);
                const float rs = 1.0f / sqrtf(s * (1.0f / 2048.0f) + eps);
#pragma unroll
                for (int bj = 0; bj < 2; ++bj) { const size_t off = (size_t)r * 2048 + c00 + 128 * bj;
                    *(f32x4*)(out + off) = acc[ai][bj][m][0] * rs * g0[bj]; *(f32x4*)(out + off + 4) = acc[ai][bj][m][1] * rs * g1[bj]; }
            }
    }
};
template <class Epi, class Sched, bool ALIGN_EPI = false, bool SP2 = false>
__device__ __forceinline__ void gemm_phase(PG8_LAS unsigned char* lds, const Gemm g, const Sched& S, const Epi& E) {
    const int tid = threadIdx.x, wid = __builtin_amdgcn_readfirstlane(tid >> 6), lane = tid & 63, wr = wid >> 2, wc = wid & 3, fr = lane & 15, fq = lane >> 4;
    const int K = g.K, nt = K / BK;
    unsigned voffA[2], voffB[2];
#pragma unroll
    for (int i = 0; i < 2; ++i) { int R, C; stage_rc(tid * 16 + i * 8192, R, C); const int Rb = Epi::PERM ? ((R & ~31) + perm32(R & 31)) : R;
        voffA[i] = (unsigned)(R * K + C) * 2u; voffB[i] = (unsigned)(Rb * K + C) * 2u; }
    const size_t kstep = (size_t)(BK * 2);
    const size_t hstep = (size_t)HALF * K * 2;
    const size_t tstep = 2 * hstep;
    const unsigned ldsw = (unsigned)wid * 1024u;
    const int aoff = lds_byte(wr * 64 + fr, fq * 8), boff = lds_byte(wc * 32 + fr, fq * 8);
#define PG8_SA(b, h) (((b) * 2 + (h)) * HTB)
#define PG8_SB(b, h) ((4 + (b) * 2 + (h)) * HTB)
#define PG8_STAGE(bufoff, gbase, voff) do { _Pragma("unroll") for (int _i = 0; _i < 2; ++_i) \
        __builtin_amdgcn_global_load_lds((const unsigned*)((const char*)(gbase) + (voff)[_i]), (PG8_LAS unsigned*)(lds + (bufoff) + ldsw + _i * 8192), 16, 0, 0); } while (0)
#define PG8_LDA(dst, b, h) do { _Pragma("unroll") for (int m = 0; m < 4; ++m) _Pragma("unroll") for (int k = 0; k < 2; ++k) dst[m][k] = *(const PG8_LAS bf16x8*)(lds + PG8_SA(b, h) + aoff + m * 2048 + k * 1024); } while (0)
#define PG8_LDB(dst, b, h) do { _Pragma("unroll") for (int n = 0; n < 2; ++n) _Pragma("unroll") for (int k = 0; k < 2; ++k) dst[n][k] = *(const PG8_LAS bf16x8*)(lds + PG8_SB(b, h) + boff + n * 2048 + k * 1024); } while (0)
#define PG8_MMA(ai, bj, At, Bt) do { __builtin_amdgcn_s_setprio(1); _Pragma("unroll") for (int m = 0; m < 4; ++m) _Pragma("unroll") for (int n = 0; n < 2; ++n) _Pragma("unroll") for (int k = 0; k < 2; ++k) \
        acc[ai][bj][m][n] = __builtin_amdgcn_mfma_f32_16x16x32_bf16(Bt[n][k], At[m][k], acc[ai][bj][m][n], 0, 0, 0); __builtin_amdgcn_s_setprio(0); } while (0)
#define PG8_WAIT_V(n) asm volatile("s_waitcnt vmcnt(" #n ")" ::: "memory")
#define PG8_WAIT_L(n) asm volatile("s_waitcnt lgkmcnt(" #n ")" ::: "memory")
#define PG8_BAR __builtin_amdgcn_s_barrier()
#define PG8_SCHED __builtin_amdgcn_sched_barrier(0)
    Unit cur, nxt; int ui = 0;
    if (!S.next(0, cur)) return;
    f32x4 acc[2][2][4][2];
#pragma unroll
    for (int a = 0; a < 2; ++a)
#pragma unroll
        for (int b = 0; b < 2; ++b)
#pragma unroll
            for (int m = 0; m < 4; ++m)
#pragma unroll
                for (int n = 0; n < 2; ++n) acc[a][b][m][n] = (f32x4){0.f, 0.f, 0.f, 0.f};
    bf16x8 At[4][2], B0[2][2], B1[2][2];
    const char* cA = (const char*)g.A + (size_t)cur.pm * tstep; const char* cB = (const char*)g.Bt + (size_t)cur.pn * tstep;
    S.a_ready(cur);
    if constexpr (SP2) {
        PG8_STAGE(PG8_SB(0, 0), cB, voffB); PG8_STAGE(PG8_SB(0, 1), cB + hstep, voffB); PG8_STAGE(PG8_SA(0, 0), cA, voffA); PG8_STAGE(PG8_SA(0, 1), cA + hstep, voffA);
        if (wr == 1) PG8_BAR;
        PG8_WAIT_V(2); PG8_BAR;
        PG8_STAGE(PG8_SB(1, 0), cB + kstep, voffB); PG8_STAGE(PG8_SA(1, 0), cA + kstep, voffA); PG8_STAGE(PG8_SB(1, 1), cB + hstep + kstep, voffB);
        PG8_WAIT_V(6); PG8_BAR;
    } else {
        PG8_STAGE(PG8_SB(0, 0), cB, voffB); PG8_STAGE(PG8_SA(0, 0), cA, voffA); PG8_STAGE(PG8_SB(0, 1), cB + hstep, voffB); PG8_STAGE(PG8_SA(0, 1), cA + hstep, voffA);
        if (wr == 1) PG8_BAR;
        PG8_WAIT_V(4); PG8_BAR;
        PG8_STAGE(PG8_SB(1, 0), cB + kstep, voffB); PG8_STAGE(PG8_SA(1, 0), cA + kstep, voffA); PG8_STAGE(PG8_SB(1, 1), cB + hstep + kstep, voffB);
        PG8_WAIT_V(6); PG8_BAR;
    }
    for (;;) {
        const bool has_next = S.next(ui + 1, nxt);
        const char* nA = has_next ? (const char*)g.A + (size_t)nxt.pm * tstep : cA; const char* nB = has_next ? (const char*)g.Bt + (size_t)nxt.pn * tstep : cB;
        for (int t = 0; t < nt; t += 2) {
            const bool last = (t == nt - 2);
            const char* a1 = cA + (size_t)(t + 1) * kstep;
            const char* a2 = last ? nA : cA + (size_t)(t + 2) * kstep; const char* b2 = last ? nB : cB + (size_t)(t + 2) * kstep;
            const char* a3 = a2 + kstep; const char* b3 = b2 + kstep;
            if (last && has_next) S.a_ready(nxt);
            if constexpr (SP2) {
            PG8_LDB(B0, 0, 0); PG8_LDB(B1, 0, 1); PG8_SCHED; PG8_LDA(At, 0, 0); PG8_STAGE(PG8_SA(1, 1), a1 + hstep, voffA);
            PG8_WAIT_V(8); PG8_WAIT_L(0); PG8_BAR; PG8_MMA(0, 0, At, B0); PG8_MMA(0, 1, At, B1); PG8_BAR; PG8_SCHED;
            PG8_LDA(At, 0, 1); PG8_STAGE(PG8_SB(0, 0), b2, voffB); PG8_STAGE(PG8_SB(0, 1), b2 + hstep, voffB); PG8_STAGE(PG8_SA(0, 0), a2, voffA);
            PG8_WAIT_V(8); PG8_WAIT_L(0); PG8_BAR; PG8_MMA(1, 0, At, B0); PG8_MMA(1, 1, At, B1); PG8_BAR; PG8_SCHED;
            PG8_LDB(B0, 1, 0); PG8_LDB(B1, 1, 1); PG8_SCHED; PG8_LDA(At, 1, 0); PG8_STAGE(PG8_SA(0, 1), a2 + hstep, voffA);
            PG8_WAIT_V(8); PG8_WAIT_L(0); PG8_BAR; PG8_MMA(0, 0, At, B0); PG8_MMA(0, 1, At, B1); PG8_BAR; PG8_SCHED;
            PG8_LDA(At, 1, 1); PG8_STAGE(PG8_SB(1, 0), b3, voffB); PG8_STAGE(PG8_SB(1, 1), b3 + hstep, voffB); PG8_STAGE(PG8_SA(1, 0), a3, voffA);
            PG8_WAIT_V(8); PG8_WAIT_L(0); PG8_BAR; PG8_MMA(1, 0, At, B0); PG8_MMA(1, 1, At, B1); PG8_BAR; PG8_SCHED;
            } else {
            PG8_LDB(B0, 0, 0); PG8_SCHED; PG8_LDA(At, 0, 0); PG8_STAGE(PG8_SA(1, 1), a1 + hstep, voffA);
            PG8_WAIT_L(8); PG8_BAR; PG8_WAIT_L(0); PG8_MMA(0, 0, At, B0); PG8_BAR; PG8_SCHED;
            PG8_LDB(B1, 0, 1); PG8_STAGE(PG8_SB(0, 0), b2, voffB);
            PG8_BAR; PG8_WAIT_L(0); PG8_MMA(0, 1, At, B1); PG8_BAR;
            PG8_LDA(At, 0, 1); PG8_STAGE(PG8_SA(0, 0), a2, voffA);
            PG8_BAR; PG8_WAIT_L(0); PG8_MMA(1, 0, At, B0); PG8_BAR; PG8_SCHED;
            PG8_STAGE(PG8_SB(0, 1), b2 + hstep, voffB);
            PG8_WAIT_V(6); PG8_BAR; PG8_MMA(1, 1, At, B1); PG8_BAR;
            PG8_LDB(B0, 1, 0); PG8_SCHED; PG8_LDA(At, 1, 0); PG8_STAGE(PG8_SA(0, 1), a2 + hstep, voffA);
            PG8_WAIT_L(8); PG8_BAR; PG8_WAIT_L(0); PG8_MMA(0, 0, At, B0); PG8_BAR; PG8_SCHED;
            PG8_LDB(B1, 1, 1); PG8_STAGE(PG8_SB(1, 0), b3, voffB);
            PG8_BAR; PG8_WAIT_L(0); PG8_MMA(0, 1, At, B1); PG8_BAR;
            PG8_LDA(At, 1, 1); PG8_STAGE(PG8_SA(1, 0), a3, voffA);
            PG8_BAR; PG8_WAIT_L(0); PG8_MMA(1, 0, At, B0); PG8_BAR; PG8_SCHED;
            PG8_STAGE(PG8_SB(1, 1), b3 + hstep, voffB);
            PG8_WAIT_V(6); PG8_BAR; PG8_MMA(1, 1, At, B1); PG8_BAR;
            }
        }
        if constexpr (ALIGN_EPI) { if (wr == 0) PG8_BAR; }
        if constexpr (!Epi::AFTER_DRAIN) { E(acc, cur, wr, wc, fr, fq); S.done(cur); }
        if (!has_next) break;
#pragma unroll
        for (int a = 0; a < 2; ++a)
#pragma unroll
            for (int b = 0; b < 2; ++b)
#pragma unroll
                for (int m = 0; m < 4; ++m)
#pragma unroll
                    for (int n = 0; n < 2; ++n) acc[a][b][m][n] = (f32x4){0.f, 0.f, 0.f, 0.f};
        cur = nxt; cA = nA; cB = nB; ++ui;
        if constexpr (ALIGN_EPI) { if (wr == 1) PG8_BAR; }
    }
    PG8_WAIT_V(0);
    if constexpr (!ALIGN_EPI) { if (wr == 0) PG8_BAR; }
    PG8_BAR;
    if constexpr (Epi::AFTER_DRAIN) { E.fused(acc, cur, wr, wc, fr, fq, lds, wid, lane); S.done(cur); }
#undef PG8_SA
#undef PG8_SB
#undef PG8_STAGE
#undef PG8_LDA
#undef PG8_LDB
#undef PG8_MMA
#undef PG8_WAIT_V
#undef PG8_WAIT_L
#undef PG8_BAR
#undef PG8_SCHED
}
}
#ifndef ATTN_MFMA
#define ATTN_MFMA 1
#endif
constexpr int NWAVES = 8;
constexpr int BATCH = 2, SEQ = 4096, DM = 2048, MTOK = BATCH * SEQ;
constexpr int NH = 16, HD = 128, NKV = 4;
constexpr int IH = 8, ID = 64, TOPK = 256;
constexpr int DFF = 8192, DIN = 11848, NP = 12032;
constexpr float EPS = 1e-6f;
constexpr float QSCALE = 0.08838834764831845f * 1.4426950408889634f;
constexpr float IDX_SCALE = 0.35355339059327373f * 0.125f;

constexpr size_t MiB = 1u << 20;
constexpr size_t WS_CTL = 0, CTL_ZERO_BYTES = 64 * 1024;
constexpr size_t WS_RS1 = 1 * MiB;
constexpr size_t WS_BTAB = 1 * MiB + 64 * 1024;
constexpr size_t WS_WI = 1 * MiB + 256 * 1024;
constexpr size_t WS_WSB = 1 * MiB + 512 * 1024;
constexpr size_t WS_VST = 2 * MiB;
constexpr size_t WS_SSQ2 = 4 * MiB, WS_SSQ3 = 5 * MiB;
constexpr size_t WS_KI = 6 * MiB;
constexpr size_t WS_WIN = 8 * MiB;
constexpr size_t WS_WOUT = 56 * MiB;
constexpr size_t WS_W1 = 64 * MiB;
constexpr size_t WS_W2 = 96 * MiB;
constexpr size_t WS_XB = 128 * MiB;
constexpr size_t WS_MASK = 160 * MiB;
constexpr size_t WS_Q2 = 164 * MiB;
constexpr size_t WS_K2 = 196 * MiB, WS_V2 = 204 * MiB;
constexpr size_t WS_QI = 212 * MiB;
constexpr size_t WS_GU = 220 * MiB, WS_GV = 252 * MiB, WS_SGA = 284 * MiB, WS_SGB = 316 * MiB;
constexpr size_t WS_MERGED = WS_XB;
constexpr size_t WS_H2 = 164 * MiB;
constexpr size_t WS_FF = 196 * MiB;
constexpr size_t WS_LM = 348 * MiB;
constexpr size_t WS_END = 364 * MiB;
static_assert(WS_WIN + (size_t)NP * DM * 2 <= WS_WOUT && WS_FF + (size_t)MTOK * DFF * 2 <= WS_END, "d_ws map");
constexpr int CW_BAR = 1024;

constexpr int RING_BYTES = 147456;
constexpr int LDSCTL_OFF = RING_BYTES, MISC_OFF = LDSCTL_OFF + 320;
constexpr int LDS_BYTES = RING_BYTES + 1024;

#define GAS __attribute__((address_space(1)))
#define LAS __attribute__((address_space(3)))
typedef unsigned short bf16;
typedef unsigned v4u __attribute__((ext_vector_type(4)));
typedef float f32x4 __attribute__((ext_vector_type(4)));
typedef float f32x2 __attribute__((ext_vector_type(2)));
typedef float f32x16 __attribute__((ext_vector_type(16)));
typedef short bf16x8 __attribute__((ext_vector_type(8)));
typedef GAS unsigned gu32;
#define LDS_WAIT() asm volatile("s_waitcnt lgkmcnt(0)" ::: "memory")
#define VM_WAIT() asm volatile("s_waitcnt vmcnt(0)" ::: "memory")
__device__ __forceinline__ unsigned f2bf(float f) { unsigned u = __builtin_bit_cast(unsigned, f); return (u + 0x7fffu + ((u >> 16) & 1u)) >> 16; }
__device__ __forceinline__ unsigned pk2(float lo, float hi) { unsigned r; asm("v_cvt_pk_bf16_f32 %0, %1, %2" : "=v"(r) : "v"(lo), "v"(hi)); return r; }
__device__ __forceinline__ float bf_lo(unsigned w) { return __uint_as_float(w << 16); }
__device__ __forceinline__ float bf_hi(unsigned w) { return __uint_as_float(w & 0xffff0000u); }
#define XB_TMO      128
#define XB_XCNT(j)  (256  + 64 * (j))
#define XB_XSUB(j)  (1280 + 64 * (j))
#define XB_XGEN(j)  (2304 + 64 * (j))
#define XB_TOP      3328
#define XB_TOPGEN   3392
#define XCD_BAR_WORDS 3456
#define XB_SPIN_CAP (1u << 18)

__device__ __forceinline__ unsigned xb_ld(unsigned* p)              { return __hip_atomic_load(p, __ATOMIC_RELAXED, __HIP_MEMORY_SCOPE_AGENT); }
__device__ __forceinline__ unsigned xb_add(unsigned* p, unsigned v) { return __hip_atomic_fetch_add(p, v, __ATOMIC_RELAXED, __HIP_MEMORY_SCOPE_AGENT); }
__device__ __forceinline__ unsigned xb_xcc_id() { return (unsigned)__builtin_amdgcn_s_getreg((3 << 11) | 20) & 0xFu; }
#define XB_SPIN(cond, bar) do { unsigned _sp = 0; while (cond) { __builtin_amdgcn_s_sleep(1); \
    if ((++_sp & 255u) == 0u) { if (xb_ld(&(bar)[XB_TMO])) break; if (_sp > XB_SPIN_CAP) { atomicAdd(&(bar)[XB_TMO], 1u); break; } } } } while (0)

struct XcdBarrier {
    unsigned* bar; unsigned x;
    volatile LAS unsigned* st;
};

__device__ __forceinline__ XcdBarrier xcd_barrier_post(unsigned* bar, volatile LAS unsigned* st) {
    XcdBarrier b; b.bar = bar; b.x = xb_xcc_id(); b.st = st;
    if (threadIdx.x == 0) (void)xb_add(&bar[XB_XCNT(b.x)], 1u);
    return b;
}
__device__ __forceinline__ void xcd_barrier_complete(unsigned* bar, unsigned x, unsigned& nloc, unsigned& nx) {
    const unsigned G = gridDim.x * gridDim.y * gridDim.z;
    unsigned sum, cnt, mine, sp = 0u;
    for (;;) {
        sum = 0u; cnt = 0u; mine = 0u;
#pragma unroll
        for (unsigned j = 0; j < 16; ++j) { const unsigned c = xb_ld(&bar[XB_XCNT(j)]); sum += c; cnt += (c > 0u) ? 1u : 0u; mine = (j == x) ? c : mine; }
        if (sum == G) break;
        __builtin_amdgcn_s_sleep(1);
        if ((++sp & 255u) == 0u) { if (xb_ld(&bar[XB_TMO])) break; if (sp > XB_SPIN_CAP) { atomicAdd(&bar[XB_TMO], 1u); break; } }
    }
    nloc = mine > 0u ? mine : 1u; nx = cnt > 0u ? cnt : 1u;
}

__device__ __forceinline__ void xcd_barrier(const XcdBarrier& b) {
    asm volatile("s_waitcnt vmcnt(0)" ::: "memory");
    __syncthreads();
    if (threadIdx.x == 0) {
        unsigned* bar = b.bar;
        __builtin_amdgcn_s_waitcnt(0);
        unsigned nloc = b.st[0], nx = b.st[1];
        if (nloc == 0u) { xcd_barrier_complete(bar, b.x, nloc, nx); b.st[0] = nloc; b.st[1] = nx; }
        const unsigned old = xb_add(&bar[XB_XSUB(b.x)], 1u);
        const unsigned gen = old / nloc;
        if (old + 1u == (gen + 1u) * nloc) {
            __builtin_amdgcn_fence(__ATOMIC_RELEASE, "agent");
            asm volatile("s_waitcnt vmcnt(0)" ::: "memory");
            const unsigned og = xb_add(&bar[XB_TOP], 1u);
            const unsigned tg = og / nx;
            if (og + 1u == (tg + 1u) * nx) xb_add(&bar[XB_TOPGEN], 1u);
            else XB_SPIN(xb_ld(&bar[XB_TOPGEN]) == tg, bar);
            __builtin_amdgcn_fence(__ATOMIC_ACQUIRE, "agent");
            xb_add(&bar[XB_XGEN(b.x)], 1u);
            asm volatile("s_waitcnt vmcnt(0)" ::: "memory");
        } else {
            XB_SPIN(xb_ld(&bar[XB_XGEN(b.x)]) == gen, bar);
            __builtin_amdgcn_fence(__ATOMIC_ACQUIRE, "agent");
            asm volatile("s_waitcnt vmcnt(0)" ::: "memory");
        }
    }
    __syncthreads();
}
struct Args { const float* in[13]; float* out; unsigned char* ws; int ph_lo, ph_hi; };
struct Frame {
    LAS unsigned char* lds; volatile LAS unsigned* MISC; gu32* ctl;
    int tid, lane, wave, vcu, G;
};
#define IN_X(A) ((A).in[0])
#define IN_RELB(A) ((A).in[1])
#define IN_N1G(A) ((A).in[2])
#define IN_WIN(A) ((A).in[3])
#define IN_LNG(A) ((A).in[4])
#define IN_LNB(A) ((A).in[5])
#define IN_SGUW(A) ((A).in[6])
#define IN_SGUB(A) ((A).in[7])
#define IN_WOUT(A) ((A).in[8])
#define IN_N2G(A) ((A).in[9])
#define IN_W1(A) ((A).in[10])
#define IN_W2(A) ((A).in[11])
#define IN_FING(A) ((A).in[12])
#define WSP(A, T, off) ((T*)((A).ws + (off)))
__device__ __forceinline__ float wave_sum(float v) {
#pragma unroll
    for (int o = 1; o < 64; o <<= 1) v += __shfl_xor(v, o);
    return v;
}
__device__ __forceinline__ float wave_max(float v) {
#pragma unroll
    for (int o = 1; o < 64; o <<= 1) v = fmaxf(v, __shfl_xor(v, o));
    return v;
}
struct CvItem { const float* W; const float* gk; bf16* WT; int K, N, nrow0, src0, nvalid, k0; };
__device__ __forceinline__ void cv_issue(float (&v)[32], const CvItem& it, int lane) {
    const bool ok = (lane & 31) < it.nvalid; const float* wp = it.W + (size_t)(it.k0 + (lane >> 5)) * it.N + it.src0 + (lane & 31);
#pragma unroll
    for (int i = 0; i < 32; ++i) v[i] = ok ? __builtin_nontemporal_load(wp + (size_t)(2 * i) * it.N) : 0.f;
}
__device__ __forceinline__ void cv_finish(float (&v)[32], const CvItem& it, LAS float* scr, int lane) {
    if (it.gk) { const float* gp = it.gk + it.k0 + (lane >> 5);
#pragma unroll
        for (int i = 0; i < 32; ++i) v[i] *= gp[2 * i]; }
#pragma unroll
    for (int i = 0; i < 32; ++i) scr[(2 * i + (lane >> 5)) * 33 + (lane & 31)] = v[i];
    LDS_WAIT(); asm volatile("" ::: "memory");
    const int c = lane & 7;
#pragma unroll
    for (int j = 0; j < 4; ++j) { const int n = (lane >> 3) + 8 * j; const LAS float* s = scr + (8 * c) * 33 + n;
        v4u o; o.x = pk2(s[0 * 33], s[1 * 33]); o.y = pk2(s[2 * 33], s[3 * 33]); o.z = pk2(s[4 * 33], s[5 * 33]); o.w = pk2(s[6 * 33], s[7 * 33]);
        *(GAS v4u*)(it.WT + (size_t)(it.nrow0 + n) * it.K + it.k0 + 8 * c) = o; }
    LDS_WAIT(); asm volatile("" ::: "memory");
}
constexpr int CV_KB2 = DM / 64, CV_KB8 = DFF / 64;
constexpr int CV_I_IN = CV_KB2 * (NP / 32), CV_I_OUT = CV_KB2 * (DM / 32), CV_I_1 = CV_KB2 * (DFF / 32), CV_I_2 = CV_KB8 * (DM / 32), CV_I_LATE = CV_I_OUT + CV_I_1 + CV_I_2;
__device__ __forceinline__ CvItem cv_item_in(const Args& A, int r) {
    const int nb = r / CV_KB2, kb = r % CV_KB2, nphys = nb * 32, n0 = pg8::proj_logical_tile(nphys >> 8) * 256 + (nphys & 255); int src0, nvalid;
    if (n0 < 3584) { src0 = n0; nvalid = 32; }
    else if (n0 < 3840) { const int j0 = n0 - 3584; src0 = 3584 + j0; nvalid = 72 - j0; nvalid = nvalid < 0 ? 0 : (nvalid > 32 ? 32 : nvalid); }
    else { src0 = n0 - 3840 + 3656; nvalid = 32; }
    return CvItem{IN_WIN(A), IN_N1G(A), WSP(A, bf16, WS_WIN), DM, DIN, nphys, src0, nvalid, kb * 64};
}
__device__ __forceinline__ CvItem cv_item_late(const Args& A, int r) {
    if (r < CV_I_OUT) { const int nb = r / CV_KB2, kb = r % CV_KB2; return CvItem{IN_WOUT(A), nullptr, WSP(A, bf16, WS_WOUT), DM, DM, nb * 32, nb * 32, 32, kb * 64}; }
    r -= CV_I_OUT;
    if (r < CV_I_1) { const int nb = r / CV_KB2, kb = r % CV_KB2; return CvItem{IN_W1(A), IN_N2G(A), WSP(A, bf16, WS_W1), DM, DFF, nb * 32, nb * 32, 32, kb * 64}; }
    r -= CV_I_1;
    { const int nb = r / CV_KB8, kb = r % CV_KB8; return CvItem{IN_W2(A), nullptr, WSP(A, bf16, WS_W2), DFF, DM, nb * 32, nb * 32, 32, kb * 64}; }
}
__device__ __forceinline__ void p0_prologue(Frame& F, const Args& A, bool late_in_prologue) {
    LAS float* scr = (LAS float*)(F.lds + F.wave * 18432);
    const int gw = F.vcu * NWAVES + F.wave, NGW = F.G * NWAVES, lane = F.lane;
    const int nitems = late_in_prologue ? CV_I_IN + CV_I_LATE : CV_I_IN;
    for (int it = gw; it < nitems; it += 2 * NGW) {
        const CvItem c0 = it < CV_I_IN ? cv_item_in(A, it) : cv_item_late(A, it - CV_I_IN); const int it1 = it + NGW; const bool two = it1 < nitems;
        const CvItem c1 = it1 < CV_I_IN ? cv_item_in(A, it1) : cv_item_late(A, (two ? it1 : it) - CV_I_IN);
        float v0[32], v1[32]; cv_issue(v0, c0, lane); if (two) cv_issue(v1, c1, lane);
        cv_finish(v0, c0, scr, lane); if (two) cv_finish(v1, c1, scr + 2112, lane);
    }
    for (int i = (F.vcu * NWAVES * 64 + F.tid); i < 16 * 128 * 128 / 4; i += F.G * NWAVES * 64) { const int e = i * 4, t = (e >> 7) & 127, s0 = e & 127;
        const f32x4 v = *(const f32x4*)(IN_SGUW(A) + e);
        const unsigned lo = pk2(s0 <= t ? v[0] : 0.f, s0 + 1 <= t ? v[1] : 0.f), hi2 = pk2(s0 + 2 <= t ? v[2] : 0.f, s0 + 3 <= t ? v[3] : 0.f);
        *(unsigned long long*)(WSP(A, bf16, WS_WSB) + e) = (unsigned long long)lo | ((unsigned long long)hi2 << 32); }
    for (int m = gw; m < MTOK; m += NGW) {
        const GAS f32x4* xr = (const GAS f32x4*)(IN_X(A) + (size_t)m * DM) + lane; f32x4 v[8]; float ss = 0.f;
#pragma unroll
        for (int j = 0; j < 8; ++j) { v[j] = __builtin_nontemporal_load(xr + 64 * j); ss += (v[j].x * v[j].x + v[j].y * v[j].y) + (v[j].z * v[j].z + v[j].w * v[j].w); }
        ss = wave_sum(ss);
        const float rs = 1.0f / sqrtf(ss * (1.0f / DM) + EPS);
        GAS unsigned long long* o8 = (GAS unsigned long long*)(WSP(A, bf16, WS_XB) + (size_t)m * DM) + lane;
#pragma unroll
        for (int j = 0; j < 8; ++j) o8[64 * j] = (unsigned long long)pk2(v[j].x * rs, v[j].y * rs) | ((unsigned long long)pk2(v[j].z * rs, v[j].w * rs) << 32);
    }
    if (blockIdx.x == 0) {
        for (int i = F.tid; i < 128 * 16; i += NWAVES * 64) { const int n = i >> 4, h = i & 15; int bk;
            if (n < 16) bk = n; else { bk = 16 + (int)(logf((float)n / 16.0f) / 2.0794415416798357f * 16.0f); bk = bk > 31 ? 31 : bk; }
            WSP(A, float, WS_BTAB)[i] = (IN_RELB(A)[bk * 16 + h] - IN_RELB(A)[31 * 16 + h]) * 1.4426950408889634f; }
    }
}
__device__ __forceinline__ unsigned fkey(float f) { const unsigned u = __float_as_uint(f); return (u & 0x80000000u) ? ~u : (u | 0x80000000u); }
__device__ __forceinline__ int mbcnt64(unsigned long long m) { return __builtin_amdgcn_mbcnt_hi((unsigned)(m >> 32), __builtin_amdgcn_mbcnt_lo((unsigned)m, 0u)); }
__device__ __forceinline__ int wave_sum_i(int x) {
    x += __builtin_amdgcn_update_dpp(0, x, 0xB1, 0xF, 0xF, true);
    x += __builtin_amdgcn_update_dpp(0, x, 0x4E, 0xF, 0xF, true);
    x += __builtin_amdgcn_update_dpp(0, x, 0x141, 0xF, 0xF, true);
    x += __builtin_amdgcn_update_dpp(0, x, 0x140, 0xF, 0xF, true);
    return __builtin_amdgcn_readlane(x, 0) + __builtin_amdgcn_readlane(x, 16) + __builtin_amdgcn_readlane(x, 32) + __builtin_amdgcn_readlane(x, 48);
}
template <int NJ> __device__ __forceinline__ unsigned long long select_query(const LAS unsigned* sk, int lane) {
    unsigned v[NJ];
#pragma unroll
    for (int j = 0; j < NJ; ++j) v[j] = sk[lane + 64 * j];
    unsigned prefix = 0u; bool exact = false;
    for (int bit = 31; bit >= 0; --bit) {
        const unsigned cand = __builtin_amdgcn_readfirstlane(prefix | (1u << bit)); int c0 = 0, c1 = 0, c2 = 0, c3 = 0;
#define CNT_GE8(j0) asm volatile( \
            "v_cmp_le_u32_e32 vcc, %4, %5\n\tv_addc_co_u32_e32 %0, vcc, 0, %0, vcc\n\tv_cmp_le_u32_e32 vcc, %4, %6\n\tv_addc_co_u32_e32 %1, vcc, 0, %1, vcc\n\t" \
            "v_cmp_le_u32_e32 vcc, %4, %7\n\tv_addc_co_u32_e32 %2, vcc, 0, %2, vcc\n\tv_cmp_le_u32_e32 vcc, %4, %8\n\tv_addc_co_u32_e32 %3, vcc, 0, %3, vcc\n\t" \
            "v_cmp_le_u32_e32 vcc, %4, %9\n\tv_addc_co_u32_e32 %0, vcc, 0, %0, vcc\n\tv_cmp_le_u32_e32 vcc, %4, %10\n\tv_addc_co_u32_e32 %1, vcc, 0, %1, vcc\n\t" \
            "v_cmp_le_u32_e32 vcc, %4, %11\n\tv_addc_co_u32_e32 %2, vcc, 0, %2, vcc\n\tv_cmp_le_u32_e32 vcc, %4, %12\n\tv_addc_co_u32_e32 %3, vcc, 0, %3, vcc" \
            : "+v"(c0), "+v"(c1), "+v"(c2), "+v"(c3) : "s"(cand), "v"(v[j0]), "v"(v[j0 + 1]), "v"(v[j0 + 2]), "v"(v[j0 + 3]), "v"(v[j0 + 4]), "v"(v[j0 + 5]), "v"(v[j0 + 6]), "v"(v[j0 + 7]) : "vcc")
#pragma unroll
        for (int j = 0; j < NJ; j += 8) CNT_GE8(j);
#undef CNT_GE8
        const int c = wave_sum_i((c0 + c1) + (c2 + c3));
        if (c >= TOPK) { prefix = cand; if (c == TOPK) { exact = true; break; } }
    }
    unsigned mlo = 0u, mhi = 0u;
    if (exact) {
#pragma unroll
        for (int j = 0; j < NJ; ++j) { const unsigned long long bsel = __ballot(v[j] >= prefix); if (lane == j) { mlo = (unsigned)bsel; mhi = (unsigned)(bsel >> 32); } asm volatile("" : "+v"(mlo), "+v"(mhi)); }
    } else {
        int g0 = 0, g1 = 0; const unsigned pfx = __builtin_amdgcn_readfirstlane(prefix);
#define CNT_GT(acc, val) asm volatile("v_cmp_lt_u32_e32 vcc, %1, %2\n\tv_addc_co_u32_e32 %0, vcc, 0, %0, vcc" : "+v"(acc) : "s"(pfx), "v"(val) : "vcc")
#pragma unroll
        for (int j = 0; j < NJ; j += 2) { CNT_GT(g0, v[j]); CNT_GT(g1, v[j + 1]); }
#undef CNT_GT
        int rem = TOPK - wave_sum_i(g0 + g1);
#pragma unroll
        for (int j = 0; j < NJ; ++j) { const unsigned long long eq = __ballot(v[j] == prefix);
            const bool take = (v[j] > prefix) || ((v[j] == prefix) && (mbcnt64(eq) < rem));
            const unsigned long long bsel = __ballot(take); rem -= __builtin_popcountll(eq); rem = rem < 0 ? 0 : rem;
            if (lane == j) { mlo = (unsigned)bsel; mhi = (unsigned)(bsel >> 32); } asm volatile("" : "+v"(mlo), "+v"(mhi)); }
    }
    return (unsigned long long)mlo | ((unsigned long long)mhi << 32);
}
struct IdxFrag { bf16x8 qa[2][4]; float w[2][2][8]; };
__device__ __forceinline__ void idx_load_frag_q(IdxFrag& f, Frame& F, const Args& A, int b, int t0) {
    const int lane = F.lane, rho = lane & 31, half = lane >> 5, blk = rho >> 2;
    const int q4 = (blk >> 2) + 2 * (blk & 1), hd = (rho & 3) + 4 * ((blk >> 1) & 1);
#pragma unroll
    for (int R = 0; R < 2; ++R)
#pragma unroll
        for (int ks = 0; ks < 4; ++ks) f.qa[R][ks] = *(const bf16x8*)(WSP(A, bf16, WS_QI) + ((size_t)(b * SEQ + t0 + 4 * R + q4) * 512 + hd * 64 + ks * 16 + half * 8));
}
__device__ __forceinline__ void idx_load_frag_w(IdxFrag& f, Frame& F, const Args& A, int b, int t0) {
    const int half = F.lane >> 5;
#pragma unroll
    for (int R = 0; R < 2; ++R)
#pragma unroll
        for (int lq = 0; lq < 2; ++lq) { const float* wp = WSP(A, float, WS_WI) + (size_t)(b * SEQ + t0 + 4 * R + 2 * half + lq) * 8; const f32x4 a = *(const f32x4*)wp, c = *(const f32x4*)(wp + 4);
            f.w[R][lq][0] = a[0]; f.w[R][lq][1] = a[1]; f.w[R][lq][2] = a[2]; f.w[R][lq][3] = a[3]; f.w[R][lq][4] = c[0]; f.w[R][lq][5] = c[1]; f.w[R][lq][6] = c[2]; f.w[R][lq][7] = c[3]; }
}
__device__ __forceinline__ void idx_load_frag(IdxFrag& f, Frame& F, const Args& A, int b, int t0) { idx_load_frag_q(f, F, A, b, t0); idx_load_frag_w(f, F, A, b, t0); }
__device__ __forceinline__ float relu1(float x) { const int i = __builtin_bit_cast(int, x); return __builtin_bit_cast(float, i > 0 ? i : 0); }
__device__ __forceinline__ void idx_scores(const IdxFrag& f, Frame& F, const Args& A, int b, int t0, int stride) {
    LAS unsigned* SK = (LAS unsigned*)F.lds;
    const int lane = F.lane, rho = lane & 31, half = lane >> 5;
    const int ntv = (t0 + 8 + 31) >> 5, nta = stride >> 5;
    const bf16* kbase = WSP(A, bf16, WS_KI) + (size_t)(b * SEQ + rho) * 64 + half * 8;
#define KLOAD(dst, kt_) do { const int kc_ = (kt_) < ntv ? (kt_) : ntv - 1; _Pragma("unroll") for (int ks = 0; ks < 4; ++ks) dst[ks] = *(const bf16x8*)(kbase + (size_t)kc_ * 32 * 64 + ks * 16); } while (0)
#define KMMA(a0, a1, kb_) do { _Pragma("unroll") for (int ks = 0; ks < 4; ++ks) { a0 = __builtin_amdgcn_mfma_f32_32x32x16_bf16(f.qa[0][ks], kb_[ks], a0, 0, 0, 0); a1 = __builtin_amdgcn_mfma_f32_32x32x16_bf16(f.qa[1][ks], kb_[ks], a1, 0, 0, 0); } } while (0)
#define KOUT(a0, a1, kt_) do { if ((kt_) < ntv) { const int key = (kt_) * 32 + rho; \
        _Pragma("unroll") for (int R = 0; R < 2; ++R) _Pragma("unroll") for (int lq = 0; lq < 2; ++lq) { float s = 0.f; \
            _Pragma("unroll") for (int h = 0; h < 8; ++h) s = fmaf(f.w[R][lq][h], relu1(R == 0 ? a0[lq * 8 + h] : a1[lq * 8 + h]), s); \
            const int ql = 4 * R + 2 * half + lq; SK[ql * stride + key] = (key <= t0 + ql) ? fkey(s) : 0u; } } } while (0)
    bf16x8 kA[4], kB[4], nA[4], nB[4];
    KLOAD(kA, F.wave); KLOAD(kB, F.wave + NWAVES);
    for (int kt = F.wave; kt < ntv; kt += 2 * NWAVES) {
        KLOAD(nA, kt + 2 * NWAVES); KLOAD(nB, kt + 3 * NWAVES);
        f32x16 a0 = {}, a1 = {}, c0 = {}, c1 = {};
        KMMA(a0, a1, kA); KMMA(c0, c1, kB);
        KOUT(a0, a1, kt); KOUT(c0, c1, kt + NWAVES);
#pragma unroll
        for (int ks = 0; ks < 4; ++ks) { kA[ks] = nA[ks]; kB[ks] = nB[ks]; }
    }
#undef KLOAD
#undef KMMA
#undef KOUT
    for (int kt = ntv + F.wave; kt < nta; kt += NWAVES) {
        const int key = kt * 32 + rho;
#pragma unroll
        for (int q = 0; q < 4; ++q) SK[(2 * half + (q & 1) + 4 * (q >> 1)) * stride + key] = 0u;
    }
}
constexpr int LM_OFF = 131072;
__device__ __forceinline__ void idx_unit(IdxFrag& fr, Frame& F, const Args& A, int b, int u, int nb_, int nu, int cvi) {
    const int t0 = 8 * u, lane = F.lane, t = t0 + F.wave;
    LAS unsigned long long* LM = (LAS unsigned long long*)(F.lds + LM_OFF);
    { LAS v4u* z = (LAS v4u*)(F.lds + LM_OFF); z[F.tid] = (v4u){0u, 0u, 0u, 0u}; z[F.tid + 512] = (v4u){0u, 0u, 0u, 0u}; }
    unsigned long long word; float cv0[32], cv1[32]; const int cvj = cvi + F.G * NWAVES;
    const bool cva = cvi >= 0 && cvi < CV_I_LATE, cvb = false && cvj < CV_I_LATE; const CvItem ci0 = cv_item_late(A, cva ? cvi : 0), ci1 = cv_item_late(A, cvb ? cvj : 0);
    if (t0 + 8 <= TOPK) {
        const int nb = t + 1 - 64 * lane; word = nb >= 64 ? ~0ull : (nb > 0 ? ((1ull << nb) - 1ull) : 0ull);
        if (nu >= 32) idx_load_frag_q(fr, F, A, nb_, 8 * nu);
        if (cva) cv_issue(cv0, ci0, lane); if (cvb) cv_issue(cv1, ci1, lane);
        __syncthreads();
    } else {
        const int njc = (t0 + 8 + 511) >> 9, stride = njc * 512;
        idx_scores(fr, F, A, b, t0, stride);
        __syncthreads();
        if (nu >= 32) idx_load_frag_q(fr, F, A, nb_, 8 * nu);
        if (cva) cv_issue(cv0, ci0, lane); if (cvb) cv_issue(cv1, ci1, lane);
        const LAS unsigned* sk = (const LAS unsigned*)F.lds + F.wave * stride;
        switch (njc) {
            case 1: word = select_query<8>(sk, lane); break;
            case 2: word = select_query<16>(sk, lane); break;
            case 3: word = select_query<24>(sk, lane); break;
            case 4: word = select_query<32>(sk, lane); break;
            case 5: word = select_query<40>(sk, lane); break;
            case 6: word = select_query<48>(sk, lane); break;
            case 7: word = select_query<56>(sk, lane); break;
            default: word = select_query<64>(sk, lane); break;
        }
    }
#if !ATTN_MFMA
    WSP(A, unsigned long long, WS_MASK)[(size_t)(b * SEQ + t) * 64 + lane] = word;
#endif
    const int jmax = (t0 + 7) >> 6;
    if (lane <= jmax) {
        const int sh = 4 * F.wave;
#pragma unroll
        for (int rp = 0; rp < 32; ++rp) { const int c = 32 * (rp >> 4) + (rp & 3) + 8 * ((rp & 15) >> 2);
            const unsigned long long v = (((word >> c) & 1ull) ? (0xFull << sh) : 0ull) | (((word >> (c + 4)) & 1ull) ? (0xFull << (32 + sh)) : 0ull);
            __hip_atomic_fetch_or(&LM[rp * 64 + lane], v, __ATOMIC_RELAXED, __HIP_MEMORY_SCOPE_WORKGROUP); }
    }
    __syncthreads();
    if (cva) cv_finish(cv0, ci0, (LAS float*)(F.lds + F.wave * 16384), lane);
    if (cvb) cv_finish(cv1, ci1, (LAS float*)(F.lds + F.wave * 16384) + 2112, lane);
    if (nu >= 32) idx_load_frag_w(fr, F, A, nb_, 8 * nu);
    { const int j = F.tid >> 3;
      if (j <= jmax) { const int rp0 = 4 * (F.tid & 7); const unsigned long long w0 = LM[rp0 * 64 + j], w1 = LM[(rp0 + 1) * 64 + j], w2 = LM[(rp0 + 2) * 64 + j], w3 = LM[(rp0 + 3) * 64 + j];
          v4u* d = (v4u*)(WSP(A, unsigned long long, WS_LM) + ((size_t)(b * 512 + u) * 64) * 32) + F.tid * 2;
          d[0] = (v4u){(unsigned)w0, (unsigned)(w0 >> 32), (unsigned)w1, (unsigned)(w1 >> 32)}; d[1] = (v4u){(unsigned)w2, (unsigned)(w2 >> 32), (unsigned)w3, (unsigned)(w3 >> 32)}; } }
    __syncthreads();
}
__device__ __forceinline__ void idx_unit_probe(Frame& F, const Args& A, int b, int u, int mode) {
    const int t0 = 8 * u, lane = F.lane;
    if (t0 + 8 <= TOPK) return;
    const int njc = (t0 + 8 + 511) >> 9, stride = njc * 512;
    IdxFrag fr; idx_load_frag(fr, F, A, b, t0); idx_scores(fr, F, A, b, t0, stride);
    __syncthreads();
    if (mode == 1) {
        const LAS unsigned* sk = (const LAS unsigned*)F.lds + F.wave * stride; unsigned long long word;
        switch (njc) {
            case 1: word = select_query<8>(sk, lane); break;
            case 2: word = select_query<16>(sk, lane); break;
            case 3: word = select_query<24>(sk, lane); break;
            case 4: word = select_query<32>(sk, lane); break;
            case 5: word = select_query<40>(sk, lane); break;
            case 6: word = select_query<48>(sk, lane); break;
            case 7: word = select_query<56>(sk, lane); break;
            default: word = select_query<64>(sk, lane); break;
        }
        if (word == 0x123456789abcdef1ull) WSP(A, unsigned long long, WS_MASK)[0] = word;
    }
    __syncthreads();
}
__device__ __forceinline__ void sgu_unit(Frame& F, const Args& A, int b, int c, int g) {
    LAS float* VN = (LAS float*)F.lds;
    LAS float* WT = (LAS float*)(F.lds + 65536);
    LAS float* ST = (LAS float*)(F.lds + 65536 + 66048);
    const int tid = F.tid, m0 = b * SEQ + c * 128, ch0 = g * 128;
    if (tid < 128) { const float* p = WSP(A, float, WS_VST) + (size_t)(m0 + tid) * 64; float s = 0.f, q = 0.f;
#pragma unroll
        for (int i = 0; i < 16; ++i) { const f32x4 v = *(const f32x4*)(p + 4 * i); s += v[0] + v[2]; q += v[1] + v[3]; }
        const float mean = s * (1.0f / 2048.0f), var = q * (1.0f / 2048.0f) - mean * mean;
        ST[2 * tid] = mean; ST[2 * tid + 1] = 1.0f / sqrtf(var + EPS); }
    { const float* Wg = IN_SGUW(A) + (size_t)g * 16384;
#pragma unroll
        for (int i = 0; i < 8; ++i) { const int idx = tid + 512 * i, t = idx >> 5, s0 = (idx & 31) * 4; const f32x4 v = *(const f32x4*)(Wg + t * 128 + s0);
#pragma unroll
            for (int e = 0; e < 4; ++e) WT[t * 129 + s0 + e] = (s0 + e <= t) ? v[e] : 0.f; } }
    __syncthreads();
#pragma unroll
    for (int i = 0; i < 4; ++i) { const int idx = tid + 512 * i, row = idx >> 4, cc = (idx & 15) * 8;
        const v4u raw = *(const v4u*)(WSP(A, bf16, WS_GV) + (size_t)(m0 + row) * 2048 + ch0 + cc);
        const float mean = ST[2 * row], rstd = ST[2 * row + 1];
        const f32x4 g0 = *(const f32x4*)(IN_LNG(A) + ch0 + cc), g1 = *(const f32x4*)(IN_LNG(A) + ch0 + cc + 4), b0 = *(const f32x4*)(IN_LNB(A) + ch0 + cc), b1 = *(const f32x4*)(IN_LNB(A) + ch0 + cc + 4);
        f32x4 o0, o1;
        o0[0] = (bf_lo(raw.x) - mean) * rstd * g0[0] + b0[0]; o0[1] = (bf_hi(raw.x) - mean) * rstd * g0[1] + b0[1];
        o0[2] = (bf_lo(raw.y) - mean) * rstd * g0[2] + b0[2]; o0[3] = (bf_hi(raw.y) - mean) * rstd * g0[3] + b0[3];
        o1[0] = (bf_lo(raw.z) - mean) * rstd * g1[0] + b1[0]; o1[1] = (bf_hi(raw.z) - mean) * rstd * g1[1] + b1[1];
        o1[2] = (bf_lo(raw.w) - mean) * rstd * g1[2] + b1[2]; o1[3] = (bf_hi(raw.w) - mean) * rstd * g1[3] + b1[3];
        *(LAS f32x4*)(VN + row * 128 + cc) = o0; *(LAS f32x4*)(VN + row * 128 + cc + 4) = o1; }
    __syncthreads();
    const int t = tid >> 2, dq = tid & 3, tmax = (F.wave * 16 + 15);
    f32x4 acc[8];
#pragma unroll
    for (int i = 0; i < 8; ++i) acc[i] = (f32x4){0.f, 0.f, 0.f, 0.f};
    for (int s = 0; s <= tmax; ++s) { const float w = WT[t * 129 + s];
#pragma unroll
        for (int i = 0; i < 8; ++i) acc[i] += w * *(const LAS f32x4*)(VN + s * 128 + dq * 32 + 4 * i); }
    const float bs = IN_SGUB(A)[g * 128 + t];
    const size_t off = (size_t)(m0 + t) * 2048 + ch0 + dq * 32;
#pragma unroll
    for (int i = 0; i < 4; ++i) { const v4u gu = *(const v4u*)(WSP(A, bf16, WS_GU) + off + 8 * i), sb = *(const v4u*)(WSP(A, bf16, WS_SGB) + off + 8 * i); const f32x4 a0 = acc[2 * i], a1 = acc[2 * i + 1]; v4u o;
        o.x = pk2(bf_lo(gu.x) * (a0[0] + bs) * bf_lo(sb.x), bf_hi(gu.x) * (a0[1] + bs) * bf_hi(sb.x));
        o.y = pk2(bf_lo(gu.y) * (a0[2] + bs) * bf_lo(sb.y), bf_hi(gu.y) * (a0[3] + bs) * bf_hi(sb.y));
        o.z = pk2(bf_lo(gu.z) * (a1[0] + bs) * bf_lo(sb.z), bf_hi(gu.z) * (a1[1] + bs) * bf_hi(sb.z));
        o.w = pk2(bf_lo(gu.w) * (a1[2] + bs) * bf_lo(sb.w), bf_hi(gu.w) * (a1[3] + bs) * bf_hi(sb.w));
        *(v4u*)(WSP(A, bf16, WS_GU) + off + 8 * i) = o; }
    __syncthreads();
}
__device__ __forceinline__ void attn_gather_phase(Frame& F, const Args& A) {
    asm volatile("; ATTN_BEGIN" ::: "memory");
    const int lane = F.lane, gw = F.vcu * NWAVES + F.wave, NGW = F.G * NWAVES;
    LAS unsigned char* wl = F.lds + F.wave * 8192;
    LAS unsigned short* IDX = (LAS unsigned short*)wl;
    LAS float* QF = (LAS float*)(wl + 512);
    LAS float* PB = (LAS float*)(wl + 2560);
    for (int task = gw; task < MTOK * 4; task += NGW) {
        const int m = task >> 2, g = task & 3, b = m >> 12, t = m & 4095;
        const unsigned long long word = WSP(A, unsigned long long, WS_MASK)[(size_t)m * 64 + lane];
        int cnt = 0;
        for (int j = 0; j <= (t >> 6); ++j) {
            const unsigned lo = __builtin_amdgcn_readlane((unsigned)word, j), hi = __builtin_amdgcn_readlane((unsigned)(word >> 32), j);
            const unsigned long long wj = ((unsigned long long)hi << 32) | lo;
            if ((wj >> lane) & 1ull) IDX[cnt + mbcnt64(wj)] = (unsigned short)(64 * j + lane);
            cnt += __builtin_popcountll(wj);
        }
        { const v4u raw = *(const v4u*)(WSP(A, bf16, WS_Q2) + (((size_t)(b * 4 + g) * SEQ + t) * 4) * 128 + lane * 8);
          f32x4 a = {bf_lo(raw.x), bf_hi(raw.x), bf_lo(raw.y), bf_hi(raw.y)}, c = {bf_lo(raw.z), bf_hi(raw.z), bf_lo(raw.w), bf_hi(raw.w)};
          *(LAS f32x4*)(QF + lane * 8) = a; *(LAS f32x4*)(QF + lane * 8 + 4) = c; }
        LDS_WAIT(); asm volatile("" ::: "memory");
        const bf16* Kg = WSP(A, bf16, WS_K2) + (size_t)(b * 4 + g) * SEQ * 128; const bf16* Vg = WSP(A, bf16, WS_V2) + (size_t)(b * 4 + g) * SEQ * 128;
        float mx[4] = {-3.0e38f, -3.0e38f, -3.0e38f, -3.0e38f};
        for (int i = 0; i < 4; ++i) { const int n = lane + 64 * i;
            if (n < cnt) { const int s = IDX[n]; const bf16* kr = Kg + (size_t)s * 128; float a4[4] = {0.f, 0.f, 0.f, 0.f};
                for (int dd = 0; dd < 16; ++dd) { const v4u kraw = *(const v4u*)(kr + dd * 8);
                    const float k8[8] = {bf_lo(kraw.x), bf_hi(kraw.x), bf_lo(kraw.y), bf_hi(kraw.y), bf_lo(kraw.z), bf_hi(kraw.z), bf_lo(kraw.w), bf_hi(kraw.w)};
#pragma unroll
                    for (int h = 0; h < 4; ++h) { const f32x4 q0 = *(const LAS f32x4*)(QF + h * 128 + dd * 8), q1 = *(const LAS f32x4*)(QF + h * 128 + dd * 8 + 4);
                        a4[h] += (q0[0] * k8[0] + q0[1] * k8[1]) + (q0[2] * k8[2] + q0[3] * k8[3]) + (q1[0] * k8[4] + q1[1] * k8[5]) + (q1[2] * k8[6] + q1[3] * k8[7]); } }
                const int dist = t - s; const float* bt = WSP(A, float, WS_BTAB) + (dist < 127 ? dist : 127) * 16 + g * 4;
#pragma unroll
                for (int h = 0; h < 4; ++h) { const float l = a4[h] + bt[h]; PB[h * 256 + n] = l; mx[h] = fmaxf(mx[h], l); } } }
        float li[4];
#pragma unroll
        for (int h = 0; h < 4; ++h) { mx[h] = wave_max(mx[h]); float sm = 0.f;
            for (int i = 0; i < 4; ++i) { const int n = lane + 64 * i; if (n < cnt) { const float p = __builtin_amdgcn_exp2f(PB[h * 256 + n] - mx[h]); PB[h * 256 + n] = p; sm += p; } }
            li[h] = 1.0f / wave_sum(sm); }
        LDS_WAIT(); asm volatile("" ::: "memory");
        float o[4][2] = {{0.f, 0.f}, {0.f, 0.f}, {0.f, 0.f}, {0.f, 0.f}};
        for (int n = 0; n < cnt; ++n) { const int s = IDX[n]; const unsigned vraw = *(const unsigned*)(Vg + (size_t)s * 128 + 2 * lane); const float v0 = bf_lo(vraw), v1 = bf_hi(vraw);
#pragma unroll
            for (int h = 0; h < 4; ++h) { const float p = PB[h * 256 + n]; o[h][0] += p * v0; o[h][1] += p * v1; } }
#pragma unroll
        for (int h = 0; h < 4; ++h) { const size_t off = (size_t)m * 2048 + (g * 4 + h) * 128 + 2 * lane;
            const unsigned ga = *(const unsigned*)(WSP(A, bf16, WS_SGA) + off), sp = *(const unsigned*)(WSP(A, bf16, WS_GU) + off);
            *(unsigned*)(WSP(A, bf16, WS_MERGED) + off) = pk2(bf_lo(ga) * (o[h][0] * li[h]) + bf_lo(sp), bf_hi(ga) * (o[h][1] * li[h]) + bf_hi(sp)); }
        LDS_WAIT(); asm volatile("" ::: "memory");
    }
    asm volatile("; ATTN_END" ::: "memory");
}
__device__ __forceinline__ void final_norm_phase(Frame& F, const Args& A) {
    const int lane = F.lane, gw = F.vcu * NWAVES + F.wave, NGW = F.G * NWAVES;
    for (int m = gw; m < MTOK; m += NGW) {
        float s = lane < 32 ? WSP(A, float, WS_SSQ3)[(size_t)m * 32 + lane] : 0.f; s = wave_sum(s);
        const float rs = 1.0f / sqrtf(s * (1.0f / DM) + EPS);
        GAS f32x4* xr = (GAS f32x4*)((A).out + (size_t)m * DM) + lane; const GAS f32x4* gr = (const GAS f32x4*)IN_FING(A) + lane;
#pragma unroll
        for (int j = 0; j < 8; ++j) { const f32x4 v = xr[64 * j], g = gr[64 * j]; xr[64 * j] = v * rs * g; }
    }
}
namespace att {
constexpr int D = 128, NW = 8, QBLK = 32, KVBLK = 64, QB = 256, SHM_V = 16384, SHM_K = 16384;
constexpr int NRING = 3;
constexpr int L_V = 0, L_K = NRING * SHM_V, L_WS = L_K + NRING * SHM_K, L_BT = L_WS + NW * 64 * 4, L_OST = L_BT + 2048, L_END = L_OST + NW * 4096;
constexpr int SG_V = 0, SG_WS = 65536, SG_OST = 69632;
constexpr float THR2 = 11.5f;
#define KSWZ(row, colB) ((row) * 256 + ((colB) ^ (((row) & 7) << 4)))
#define SBAR() __builtin_amdgcn_sched_barrier(0)
typedef short s16x4 __attribute__((ext_vector_type(4)));
__device__ __forceinline__ int v_st(int k, int c) { const int kk = (k & ~0xC) | ((k & 4) << 1) | ((k & 8) >> 1); return ((kk >> 3) * 4 + (c >> 5)) * 512 + ((kk & 7) * 32 + (c & 31)) * 2; }
__device__ __forceinline__ int v_rd_base(int lane) { return ((lane & 3) << 3) | (((lane >> 2) & 3) << 6) | (((lane >> 4) & 1) << 5) | (((lane >> 5) & 1) << 8); }
constexpr int v_rd_off(int d0, int ks, int half) { return d0 * 512 + ks * 4096 + half * 2048; }
__device__ __forceinline__ int crow(int r, int hi) { return (r & 3) + 8 * (r >> 2) + 4 * hi; }
__device__ __forceinline__ unsigned cvtpk(float lo, float hi) { unsigned r; asm volatile("v_cvt_pk_bf16_f32 %0, %1, %2" : "=v"(r) : "v"(lo), "v"(hi)); return r; }
typedef unsigned u32x16 __attribute__((ext_vector_type(16)));
template <int OFF> __device__ __forceinline__ u32x16 lm_load(const void* p) { u32x16 v; asm volatile("s_load_dwordx16 %0, %1, %2 glc" : "=&s"(v) : "s"(p), "i"(OFF)); return v; }
__device__ __forceinline__ void lm_wait(u32x16& a, u32x16& b) { asm volatile("s_waitcnt lgkmcnt(0)" : "+s"(a), "+s"(b)); }
__device__ __forceinline__ void lm_apply(f32x16& p, const u32x16& a, const u32x16& b, float neg) {
#pragma unroll
    for (int k = 0; k < 8; ++k) { const unsigned long long mk = (unsigned long long)a[2 * k] | ((unsigned long long)a[2 * k + 1] << 32);
        asm volatile("v_cndmask_b32_e64 %0, %1, %0, %2" : "+v"(p[k]) : "v"(neg), "s"(mk)); }
#pragma unroll
    for (int k = 0; k < 8; ++k) { const unsigned long long mk = (unsigned long long)b[2 * k] | ((unsigned long long)b[2 * k + 1] << 32);
        asm volatile("v_cndmask_b32_e64 %0, %1, %0, %2" : "+v"(p[8 + k]) : "v"(neg), "s"(mk)); }
}
__device__ __forceinline__ void band_bias(f32x16& p0, f32x16& p1, int dq, const LAS float* bt) {
#pragma unroll
    for (int r = 0; r < 16; ++r) { const int c = (r & 3) + 8 * (r >> 2); const unsigned d0 = (unsigned)(dq - c), d1 = (unsigned)(dq - c - 32);
        p0[r] += bt[(d0 < 127u ? d0 : 127u) * 4]; p1[r] += bt[(d1 < 127u ? d1 : 127u) * 4]; }
}
__device__ __forceinline__ float fadd_s(float x, float y) { float r; asm("v_add_f32_e32 %0, %1, %2" : "=v"(r) : "v"(x), "v"(y)); return r; }
__device__ __forceinline__ float fsub_s(float x, float y) { float r; asm("v_sub_f32_e32 %0, %1, %2" : "=v"(r) : "v"(x), "v"(y)); return r; }
__device__ __forceinline__ void partialSM(f32x16& p0, f32x16& p1, float& m_reg, float& mn, float& alpha) {
    float pmax = p0[0];
#pragma unroll
    for (int r = 1; r < 16; ++r) pmax = fmaxf(pmax, p0[r]);
#pragma unroll
    for (int r = 0; r < 16; ++r) pmax = fmaxf(pmax, p1[r]);
    { auto rr = __builtin_amdgcn_permlane32_swap(__float_as_uint(pmax), __float_as_uint(pmax), false, false);
      pmax = fmaxf(__uint_as_float(rr[0]), __uint_as_float(rr[1])); }
    if (__builtin_expect(__all((pmax - m_reg) <= THR2), 1)) { mn = m_reg; alpha = 1.f; }
    else { mn = fmaxf(m_reg, pmax); alpha = __builtin_amdgcn_exp2f(m_reg - mn); m_reg = mn; }
#pragma unroll
    for (int r = 0; r < 16; ++r) { p0[r] = fsub_s(p0[r], mn); p1[r] = fsub_s(p1[r], mn); }
#pragma unroll
    for (int r = 0; r < 16; ++r) p0[r] = __builtin_amdgcn_exp2f(p0[r]);
}
__device__ __forceinline__ void finishSM(f32x16& p0, f32x16& p1, float alpha, float& l_reg, bf16x8& pa0, bf16x8& pa1, bf16x8& pa2, bf16x8& pa3) {
#pragma unroll
    for (int r = 0; r < 16; ++r) p1[r] = __builtin_amdgcn_exp2f(p1[r]);
    float ps = fadd_s(p0[0], p0[1]), ps1 = fadd_s(p0[2], p0[3]), ps2 = fadd_s(p1[0], p1[1]), ps3 = fadd_s(p1[2], p1[3]);
#pragma unroll
    for (int r = 4; r < 16; r += 2) { ps = fadd_s(ps, p0[r]); ps1 = fadd_s(ps1, p0[r + 1]); ps2 = fadd_s(ps2, p1[r]); ps3 = fadd_s(ps3, p1[r + 1]); }
    ps = fadd_s(fadd_s(ps, ps1), fadd_s(ps2, ps3));
    { auto rr = __builtin_amdgcn_permlane32_swap(__float_as_uint(ps), __float_as_uint(ps), false, false);
      ps = __uint_as_float(rr[0]) + __uint_as_float(rr[1]); }
    l_reg = l_reg * alpha + ps;
#define PK4(P, B_, OUT) do { unsigned a0 = cvtpk(P[B_+0], P[B_+1]), a1 = cvtpk(P[B_+2], P[B_+3]);                          \
        unsigned b0 = cvtpk(P[B_+4], P[B_+5]), b1 = cvtpk(P[B_+6], P[B_+7]);                                             \
        auto r0 = __builtin_amdgcn_permlane32_swap(a0, b0, false, false); auto r1 = __builtin_amdgcn_permlane32_swap(a1, b1, false, false); \
        v4u w = {r0[0], r1[0], r0[1], r1[1]}; OUT = *reinterpret_cast<bf16x8*>(&w); } while (0)
    PK4(p0, 0, pa0); PK4(p0, 8, pa1); PK4(p1, 0, pa2); PK4(p1, 8, pa3);
#undef PK4
}
template <int KB>
__device__ __forceinline__ void qkt(f32x16& p0, f32x16& p1, const char* K_lds, int r32, int hi, const bf16x8* qr) {
    p0 = f32x16{}; p1 = f32x16{};
    const char* kb[4];
#pragma unroll
    for (int dd = 0; dd < 4; ++dd) kb[dd] = K_lds + KB * SHM_K + KSWZ(r32, (dd * 16 + hi * 8) * 2);
#pragma unroll
    for (int d0 = 0; d0 < 8; ++d0) { const char* a = kb[d0 & 3] + (d0 >> 2) * 128;
        bf16x8 b0 = *reinterpret_cast<const bf16x8*>(a);
        bf16x8 b1 = *reinterpret_cast<const bf16x8*>(a + 32 * 256);
        p0 = __builtin_amdgcn_mfma_f32_32x32x16_bf16(b0, qr[d0], p0, 0, 0, 0);
        p1 = __builtin_amdgcn_mfma_f32_32x32x16_bf16(b1, qr[d0], p1, 0, 0, 0); }
}
template <int VB>
__device__ __forceinline__ void pv_tile(f32x16* o, int vb0, bf16x8 pa0, bf16x8 pa1, bf16x8 pa2, bf16x8 pa3) {
#define TRRD(dst, off) asm volatile("ds_read_b64_tr_b16 %0, %1 offset:%2" : "=&v"(dst) : "v"(vb0), "i"(off) : "memory")
#define PV_D0(d0) do { s16x4 l0, l1, l2, l3, h0, h1, h2, h3; constexpr int b_ = VB * SHM_V + v_rd_off(d0, 0, 0); \
        TRRD(l0, b_); TRRD(h0, b_ + 2048); TRRD(l1, b_ + 4096); TRRD(h1, b_ + 6144); TRRD(l2, b_ + 8192); TRRD(h2, b_ + 10240); TRRD(l3, b_ + 12288); TRRD(h3, b_ + 14336); \
        asm volatile("s_waitcnt lgkmcnt(0)" ::: "memory"); SBAR();   \
        o[d0] = __builtin_amdgcn_mfma_f32_32x32x16_bf16(pa0, (bf16x8){l0[0], l0[1], l0[2], l0[3], h0[0], h0[1], h0[2], h0[3]}, o[d0], 0, 0, 0);   \
        o[d0] = __builtin_amdgcn_mfma_f32_32x32x16_bf16(pa1, (bf16x8){l1[0], l1[1], l1[2], l1[3], h1[0], h1[1], h1[2], h1[3]}, o[d0], 0, 0, 0);   \
        o[d0] = __builtin_amdgcn_mfma_f32_32x32x16_bf16(pa2, (bf16x8){l2[0], l2[1], l2[2], l2[3], h2[0], h2[1], h2[2], h2[3]}, o[d0], 0, 0, 0);   \
        o[d0] = __builtin_amdgcn_mfma_f32_32x32x16_bf16(pa3, (bf16x8){l3[0], l3[1], l3[2], l3[3], h3[0], h3[1], h3[2], h3[3]}, o[d0], 0, 0, 0); } while (0)
    PV_D0(0); PV_D0(1); PV_D0(2); PV_D0(3);
#undef PV_D0
#undef TRRD
}
struct BlockRef { const bf16* Q; const bf16* K; const bf16* V; const unsigned long long* LMB; int qb; int m0; };
__device__ __forceinline__ bf16x8 ld8(const bf16* p) { return *reinterpret_cast<const bf16x8*>(p); }
#define ROW(p, k0, rr) ((p) + (size_t)((k0) + (rr)) * D + sc)
#define VMW() asm volatile("s_waitcnt vmcnt(0)" ::: "memory")
#define SLOAD_H(Kp, Vp, k0) do { st_v0 = ld8(ROW(Vp, k0, sr)); st_v1 = ld8(ROW(Vp, k0, 32 + sr)); st_k0 = ld8(ROW(Kp, k0, sr)); st_k1 = ld8(ROW(Kp, k0, 32 + sr)); } while (0)
#define SWRITE_H(bf) do { *(bf16x8*)(V_lds + (bf) * SHM_V + vst0) = st_v0; *(bf16x8*)(V_lds + (bf) * SHM_V + vst1) = st_v1; \
                          *(bf16x8*)(K_lds + (bf) * SHM_K + kws) = st_k0; *(bf16x8*)(K_lds + (bf) * SHM_K + kws + 32 * 256) = st_k1; } while (0)
__device__ __forceinline__ void attn_block(const BlockRef& cur, char* lds, int g4, const bf16* SGA, const bf16* SP, bf16* MERGED) {
    const int tid = threadIdx.x, wid = __builtin_amdgcn_readfirstlane(tid >> 6), lane = tid & 63, r32 = lane & 31, hi = lane >> 5;
    const bool lag = wid >= 4;
    const int NT = cur.qb + 1;
    char* V_lds = lds + L_V; char* K_lds = lds + L_K;
    float* ws = (float*)(lds + L_WS) + wid * 64; float* li_l = ws, * al_l = ws + 32;
    const LAS float* bt = (const LAS float*)((LAS char*)(lds + L_BT)) + (r32 & 3);
    const int sr = tid >> 4, sc = (tid & 15) * 8, vst0 = v_st(sr, sc), vst1 = v_st(32 + sr, sc), kws = KSWZ(sr, sc * 2);
    const int vb0 = (int)(uintptr_t)V_lds + v_rd_base(lane);
    const bf16* Kh = cur.K; const bf16* Vh = cur.V;
    const char* lmw = (const char*)(cur.LMB + (size_t)wid * 64 * 32);
    const float NEGINF = -__builtin_inff();
    const int qpos = cur.qb * 64 + wid * 8 + (r32 >> 2);
    const int qlo = cur.qb * 64 + wid * 8;
    bf16x8 qr[8], st_v0, st_v1, st_k0, st_k1;
#pragma unroll
    for (int d0 = 0; d0 < 8; ++d0) qr[d0] = ld8(cur.Q + (size_t)(wid * QBLK + r32) * D + d0 * 16 + hi * 8);
    SLOAD_H(Kh, Vh, 0); VMW(); SWRITE_H(0);
    __syncthreads();
    float m_reg = -1e30f, l_reg = 0; f32x16 o[4] = {};
    bf16x8 pa0, pa1, pa2, pa3;
    u32x16 ma_ = lm_load<0>(lmw), mb_ = lm_load<64>(lmw), mc_ = lm_load<128>(lmw), md_ = lm_load<192>(lmw);
#define STEP(BUF, NBUF_, PBUF_, t) do {                                                                                       \
        if ((t) + 1 < NT) SLOAD_H(Kh, Vh, ((t) + 1) * KVBLK);                                                                 \
        SBAR(); if (lag && (t) > 0) { __builtin_amdgcn_s_setprio(1); pv_tile<PBUF_>(o, vb0, pa0, pa1, pa2, pa3); __builtin_amdgcn_s_setprio(0); } \
        SBAR(); f32x16 p0, p1; __builtin_amdgcn_s_setprio(1); qkt<BUF>(p0, p1, K_lds, r32, hi, qr); __builtin_amdgcn_s_setprio(0);     \
        asm volatile("s_nop 15\n\ts_nop 7" : "+v"(p0), "+v"(p1));     \
        lm_wait(ma_, mb_); lm_wait(mc_, md_); lm_apply(p0, ma_, mb_, NEGINF); lm_apply(p1, mc_, md_, NEGINF);                 \
        { const char* lmp_ = lmw + (size_t)((t) + 1 < NT ? (t) + 1 : (t)) * 256;     \
          ma_ = lm_load<0>(lmp_); mb_ = lm_load<64>(lmp_); mc_ = lm_load<128>(lmp_); md_ = lm_load<192>(lmp_); }                \
        if (qlo - ((t) * KVBLK + KVBLK - 1) < 113) band_bias(p0, p1, qpos - (t) * KVBLK - 4 * hi, bt);                        \
        float mn_, al_; partialSM(p0, p1, m_reg, mn_, al_);                                                                   \
        finishSM(p0, p1, al_, l_reg, pa0, pa1, pa2, pa3);                                                                     \
        if (__any(al_ < 1.f)) { if (hi == 0) al_l[r32] = al_; asm volatile("s_waitcnt lgkmcnt(0)" ::: "memory");              \
            for (int d_ = 0; d_ < 4; ++d_) for (int r = 0; r < 16; ++r) o[d_][r] *= al_l[crow(r, hi)]; }                      \
        SBAR(); if (!lag) { __builtin_amdgcn_s_setprio(1); pv_tile<BUF>(o, vb0, pa0, pa1, pa2, pa3); __builtin_amdgcn_s_setprio(0); } \
        SBAR(); if ((t) + 1 < NT) { VMW(); SWRITE_H(NBUF_); }                                                                 \
        __syncthreads(); } while (0)
    for (int t = 0; t < NT; t += 3) { STEP(0, 1, 2, t); if (t + 1 < NT) STEP(1, 2, 0, t + 1); if (t + 2 < NT) STEP(2, 0, 1, t + 2); }
#undef STEP
    if (lag) { const int lb = (NT - 1) % 3;
        if (lb == 0) pv_tile<0>(o, vb0, pa0, pa1, pa2, pa3); else if (lb == 1) pv_tile<1>(o, vb0, pa0, pa1, pa2, pa3); else pv_tile<2>(o, vb0, pa0, pa1, pa2, pa3); }
    if (hi == 0) li_l[r32] = l_reg; asm volatile("s_waitcnt lgkmcnt(0)" ::: "memory");
    float rli[16];
#pragma unroll
    for (int r = 0; r < 16; ++r) rli[r] = __builtin_amdgcn_rcpf(li_l[crow(r, hi)]);
    float* ost = (float*)(lds + L_OST) + wid * 1024;
#pragma unroll
    for (int d0 = 0; d0 < 4; ++d0) {
#pragma unroll
        for (int r = 0; r < 16; ++r) ost[crow(r, hi) * 32 + r32] = o[d0][r] * rli[r];
        asm volatile("s_waitcnt lgkmcnt(0)" ::: "memory");
#pragma unroll
        for (int i = 0; i < 2; ++i) { const int cid = lane + 64 * i, row = cid >> 2, c8 = (cid & 3) * 8;
            const f32x4 a = *(const f32x4*)(ost + row * 32 + c8), c = *(const f32x4*)(ost + row * 32 + c8 + 4);
            const size_t off = (size_t)(cur.m0 + wid * 8 + (row >> 2)) * 2048 + (g4 * 4 + (row & 3)) * 128 + d0 * 32 + c8;
            const v4u ga = __builtin_nontemporal_load((const v4u*)(SGA + off)), sp = __builtin_nontemporal_load((const v4u*)(SP + off)); v4u w;
            w.x = pk2(bf_lo(ga.x) * a[0] + bf_lo(sp.x), bf_hi(ga.x) * a[1] + bf_hi(sp.x)); w.y = pk2(bf_lo(ga.y) * a[2] + bf_lo(sp.y), bf_hi(ga.y) * a[3] + bf_hi(sp.y));
            w.z = pk2(bf_lo(ga.z) * c[0] + bf_lo(sp.z), bf_hi(ga.z) * c[1] + bf_hi(sp.z)); w.w = pk2(bf_lo(ga.w) * c[2] + bf_lo(sp.w), bf_hi(ga.w) * c[3] + bf_hi(sp.w));
            pg8::st16_out(MERGED + off, w); }
        asm volatile("s_waitcnt lgkmcnt(0)" ::: "memory");
    }
    __syncthreads();
}
#undef ROW
#undef VMW
#undef SLOAD_H
#undef SWRITE_H
#undef KSWZ
#undef SBAR
}

__device__ __forceinline__ void sgu_pair_unit(Frame& F, const Args& A, unsigned char* lds_generic, int b, int c, int gp, int cvi) {
    using namespace att;
    char* lds = (char*)lds_generic;
    const int tid = F.tid, wid = F.wave, lane = F.lane, r32 = lane & 31, hi = lane >> 5;
    const int m0 = b * SEQ + c * 128;
    LAS float* ST = (LAS float*)(F.lds + SG_WS);
    float cv0[32], cv1[32]; const int cvj = cvi + F.G * NWAVES; const bool cva = cvi >= 0 && cvi < CV_I_LATE, cvb = cvi >= 0 && cvj < CV_I_LATE;
    const CvItem ci0 = cv_item_late(A, cva ? cvi : 0), ci1 = cv_item_late(A, cvb ? cvj : 0);
    if (cva) cv_issue(cv0, ci0, lane); if (cvb) cv_issue(cv1, ci1, lane);
    if (tid < 128) { const float* p = WSP(A, float, WS_VST) + (size_t)(m0 + tid) * 64; float s = 0.f, q = 0.f;
#pragma unroll
        for (int i = 0; i < 16; ++i) { const f32x4 v = *(const f32x4*)(p + 4 * i); s += v[0] + v[2]; q += v[1] + v[3]; }
        const float mean = s * (1.0f / 2048.0f), var = q * (1.0f / 2048.0f) - mean * mean;
        ST[2 * tid] = mean; ST[2 * tid + 1] = 1.0f / sqrtf(var + EPS); }
    __syncthreads();
#pragma unroll
    for (int i = 0; i < 8; ++i) { const int id = tid + 512 * i, grp = id >> 11, s = (id >> 4) & 127, cc = (id & 15) * 8, ch = (2 * gp + grp) * 128 + cc;
        const v4u raw = __builtin_nontemporal_load((const v4u*)(WSP(A, bf16, WS_GV) + (size_t)(m0 + s) * 2048 + ch));
        const float mean = ST[2 * s], rstd = ST[2 * s + 1];
        const f32x4 g0 = *(const f32x4*)(IN_LNG(A) + ch), g1 = *(const f32x4*)(IN_LNG(A) + ch + 4), b0 = *(const f32x4*)(IN_LNB(A) + ch), b1 = *(const f32x4*)(IN_LNB(A) + ch + 4);
        v4u o;
        o.x = pk2((bf_lo(raw.x) - mean) * rstd * g0[0] + b0[0], (bf_hi(raw.x) - mean) * rstd * g0[1] + b0[1]);
        o.y = pk2((bf_lo(raw.y) - mean) * rstd * g0[2] + b0[2], (bf_hi(raw.y) - mean) * rstd * g0[3] + b0[3]);
        o.z = pk2((bf_lo(raw.z) - mean) * rstd * g1[0] + b1[0], (bf_hi(raw.z) - mean) * rstd * g1[1] + b1[1]);
        o.w = pk2((bf_lo(raw.w) - mean) * rstd * g1[2] + b1[2], (bf_hi(raw.w) - mean) * rstd * g1[3] + b1[3]);
        *(v4u*)(lds + SG_V + (grp * 2 + (s >> 6)) * SHM_V + v_st(s & 63, cc)) = o; }
    if (cva) cv_finish(cv0, ci0, (LAS float*)(F.lds + SG_OST + wid * 9728), lane);
    __syncthreads();
    if (cvb) cv_finish(cv1, ci1, (LAS float*)(F.lds + SG_OST + wid * 9728), lane);
    const int grp = wid >> 2, w4 = wid & 3, g = 2 * gp + grp;
    const int vb0 = (int)(uintptr_t)(lds + SG_V) + v_rd_base(lane);
    const bf16* wrow = WSP(A, bf16, WS_WSB) + ((size_t)g * 128 + 32 * w4 + r32) * 128 + 8 * hi;
    f32x16 o[4] = {};
    { const bf16x8 a0 = *(const bf16x8*)(wrow), a1 = *(const bf16x8*)(wrow + 16), a2 = *(const bf16x8*)(wrow + 32), a3 = *(const bf16x8*)(wrow + 48);
      if (grp == 0) pv_tile<0>(o, vb0, a0, a1, a2, a3); else pv_tile<2>(o, vb0, a0, a1, a2, a3); }
    if (w4 >= 2) { const bf16x8 a0 = *(const bf16x8*)(wrow + 64), a1 = *(const bf16x8*)(wrow + 80), a2 = *(const bf16x8*)(wrow + 96), a3 = *(const bf16x8*)(wrow + 112);
      if (grp == 0) pv_tile<1>(o, vb0, a0, a1, a2, a3); else pv_tile<3>(o, vb0, a0, a1, a2, a3); }
    float* ost = (float*)(lds + SG_OST + wid * 9728);
    bf16* GU = WSP(A, bf16, WS_GU); const bf16* SGB = WSP(A, bf16, WS_SGB);
#pragma unroll
    for (int hf = 0; hf < 2; ++hf) {
#pragma unroll
        for (int r = 0; r < 16; ++r) { const int orow = crow(r, hi); ost[orow * 64 + r32] = o[2 * hf][r]; ost[orow * 64 + 32 + r32] = o[2 * hf + 1][r]; }
        asm volatile("s_waitcnt lgkmcnt(0)" ::: "memory");
#pragma unroll
        for (int i = 0; i < 4; ++i) { const int cid = lane + 64 * i, row = cid >> 3, c8 = (cid & 7) * 8, t = 32 * w4 + row;
            const f32x4 a = *(const f32x4*)(ost + row * 64 + c8), cq = *(const f32x4*)(ost + row * 64 + c8 + 4);
            const float bs = IN_SGUB(A)[g * 128 + t];
            const size_t off = (size_t)(m0 + t) * 2048 + g * 128 + hf * 64 + c8;
            const v4u gu = __builtin_nontemporal_load((const v4u*)(GU + off)), sb = __builtin_nontemporal_load((const v4u*)(SGB + off)); v4u w;
            w.x = pk2(bf_lo(gu.x) * (a[0] + bs) * bf_lo(sb.x), bf_hi(gu.x) * (a[1] + bs) * bf_hi(sb.x)); w.y = pk2(bf_lo(gu.y) * (a[2] + bs) * bf_lo(sb.y), bf_hi(gu.y) * (a[3] + bs) * bf_hi(sb.y));
            w.z = pk2(bf_lo(gu.z) * (cq[0] + bs) * bf_lo(sb.z), bf_hi(gu.z) * (cq[1] + bs) * bf_hi(sb.z)); w.w = pk2(bf_lo(gu.w) * (cq[2] + bs) * bf_lo(sb.w), bf_hi(gu.w) * (cq[3] + bs) * bf_hi(sb.w));
            pg8::st16_out(GU + off, w); }
        asm volatile("s_waitcnt lgkmcnt(0)" ::: "memory");
    }
    __syncthreads();
}
__device__ __forceinline__ void attn_mfma_phase(Frame& F, const Args& A, unsigned char* lds_generic) {
    char* lds = (char*)lds_generic;
    for (int item = F.vcu; item < 256; item += F.G) {
        const int bg = item >> 5, pi = item & 31, b = bg >> 2, g = bg & 3;
        { LAS float* BT = (LAS float*)(F.lds + att::L_BT); const float* src = WSP(A, float, WS_BTAB);
          if (F.tid < 512) BT[F.tid] = src[(F.tid >> 2) * 16 + g * 4 + (F.tid & 3)]; }
        const bf16* Qg = WSP(A, bf16, WS_Q2) + (size_t)bg * SEQ * 4 * 128; const bf16* Kg = WSP(A, bf16, WS_K2) + (size_t)bg * SEQ * 128; const bf16* Vg = WSP(A, bf16, WS_V2) + (size_t)bg * SEQ * 128;
        const unsigned long long* Lb = WSP(A, unsigned long long, WS_LM) + (size_t)b * 512 * 64 * 32;
        const int q1 = 63 - pi;
        att::BlockRef cur{Qg + (size_t)pi * 256 * 128, Kg, Vg, Lb + (size_t)pi * 8 * 64 * 32, pi, b * SEQ + pi * 64};
        const att::BlockRef r1{Qg + (size_t)q1 * 256 * 128, Kg, Vg, Lb + (size_t)q1 * 8 * 64 * 32, q1, b * SEQ + q1 * 64};
        for (int pass = 0; pass < 2; ++pass) {
            att::attn_block(cur, lds, g, WSP(A, bf16, WS_SGA), WSP(A, bf16, WS_GU), WSP(A, bf16, WS_MERGED));
            cur = r1;
        }
    }
}
#ifndef LATE_CONV
#define LATE_CONV 1
#endif
#ifndef SGU_MFMA
#define SGU_MFMA 1
#endif
#ifndef PHASE_MIX
#define PHASE_MIX 1
#endif
#ifndef ATTN_MFMA
#define ATTN_MFMA 1
#endif
__global__ void __launch_bounds__(NWAVES * 64, 2) hybrid_fwd(const Args A) {
    extern __shared__ __attribute__((aligned(16))) unsigned char lds[];
    Frame F;
    F.lds = (LAS unsigned char*)lds;
    F.MISC = (volatile LAS unsigned*)(F.lds + MISC_OFF);
    F.tid = threadIdx.x; F.lane = F.tid & 63; F.wave = __builtin_amdgcn_readfirstlane(F.tid >> 6);
    F.G = gridDim.x; { const int bx = blockIdx.x; F.vcu = (F.G % 8 == 0) ? (bx % 8) * (F.G / 8) + bx / 8 : bx; }
    F.ctl = (gu32*)(A.ws + WS_CTL);
    for (int u = F.tid; u < (LDS_BYTES - LDSCTL_OFF) / 4; u += NWAVES * 64) ((LAS unsigned*)(F.lds + LDSCTL_OFF))[u] = 0u;
    __syncthreads();
    const int lo = A.ph_lo, hi = A.ph_hi;
    const bool one_launch = (hi - lo) > 1;
    XcdBarrier bar; bar.bar = (unsigned*)(F.ctl + CW_BAR); bar.x = 0; bar.st = nullptr;
    if (one_launch) bar = xcd_barrier_post((unsigned*)(F.ctl + CW_BAR), F.MISC + 8);
#define IN(k) (lo <= (k) && (k) < hi)
#define SEAM(k) do { if (IN(k) && IN((k) + 1)) xcd_barrier(bar); } while (0)

    if (IN(0)) { p0_prologue(F, A, !LATE_CONV); } SEAM(0);

    if (IN(1)) {
        pg8::Gemm g{WSP(A, bf16, WS_XB), WSP(A, bf16, WS_WIN), MTOK, NP, DM}; pg8::StaticOrder S; S.init(MTOK, NP, F.G, (int)blockIdx.x);
        pg8::EpiProj E{WSP(A, float, WS_RS1), WSP(A, bf16, WS_Q2), WSP(A, bf16, WS_K2), WSP(A, bf16, WS_V2), WSP(A, bf16, WS_QI), WSP(A, bf16, WS_KI), WSP(A, bf16, WS_GU), WSP(A, bf16, WS_GV), WSP(A, bf16, WS_SGA), WSP(A, bf16, WS_SGB), WSP(A, float, WS_WI), WSP(A, float, WS_VST), QSCALE, IDX_SCALE};
        pg8::gemm_phase<pg8::EpiProj, pg8::StaticOrder, true, true>(F.lds, g, S, E);
    } SEAM(1);

    const bool sgu_first = one_launch && PHASE_MIX && (F.vcu & 1);
#define SGU_PHASE() do { if (IN(3)) { const int gwv = F.vcu * NWAVES + F.wave, NGWV = F.G * NWAVES, nun = (F.G == 256) ? 4 : (1024 - F.vcu + F.G - 1) / F.G; int k = 0; \
        for (int i = F.vcu; i < 512; i += F.G, ++k) sgu_pair_unit(F, A, lds, i >> 8, (i >> 3) & 31, i & 7, LATE_CONV ? gwv + (nun + 2 * k) * NGWV : -1); \
        if (LATE_CONV) { for (int it = gwv + (nun + 2 * k) * NGWV; it < CV_I_LATE; it += NGWV) { const CvItem ci = cv_item_late(A, it); float v[32]; cv_issue(v, ci, F.lane); cv_finish(v, ci, (LAS float*)(F.lds + F.wave * 16384), F.lane); } } \
    } } while (0)
    if (sgu_first) SGU_PHASE();
    if (IN(2)) {
        const int w = F.vcu;
        IdxFrag fr; const int nun = (F.G == 256) ? 4 : (1024 - w + F.G - 1) / F.G;
#define UNIT_B(i) ((F.G == 256) ? ((i) >> 1) : ((w + (i) * F.G) >> 9))
#define UNIT_U(i) ((F.G == 256) ? (((i) & 1) ? w : 511 - w) : ((w + (i) * F.G) & 511))
        if (UNIT_U(0) >= 32) idx_load_frag(fr, F, A, UNIT_B(0), 8 * UNIT_U(0));
        const int gwv = F.vcu * NWAVES + F.wave, NGWV = F.G * NWAVES;
        for (int i = 0; i < nun; ++i) idx_unit(fr, F, A, UNIT_B(i), UNIT_U(i), i + 1 < nun ? UNIT_B(i + 1) : 0, i + 1 < nun ? UNIT_U(i + 1) : -1, LATE_CONV ? gwv + i * NGWV : -1);
#undef UNIT_B
#undef UNIT_U
    }
    if (!sgu_first) SGU_PHASE();
#undef SGU_PHASE
    SEAM(3);

#if ATTN_MFMA
    if (IN(4)) { attn_mfma_phase(F, A, lds); } SEAM(4);
#else
    if (IN(4)) { attn_gather_phase(F, A); } SEAM(4);
#endif

    if (IN(5)) {
        pg8::Gemm g{WSP(A, bf16, WS_MERGED), WSP(A, bf16, WS_WOUT), MTOK, DM, DM}; pg8::StaticOrder S; S.init(MTOK, DM, F.G, (int)blockIdx.x);
        if (one_launch && F.G == 256) {
            pg8::EpiRes<true, false> E{IN_X(A), (A).out, WSP(A, bf16, WS_H2), WSP(A, float, WS_SSQ2)};
            pg8::gemm_phase<pg8::EpiRes<true, false>, pg8::StaticOrder, true, true>(F.lds, g, S, E);
        } else {
            pg8::EpiRes<true, true> E{IN_X(A), (A).out, WSP(A, bf16, WS_H2), WSP(A, float, WS_SSQ2)};
            pg8::gemm_phase<pg8::EpiRes<true, true>, pg8::StaticOrder, true, true>(F.lds, g, S, E);
        }
    } SEAM(5);

    if (IN(6)) {
        pg8::Gemm g{WSP(A, bf16, WS_H2), WSP(A, bf16, WS_W1), MTOK, DFF, DM}; pg8::StaticOrder S; S.init(MTOK, DFF, F.G, (int)blockIdx.x);
        pg8::EpiFF1 E{WSP(A, float, WS_SSQ2), WSP(A, bf16, WS_FF), EPS};
        pg8::gemm_phase<pg8::EpiFF1, pg8::StaticOrder, true, true>(F.lds, g, S, E);
    } SEAM(6);

    if (IN(7)) {
        pg8::Gemm g{WSP(A, bf16, WS_FF), WSP(A, bf16, WS_W2), MTOK, DM, DFF}; pg8::StaticOrder S; S.init(MTOK, DM, F.G, (int)blockIdx.x);
        if (one_launch && F.G == 256) {
            struct Hook { const XcdBarrier* b; __device__ __forceinline__ void operator()() const { xcd_barrier(*b); } };
            pg8::EpiResNorm<Hook> E{WSP(A, bf16, WS_H2), (A).out, WSP(A, float, WS_SSQ3), IN_FING(A), EPS, Hook{&bar}};
            pg8::gemm_phase<pg8::EpiResNorm<Hook>, pg8::StaticOrder, false, true>(F.lds, g, S, E);
        } else {
            pg8::EpiRes<false, true> E{(A).out, (A).out, nullptr, WSP(A, float, WS_SSQ3)};
            pg8::gemm_phase<pg8::EpiRes<false, true>, pg8::StaticOrder, true, true>(F.lds, g, S, E);
        }
    }
    if (!(one_launch && F.G == 256)) { SEAM(7); if (IN(8)) { final_norm_phase(F, A); } }
    if (IN(9) || IN(10)) { const int w = F.vcu, md = IN(10) ? 1 : 0; for (int i = 0; i < 4; ++i) idx_unit_probe(F, A, i >> 1, (i & 1) ? 511 - w : w, md); }
#undef IN
#undef SEAM
}

#ifndef MK_N_LAUNCHES
#define MK_N_LAUNCHES 1
#endif
constexpr int N_PHASES = 9;
#ifndef PROBE_DUP
#define PROBE_DUP (-1)
#endif
#ifndef PROBE_TAIL
#define PROBE_TAIL (-1)
#endif
extern "C" void kernel_launch(void* const* d_in, const int* in_sizes, int n_in, void* d_out, int out_size, void* d_ws, size_t ws_size, hipStream_t stream) {
    static int grid = 0;
    if (grid == 0) {
        if (n_in != 13 || in_sizes[0] != MTOK * DM || out_size != MTOK * DM || ws_size < WS_END) {
            fprintf(stderr, "kernel_launch: shape/workspace mismatch (n_in %d, in0 %d, out %d, ws %zu, need %zu); nothing launched\n", n_in, n_in > 0 ? in_sizes[0] : -1, out_size, ws_size, (size_t)WS_END); grid = -1; return; }
        int dev = 0, cus = 0, per_cu = 0;
        if (hipGetDevice(&dev) != hipSuccess || hipDeviceGetAttribute(&cus, hipDeviceAttributeMultiprocessorCount, dev) != hipSuccess) { fprintf(stderr, "kernel_launch: device query failed\n"); grid = -1; return; }
        if (hipFuncSetAttribute((const void*)hybrid_fwd, hipFuncAttributeMaxDynamicSharedMemorySize, LDS_BYTES) != hipSuccess) { fprintf(stderr, "kernel_launch: hipFuncSetAttribute failed\n"); grid = -1; return; }
        if (hipOccupancyMaxActiveBlocksPerMultiprocessor(&per_cu, (const void*)hybrid_fwd, NWAVES * 64, LDS_BYTES) != hipSuccess || per_cu < 1) { fprintf(stderr, "kernel_launch: occupancy query says %d blocks per CU\n", per_cu); }
        (void)hipGetLastError();
        grid = cus;
        fprintf(stderr, "kernel_launch: grid %d, occupancy %d, ws %zu\n", grid, per_cu, ws_size);
    }
    if (grid < 0) return;
    (void)hipMemsetAsync((char*)d_ws + WS_CTL, 0, CTL_ZERO_BYTES, stream);
    Args a{};
    for (int i = 0; i < 13; ++i) a.in[i] = (const float*)d_in[i];
    a.out = (float*)d_out; a.ws = (unsigned char*)d_ws;
    if (MK_N_LAUNCHES == 1) { a.ph_lo = 0; a.ph_hi = N_PHASES; hipLaunchKernelGGL(hybrid_fwd, dim3(grid), dim3(NWAVES * 64), LDS_BYTES, stream, a); }
    else { for (int p = 0; p < N_PHASES; ++p) { a.ph_lo = p; a.ph_hi = p + 1; for (int r = 0; r < (p == PROBE_DUP ? 2 : 1); ++r) hipLaunchKernelGGL(hybrid_fwd, dim3(grid), dim3(NWAVES * 64), LDS_BYTES, stream, a); }
           if (PROBE_DUP >= 9) { a.ph_lo = PROBE_DUP; a.ph_hi = PROBE_DUP + 1; hipLaunchKernelGGL(hybrid_fwd, dim3(grid), dim3(NWAVES * 64), LDS_BYTES, stream, a); }
           if (PROBE_TAIL >= 0) { a.ph_lo = PROBE_TAIL; a.ph_hi = PROBE_TAIL + 1; hipLaunchKernelGGL(hybrid_fwd, dim3(grid), dim3(NWAVES * 64), LDS_BYTES, stream, a); } }
}
```

```cpp
#include <hip/hip_runtime.h>
#include <hip/hip_bf16.h>
#include <cstdio>
#include <cstdint>
namespace pg8 {
#define PG8_LAS __attribute__((address_space(3)))
typedef unsigned short bf16_t;
typedef short bf16x8 __attribute__((ext_vector_type(8)));
typedef float f32x4 __attribute__((ext_vector_type(4)));
typedef unsigned u32x4 __attribute__((ext_vector_type(4)));
constexpr int BM = 256, BK = 64, HALF = 128, HTB = HALF * BK * 2  , STAGE_BYTES = 8 * HTB, NXCD = 8, WGM = 8;

__host__ __device__ __forceinline__ int lds_byte(int r, int c) { const int st = (r >> 4) * 2 + (c >> 5), rr = r & 15, cc = c & 31, ob = rr * 64 + cc * 2; return st * 1024 + (ob ^ (((ob >> 9) & 1) << 5)); }
__host__ __device__ __forceinline__ void stage_rc(int b, int& R, int& C) { const int st = b / 1024, sb = b % 1024, swz = sb ^ (((sb >> 9) & 1) << 5); R = (st >> 1) * 16 + swz / 64; C = (st & 1) * 32 + (swz % 64) / 2; }
__host__ __device__ __forceinline__ int perm32(int rho) { const int n = rho >> 4, i = rho & 15; return 8 * (i >> 2) + 4 * n + (i & 3); }

struct Unit { int pm, pn; };
struct Gemm { const bf16_t* A; const bf16_t* Bt; int M, N, K; };

struct StaticOrder {
    int nM, nN, nwg, G, c;
    __host__ __device__ void init(int M, int N, int G_, int c_) { nM = M / BM; nN = N / BM; nwg = nM * nN; G = G_; c = c_; }
    __host__ __device__ __forceinline__ bool next(int i, Unit& u) const {
        const long L = (long)i * G + c; if (L >= nwg) return false;
        int wgid = (int)L; { const int q = nwg / NXCD, r = nwg % NXCD, xcd = wgid % NXCD, off = wgid / NXCD; wgid = (xcd < r ? xcd * (q + 1) : r * (q + 1) + (xcd - r) * q) + off; }
        const int nig = WGM * nN, gid = wgid / nig, fm = gid * WGM, gsz = (nM - fm) < WGM ? (nM - fm) : WGM;
        u.pm = fm + ((wgid % nig) % gsz); u.pn = (wgid % nig) / gsz; return true;
    }
    __device__ __forceinline__ void a_ready(const Unit&) const {}
    __device__ __forceinline__ void done(const Unit&) const {}
};

__device__ __forceinline__ unsigned cvt_pk_bf16(float lo, float hi) { unsigned r; asm volatile("v_cvt_pk_bf16_f32 %0, %1, %2" : "=v"(r) : "v"(lo), "v"(hi)); return r; }
typedef float f32x2 __attribute__((ext_vector_type(2)));
constexpr float LOG2E_F = 1.4426950408889634f;
__device__ __forceinline__ float gelu_tanh(float x) {
    const float u = x * (1.0f + 0.044715f * x * x);
    const float e = __builtin_amdgcn_exp2f(u * (-2.0f * 0.7978845608028654f * LOG2E_F));
    return x * __builtin_amdgcn_rcpf(1.0f + e);
}
__device__ __forceinline__ float sigmoid_f(float x) { return __builtin_amdgcn_rcpf(1.0f + __builtin_amdgcn_exp2f(-x * LOG2E_F)); }
__device__ __forceinline__ f32x2 gelu2(f32x2 x) {
    const f32x2 t = (x * x) * 0.044715f + 1.0f, u = (x * t) * (-2.0f * 0.7978845608028654f * LOG2E_F);
    f32x2 e; e.x = __builtin_amdgcn_exp2f(u.x); e.y = __builtin_amdgcn_exp2f(u.y); e = e + 1.0f;
    f32x2 r; r.x = __builtin_amdgcn_rcpf(e.x); r.y = __builtin_amdgcn_rcpf(e.y); return x * r;
}
__device__ __forceinline__ f32x2 sigmoid2(f32x2 x) {
    const f32x2 u = x * (-LOG2E_F); f32x2 e; e.x = __builtin_amdgcn_exp2f(u.x); e.y = __builtin_amdgcn_exp2f(u.y); e = e + 1.0f;
    f32x2 r; r.x = __builtin_amdgcn_rcpf(e.x); r.y = __builtin_amdgcn_rcpf(e.y); return r;
}
__device__ __forceinline__ f32x2 gelu_sig2(f32x2 u, f32x2 g) {
    const f32x2 t = (u * u) * 0.044715f + 1.0f, a = (u * t) * (-2.0f * 0.7978845608028654f * LOG2E_F), b = g * (-LOG2E_F);
    f32x2 e, f; e.x = __builtin_amdgcn_exp2f(a.x); e.y = __builtin_amdgcn_exp2f(a.y); f.x = __builtin_amdgcn_exp2f(b.x); f.y = __builtin_amdgcn_exp2f(b.y);
    const f32x2 d = (e + 1.0f) * (f + 1.0f); f32x2 r; r.x = __builtin_amdgcn_rcpf(d.x); r.y = __builtin_amdgcn_rcpf(d.y); return u * r;
}
__device__ __forceinline__ void gelu4(f32x4& v) { const f32x2 a = gelu2((f32x2){v[0], v[1]}), b = gelu2((f32x2){v[2], v[3]}); v = (f32x4){a.x, a.y, b.x, b.y}; }
__device__ __forceinline__ void sigmoid4(f32x4& v) { const f32x2 a = sigmoid2((f32x2){v[0], v[1]}), b = sigmoid2((f32x2){v[2], v[3]}); v = (f32x4){a.x, a.y, b.x, b.y}; }
#ifndef WT_STORES
#define WT_STORES 0
#endif
__device__ __forceinline__ void st16_out(void* p, u32x4 w) {
#if WT_STORES
    asm volatile("global_store_dwordx4 %0, %1, off sc1\n\ts_nop 1" :: "v"(p), "v"(w) : "memory");
#else
    *(u32x4*)p = w;
#endif
}
__device__ __forceinline__ void st_bf16x8(bf16_t* p, f32x4 v0, f32x4 v1) { u32x4 w; w.x = cvt_pk_bf16(v0[0], v0[1]); w.y = cvt_pk_bf16(v0[2], v0[3]); w.z = cvt_pk_bf16(v1[0], v1[1]); w.w = cvt_pk_bf16(v1[2], v1[3]); st16_out(p, w); }
__device__ __forceinline__ void st_bf16x8_nt(bf16_t* p, f32x4 v0, f32x4 v1) { u32x4 w; w.x = cvt_pk_bf16(v0[0], v0[1]); w.y = cvt_pk_bf16(v0[2], v0[3]); w.z = cvt_pk_bf16(v1[0], v1[1]); w.w = cvt_pk_bf16(v1[2], v1[3]); __builtin_nontemporal_store(w, (u32x4*)p); }
__device__ __forceinline__ float hsum8(f32x4 a, f32x4 b) { return ((a[0] + a[1]) + (a[2] + a[3])) + ((b[0] + b[1]) + (b[2] + b[3])); }
__device__ __forceinline__ float hsq8(f32x4 a, f32x4 b) { return ((a[0] * a[0] + a[1] * a[1]) + (a[2] * a[2] + a[3] * a[3])) + ((b[0] * b[0] + b[1] * b[1]) + (b[2] * b[2] + b[3] * b[3])); }

__host__ __device__ __forceinline__ int proj_logical_tile(int pn) { const int g = pn >> 2, w = pn & 3; return (g % 3 == 2) ? (g / 3) * 4 + w : 15 + (g - g / 3) * 4 + w; }
struct EpiProj {
    static constexpr bool PERM = true, AFTER_DRAIN = false;
    static constexpr int NST = 16;
    const float* rs1; bf16_t *Q2, *K2, *V2, *QI, *KI, *GU, *GV, *SGA, *SGB; float* WI; float* VST; float qscale, iscale; bf16_t* PADD;
    __device__ __forceinline__ void operator()(const f32x4 (&acc)[2][2][4][2], const Unit& u, int wr, int wc, int fr, int fq) const {
        const int pn = proj_logical_tile(u.pn), row0 = u.pm * BM + wr * 64 + fr, cl0 = wc * 32 + 8 * fq;
#pragma unroll
        for (int ai = 0; ai < 2; ++ai)
#pragma unroll
            for (int m = 0; m < 4; ++m) {
                const int r = row0 + ai * HALF + m * 16; const int b = r >> 12, t = r & 4095;
                float ssum = 0.f, ssq = 0.f;
#pragma unroll
                for (int bj = 0; bj < 2; ++bj) {
                    f32x4 v0 = acc[ai][bj][m][0], v1 = acc[ai][bj][m][1];
                    if (pn < 8) { const int head = 2 * pn + bj, g = head >> 2, h = head & 3; v0 = v0 * qscale; v1 = v1 * qscale;
                        st_bf16x8_nt(Q2 + ((((size_t)(b * 4 + g) * 4096 + t) * 4 + h) * 128 + cl0), v0, v1); }
                    else if (pn < 10) { const int g = 2 * (pn - 8) + bj; st_bf16x8_nt(K2 + (((size_t)(b * 4 + g) * 4096 + t) * 128 + cl0), v0, v1); }
                    else if (pn < 12) { const int g = 2 * (pn - 10) + bj; st_bf16x8_nt(V2 + (((size_t)(b * 4 + g) * 4096 + t) * 128 + cl0), v0, v1); }
                    else if (pn < 14) { st_bf16x8(QI + ((size_t)r * 512 + 256 * (pn - 12) + 128 * bj + cl0), v0, v1); }
                    else if (pn == 14) { const int cl = 128 * bj + cl0;
                        st_bf16x8(cl < 64 ? KI + ((((size_t)(r >> 5) * 4 + (cl >> 4)) * 64 + ((cl >> 3) & 1) * 32 + (r & 31)) * 8) : PADD + ((size_t)r * 256 + cl), v0, v1);
                        if (cl == 64) { *(f32x4*)(WI + (size_t)r * 8) = v0 * iscale; *(f32x4*)(WI + (size_t)r * 8 + 4) = v1 * iscale; } }
                    else if (pn < 23) { st_bf16x8(GU + ((size_t)r * 2048 + 256 * (pn - 15) + 128 * bj + cl0), v0, v1); }
                    else if (pn < 31) { gelu4(v0); gelu4(v1);
                        ssum += hsum8(v0, v1); ssq += hsq8(v0, v1);
                        st_bf16x8(GV + ((size_t)r * 2048 + 256 * (pn - 23) + 128 * bj + cl0), v0, v1); }
                    else if (pn < 39) { sigmoid4(v0); sigmoid4(v1);
                        st_bf16x8_nt(SGA + ((size_t)r * 2048 + 256 * (pn - 31) + 128 * bj + cl0), v0, v1); }
                    else { st_bf16x8(SGB + ((size_t)r * 2048 + 256 * (pn - 39) + 128 * bj + cl0), v0, v1); }
                }
                if (pn >= 23 && pn < 31) {
                    ssum += __shfl_xor(ssum, 16); ssum += __shfl_xor(ssum, 32); ssq += __shfl_xor(ssq, 16); ssq += __shfl_xor(ssq, 32);
                    if (fq == 0) { f32x2 o = {ssum, ssq}; *(f32x2*)(VST + ((size_t)r * 32 + (pn - 23) * 4 + wc) * 2) = o; }
                }
            }
    }
};
template <bool H2, bool F32OUT, bool RESBF = false, bool NORES = false> struct EpiRes {
    static constexpr bool PERM = true, AFTER_DRAIN = false;
    static constexpr int NST = 0;
    const void* res; float* out; bf16_t* h2; float* ssq;
    __device__ __forceinline__ void operator()(const f32x4 (&acc)[2][2][4][2], const Unit& u, int wr, int wc, int fr, int fq) const {
        const int row0 = u.pm * BM + wr * 64 + fr, c00 = u.pn * BM + wc * 32 + 8 * fq;
#pragma unroll
        for (int ai = 0; ai < 2; ++ai)
#pragma unroll
            for (int m = 0; m < 4; ++m) {
                const int r = row0 + ai * HALF + m * 16; float q = 0.f;
#pragma unroll
                for (int bj = 0; bj < 2; ++bj) { const size_t off = (size_t)r * 2048 + c00 + 128 * bj; f32x4 r0, r1;
                    if (NORES) { r0 = (f32x4){0.f, 0.f, 0.f, 0.f}; r1 = r0; }
                    else if (RESBF) { const u32x4 rw = *(const u32x4*)((const bf16_t*)res + off);
                        r0 = (f32x4){__uint_as_float(rw.x << 16), __uint_as_float(rw.x & 0xffff0000u), __uint_as_float(rw.y << 16), __uint_as_float(rw.y & 0xffff0000u)};
                        r1 = (f32x4){__uint_as_float(rw.z << 16), __uint_as_float(rw.z & 0xffff0000u), __uint_as_float(rw.w << 16), __uint_as_float(rw.w & 0xffff0000u)}; }
                    else { r0 = __builtin_nontemporal_load((const f32x4*)((const float*)res + off)); r1 = __builtin_nontemporal_load((const f32x4*)((const float*)res + off + 4)); }
                    const f32x4 v0 = acc[ai][bj][m][0] + r0, v1 = acc[ai][bj][m][1] + r1;
                    if (F32OUT) { *(f32x4*)(out + off) = v0; *(f32x4*)(out + off + 4) = v1; } q += hsq8(v0, v1);
                    if (H2) st_bf16x8(h2 + off, v0, v1); }
                q += __shfl_xor(q, 16); q += __shfl_xor(q, 32);
                if (fq == 0) ssq[(size_t)r * 32 + u.pn * 4 + wc] = q;
            }
    }
};
struct EpiFF1 {
    static constexpr bool PERM = true, AFTER_DRAIN = false;
    static constexpr int NST = 16;
    const float* ssq2; bf16_t* FF; float eps;
    __device__ __forceinline__ void operator()(const f32x4 (&acc)[2][2][4][2], const Unit& u, int wr, int wc, int fr, int fq) const {
        const int row0 = u.pm * BM + wr * 64 + fr, c00 = u.pn * BM + wc * 32 + 8 * fq;
#pragma unroll
        for (int ai = 0; ai < 2; ++ai)
#pragma unroll
            for (int m = 0; m < 4; ++m) {
                const int r = row0 + ai * HALF + m * 16;
                float s = hsum8(*(const f32x4*)(ssq2 + (size_t)r * 32 + 8 * fq), *(const f32x4*)(ssq2 + (size_t)r * 32 + 8 * fq + 4));
                s += __shfl_xor(s, 16); s += __shfl_xor(s, 32);
                const float rs = __builtin_amdgcn_rsqf(s * (1.0f / 2048.0f) + eps);
#pragma unroll
                for (int bj = 0; bj < 2; ++bj) { f32x4 v0 = acc[ai][bj][m][0] * rs, v1 = acc[ai][bj][m][1] * rs;
                    for (int e = 0; e < 4; ++e) { const float a = fmaxf(v0[e], 0.f), c = fmaxf(v1[e], 0.f); v0[e] = a * a; v1[e] = c * c; }
                    st_bf16x8(FF + ((size_t)r * 8192 + c00 + 128 * bj), v0, v1); }
            }
    }
};

template <class Hook> struct EpiResNorm {
    static constexpr bool PERM = true, AFTER_DRAIN = true;
    static constexpr int NST = 0;
    const bf16_t* res; float* out; float* ssq; const float* gain; float eps; Hook hook;
    __device__ __forceinline__ void fused(f32x4 (&acc)[2][2][4][2], const Unit& u, int wr, int wc, int fr, int fq, PG8_LAS unsigned char* lds, int wid, int lane) const {
        const int row0 = u.pm * BM + wr * 64 + fr, c00 = u.pn * BM + wc * 32 + 8 * fq;
#pragma unroll
        for (int ai = 0; ai < 2; ++ai)
#pragma unroll
            for (int m = 0; m < 4; ++m) {
                const int r = row0 + ai * HALF + m * 16; float q = 0.f;
#pragma unroll
                for (int bj = 0; bj < 2; ++bj) { const size_t off = (size_t)r * 2048 + c00 + 128 * bj;
                    const u32x4 rw = __builtin_nontemporal_load((const u32x4*)(res + off));
                    acc[ai][bj][m][0] += (f32x4){__uint_as_float(rw.x << 16), __uint_as_float(rw.x & 0xffff0000u), __uint_as_float(rw.y << 16), __uint_as_float(rw.y & 0xffff0000u)};
                    acc[ai][bj][m][1] += (f32x4){__uint_as_float(rw.z << 16), __uint_as_float(rw.z & 0xffff0000u), __uint_as_float(rw.w << 16), __uint_as_float(rw.w & 0xffff0000u)};
                    q += hsq8(acc[ai][bj][m][0], acc[ai][bj][m][1]); }
                q += __shfl_xor(q, 16); q += __shfl_xor(q, 32);
                if (fq == 0) ssq[(size_t)r * 32 + u.pn * 4 + wc] = q;
            }
        hook();
        PG8_LAS unsigned char* sl = lds + wid * 4096;
        f32x4 g0[2], g1[2];
#pragma unroll
        for (int bj = 0; bj < 2; ++bj) { g0[bj] = *(const f32x4*)(gain + c00 + 128 * bj); g1[bj] = *(const f32x4*)(gain + c00 + 128 * bj + 4); }
#pragma unroll
        for (int ai = 0; ai < 2; ++ai)
#pragma unroll
            for (int m = 0; m < 4; ++m) {
                const int r = row0 + ai * HALF + m * 16;
                float s = hsum8(*(const f32x4*)(ssq + (size_t)r * 32 + 8 * fq), *(const f32x4*)(ssq + (size_t)r * 32 + 8 * fq + 4));
                s += __shfl_xor(s, 16); s += __shfl_xor(s, 32);
                const float rs = 1.0f / sqrtf(s * (1.0f / 2048.0f) + eps);
#pragma unroll
                for (int bj = 0; bj < 2; ++bj) { PG8_LAS unsigned char* w = sl + bj * 2048 + fr * 128;
                    *(PG8_LAS f32x4*)(w + (((2 * fq) ^ (fr & 7)) * 16)) = acc[ai][bj][m][0] * rs * g0[bj]; *(PG8_LAS f32x4*)(w + (((2 * fq + 1) ^ (fr & 7)) * 16)) = acc[ai][bj][m][1] * rs * g1[bj]; }
#pragma unroll
                for (int bj = 0; bj < 2; ++bj)
#pragma unroll
                    for (int s = 0; s < 2; ++s) { const int row = 8 * s + (lane >> 3), c = lane & 7;
                        const f32x4 v = *(const PG8_LAS f32x4*)(sl + bj * 2048 + row * 128 + ((c ^ (row & 7)) * 16));
                        *(f32x4*)(out + (size_t)(r - fr + row) * 2048 + (c00 - 8 * fq) + 128 * bj + 4 * c) = v; }
            }
    }
};
template <class Epi, class Sched, bool ALIGN_EPI = false, bool SP2 = false, bool ACC_IN = false>
__device__ __forceinline__ void gemm_phase(PG8_LAS unsigned char* lds, const Gemm g, const Sched& S, const Epi& E, const f32x4 (*acc0)[2][4][2] = nullptr) {
    const int tid = threadIdx.x, wid = __builtin_amdgcn_readfirstlane(tid >> 6), lane = tid & 63, wr = wid >> 2, wc = wid & 3, fr = lane & 15, fq = lane >> 4;
    const int K = g.K, nt = K / BK;
    unsigned voffA[2], voffB[2];
#pragma unroll
    for (int i = 0; i < 2; ++i) { int R, C; stage_rc(tid * 16 + i * 8192, R, C); const int Rb = Epi::PERM ? ((R & ~31) + perm32(R & 31)) : R;
        voffA[i] = (unsigned)(R * K + C) * 2u; voffB[i] = (unsigned)(Rb * K + C) * 2u; }
    const size_t kstep = (size_t)(BK * 2);
    const size_t hstep = (size_t)HALF * K * 2;
    const size_t tstep = 2 * hstep;
    const unsigned ldsw = (unsigned)wid * 1024u;
    const int aoff = lds_byte(wr * 64 + fr, fq * 8), boff = lds_byte(wc * 32 + fr, fq * 8);
#define PG8_SA(b, h) (((b) * 2 + (h)) * HTB)
#define PG8_SB(b, h) ((4 + (b) * 2 + (h)) * HTB)
#define PG8_STAGE(bufoff, gbase, voff) do { _Pragma("unroll") for (int _i = 0; _i < 2; ++_i) \
        __builtin_amdgcn_global_load_lds((const unsigned*)((const char*)(gbase) + (voff)[_i]), (PG8_LAS unsigned*)(lds + (bufoff) + ldsw + _i * 8192), 16, 0, 0); } while (0)
#define PG8_LDA(dst, b, h) do { _Pragma("unroll") for (int m = 0; m < 4; ++m) _Pragma("unroll") for (int k = 0; k < 2; ++k) dst[m][k] = *(const PG8_LAS bf16x8*)(lds + PG8_SA(b, h) + aoff + m * 2048 + k * 1024); } while (0)
#define PG8_LDB(dst, b, h) do { _Pragma("unroll") for (int n = 0; n < 2; ++n) _Pragma("unroll") for (int k = 0; k < 2; ++k) dst[n][k] = *(const PG8_LAS bf16x8*)(lds + PG8_SB(b, h) + boff + n * 2048 + k * 1024); } while (0)
#define PG8_MMA(ai, bj, At, Bt) do { __builtin_amdgcn_s_setprio(1); _Pragma("unroll") for (int m = 0; m < 4; ++m) _Pragma("unroll") for (int n = 0; n < 2; ++n) _Pragma("unroll") for (int k = 0; k < 2; ++k) \
        acc[ai][bj][m][n] = __builtin_amdgcn_mfma_f32_16x16x32_bf16(Bt[n][k], At[m][k], acc[ai][bj][m][n], 0, 0, 0); __builtin_amdgcn_s_setprio(0); } while (0)
#define PG8_WAIT_V(n) asm volatile("s_waitcnt vmcnt(" #n ")" ::: "memory")
#define PG8_WAIT_L(n) asm volatile("s_waitcnt lgkmcnt(" #n ")" ::: "memory")
#define PG8_BAR __builtin_amdgcn_s_barrier()
#define PG8_SCHED __builtin_amdgcn_sched_barrier(0)
    Unit cur, nxt; int ui = 0;
    if (!S.next(0, cur)) return;
    f32x4 acc[2][2][4][2];
#pragma unroll
    for (int a = 0; a < 2; ++a)
#pragma unroll
        for (int b = 0; b < 2; ++b)
#pragma unroll
            for (int m = 0; m < 4; ++m)
#pragma unroll
                for (int n = 0; n < 2; ++n) acc[a][b][m][n] = ACC_IN ? acc0[a][b][m][n] : (f32x4){0.f, 0.f, 0.f, 0.f};
    bf16x8 At[4][2], B0[2][2], B1[2][2];
    const char* cA = (const char*)g.A + (size_t)cur.pm * tstep; const char* cB = (const char*)g.Bt + (size_t)cur.pn * tstep;
    S.a_ready(cur);
    if constexpr (SP2) {
        PG8_STAGE(PG8_SB(0, 0), cB, voffB); PG8_STAGE(PG8_SB(0, 1), cB + hstep, voffB); PG8_STAGE(PG8_SA(0, 0), cA, voffA); PG8_STAGE(PG8_SA(0, 1), cA + hstep, voffA);
        if (wr == 1) PG8_BAR;
        PG8_WAIT_V(2); PG8_BAR;
        PG8_STAGE(PG8_SB(1, 0), cB + kstep, voffB); PG8_STAGE(PG8_SA(1, 0), cA + kstep, voffA); PG8_STAGE(PG8_SB(1, 1), cB + hstep + kstep, voffB);
        if constexpr (Epi::NST > 0) PG8_WAIT_V(0); else PG8_WAIT_V(6);
        PG8_BAR;
    } else {
        PG8_STAGE(PG8_SB(0, 0), cB, voffB); PG8_STAGE(PG8_SA(0, 0), cA, voffA); PG8_STAGE(PG8_SB(0, 1), cB + hstep, voffB); PG8_STAGE(PG8_SA(0, 1), cA + hstep, voffA);
        if (wr == 1) PG8_BAR;
        PG8_WAIT_V(4); PG8_BAR;
        PG8_STAGE(PG8_SB(1, 0), cB + kstep, voffB); PG8_STAGE(PG8_SA(1, 0), cA + kstep, voffA); PG8_STAGE(PG8_SB(1, 1), cB + hstep + kstep, voffB);
        PG8_WAIT_V(6); PG8_BAR;
    }
    for (;;) {
        const bool has_next = S.next(ui + 1, nxt);
        const char* nA = has_next ? (const char*)g.A + (size_t)nxt.pm * tstep : cA; const char* nB = has_next ? (const char*)g.Bt + (size_t)nxt.pn * tstep : cB;
        for (int t = 0; t < nt; t += 2) {
            const bool last = (t == nt - 2);
            const char* a1 = cA + (size_t)(t + 1) * kstep;
            const char* a2 = last ? nA : cA + (size_t)(t + 2) * kstep; const char* b2 = last ? nB : cB + (size_t)(t + 2) * kstep;
            const char* a3 = a2 + kstep; const char* b3 = b2 + kstep;
            if (last && has_next) S.a_ready(nxt);
            if constexpr (SP2) {
#define PG8_KPAIR(WV01) do { \
            PG8_LDB(B0, 0, 0); PG8_LDB(B1, 0, 1); PG8_SCHED; PG8_LDA(At, 0, 0); PG8_STAGE(PG8_SA(1, 1), a1 + hstep, voffA); \
            WV01; PG8_WAIT_L(0); PG8_BAR; PG8_MMA(0, 0, At, B0); PG8_MMA(0, 1, At, B1); PG8_BAR; PG8_SCHED; \
            PG8_LDA(At, 0, 1); PG8_STAGE(PG8_SB(0, 0), b2, voffB); PG8_STAGE(PG8_SB(0, 1), b2 + hstep, voffB); PG8_STAGE(PG8_SA(0, 0), a2, voffA); \
            WV01; PG8_WAIT_L(0); PG8_BAR; PG8_MMA(1, 0, At, B0); PG8_MMA(1, 1, At, B1); PG8_BAR; PG8_SCHED; \
            PG8_LDB(B0, 1, 0); PG8_LDB(B1, 1, 1); PG8_SCHED; PG8_LDA(At, 1, 0); PG8_STAGE(PG8_SA(0, 1), a2 + hstep, voffA); \
            PG8_WAIT_V(8); PG8_WAIT_L(0); PG8_BAR; PG8_MMA(0, 0, At, B0); PG8_MMA(0, 1, At, B1); PG8_BAR; PG8_SCHED; \
            PG8_LDA(At, 1, 1); PG8_STAGE(PG8_SB(1, 0), b3, voffB); PG8_STAGE(PG8_SB(1, 1), b3 + hstep, voffB); PG8_STAGE(PG8_SA(1, 0), a3, voffA); \
            PG8_WAIT_V(8); PG8_WAIT_L(0); PG8_BAR; PG8_MMA(1, 0, At, B0); PG8_MMA(1, 1, At, B1); PG8_BAR; PG8_SCHED; } while (0)
            if constexpr (Epi::NST > 0) PG8_KPAIR(asm volatile("s_cmp_eq_u32 %0, 0\n\ts_cbranch_scc1 .Lpg8rl%=\n\ts_waitcnt vmcnt(8)\n.Lpg8rl%=:\n\ts_waitcnt vmcnt(%1)" :: "s"(t), "n"(8 + Epi::NST) : "memory", "scc"));
            else PG8_KPAIR(PG8_WAIT_V(8));
#undef PG8_KPAIR
            } else {
            PG8_LDB(B0, 0, 0); PG8_SCHED; PG8_LDA(At, 0, 0); PG8_STAGE(PG8_SA(1, 1), a1 + hstep, voffA);
            PG8_WAIT_L(8); PG8_BAR; PG8_WAIT_L(0); PG8_MMA(0, 0, At, B0); PG8_BAR; PG8_SCHED;
            PG8_LDB(B1, 0, 1); PG8_STAGE(PG8_SB(0, 0), b2, voffB);
            PG8_BAR; PG8_WAIT_L(0); PG8_MMA(0, 1, At, B1); PG8_BAR;
            PG8_LDA(At, 0, 1); PG8_STAGE(PG8_SA(0, 0), a2, voffA);
            PG8_BAR; PG8_WAIT_L(0); PG8_MMA(1, 0, At, B0); PG8_BAR; PG8_SCHED;
            PG8_STAGE(PG8_SB(0, 1), b2 + hstep, voffB);
            PG8_WAIT_V(6); PG8_BAR; PG8_MMA(1, 1, At, B1); PG8_BAR;
            PG8_LDB(B0, 1, 0); PG8_SCHED; PG8_LDA(At, 1, 0); PG8_STAGE(PG8_SA(0, 1), a2 + hstep, voffA);
            PG8_WAIT_L(8); PG8_BAR; PG8_WAIT_L(0); PG8_MMA(0, 0, At, B0); PG8_BAR; PG8_SCHED;
            PG8_LDB(B1, 1, 1); PG8_STAGE(PG8_SB(1, 0), b3, voffB);
            PG8_BAR; PG8_WAIT_L(0); PG8_MMA(0, 1, At, B1); PG8_BAR;
            PG8_LDA(At, 1, 1); PG8_STAGE(PG8_SA(1, 0), a3, voffA);
            PG8_BAR; PG8_WAIT_L(0); PG8_MMA(1, 0, At, B0); PG8_BAR; PG8_SCHED;
            PG8_STAGE(PG8_SB(1, 1), b3 + hstep, voffB);
            PG8_WAIT_V(6); PG8_BAR; PG8_MMA(1, 1, At, B1); PG8_BAR;
            }
        }
        if constexpr (ALIGN_EPI) { if (wr == 0) PG8_BAR; }
        if constexpr (!Epi::AFTER_DRAIN) { E(acc, cur, wr, wc, fr, fq); S.done(cur); }
        if (!has_next) break;
#pragma unroll
        for (int a = 0; a < 2; ++a)
#pragma unroll
            for (int b = 0; b < 2; ++b)
#pragma unroll
                for (int m = 0; m < 4; ++m)
#pragma unroll
                    for (int n = 0; n < 2; ++n) acc[a][b][m][n] = (f32x4){0.f, 0.f, 0.f, 0.f};
        cur = nxt; cA = nA; cB = nB; ++ui;
        if constexpr (ALIGN_EPI) { if (wr == 1) PG8_BAR; }
    }
    PG8_WAIT_V(0);
    if constexpr (!ALIGN_EPI) { if (wr == 0) PG8_BAR; }
    PG8_BAR;
    if constexpr (Epi::AFTER_DRAIN) { E.fused(acc, cur, wr, wc, fr, fq, lds, wid, lane); S.done(cur); }
#undef PG8_SA
#undef PG8_SB
#undef PG8_STAGE
#undef PG8_LDA
#undef PG8_LDB
#undef PG8_MMA
#undef PG8_WAIT_V
#undef PG8_WAIT_L
#undef PG8_BAR
#undef PG8_SCHED
}
}
#ifndef ATTN_MFMA
#define ATTN_MFMA 1
#endif
constexpr int NWAVES = 8;
constexpr int BATCH = 2, SEQ = 4096, DM = 2048, MTOK = BATCH * SEQ;
constexpr int NH = 16, HD = 128, NKV = 4;
constexpr int IH = 8, ID = 64, TOPK = 256;
constexpr int DFF = 8192, DIN = 11848, NP = 12032;
constexpr float EPS = 1e-6f;
constexpr float QSCALE = 0.08838834764831845f * 1.4426950408889634f;
constexpr float IDX_SCALE = 0.35355339059327373f * 0.125f;

constexpr size_t MiB = 1u << 20;
constexpr size_t WS_CTL = 0, CTL_ZERO_BYTES = 64 * 1024;
constexpr size_t WS_RS1 = 1 * MiB;
constexpr size_t WS_BTAB = 1 * MiB + 64 * 1024;
constexpr size_t WS_WI = 1 * MiB + 256 * 1024;
constexpr size_t WS_WSB = 1 * MiB + 512 * 1024;
constexpr size_t WS_VST = 2 * MiB;
constexpr size_t WS_SSQ2 = 4 * MiB, WS_SSQ3 = 5 * MiB;
constexpr size_t WS_KI = 6 * MiB;
constexpr size_t WS_WIN = 8 * MiB;
constexpr size_t WS_WOUT = 56 * MiB;
constexpr size_t WS_W1 = 64 * MiB;
constexpr size_t WS_W2 = 96 * MiB;
constexpr size_t WS_XB = 128 * MiB;
constexpr size_t WS_MASK = 160 * MiB;
constexpr size_t WS_Q2 = 164 * MiB;
constexpr size_t WS_K2 = 196 * MiB, WS_V2 = 204 * MiB;
constexpr size_t WS_QI = 212 * MiB;
constexpr size_t WS_GU = 220 * MiB, WS_GV = 252 * MiB, WS_SGA = 284 * MiB, WS_SGB = 316 * MiB;
constexpr size_t WS_MERGED = WS_XB;
constexpr size_t WS_H2 = 164 * MiB;
constexpr size_t WS_FF = 196 * MiB;
constexpr size_t WS_LM = 348 * MiB;
constexpr size_t WS_PADD = 364 * MiB;
constexpr size_t WS_END = 368 * MiB;
static_assert(WS_WIN + (size_t)NP * DM * 2 <= WS_WOUT && WS_FF + (size_t)MTOK * DFF * 2 <= WS_LM, "d_ws map");
constexpr int CW_BAR = 1024;

#ifndef XB_EARLY_WB
#define XB_EARLY_WB 0
#endif
constexpr int RING_BYTES = 147456;
constexpr int LDSCTL_OFF = RING_BYTES, MISC_OFF = LDSCTL_OFF + 320;
constexpr int LDS_BYTES = RING_BYTES + 1024;

#define GAS __attribute__((address_space(1)))
#define LAS __attribute__((address_space(3)))
typedef unsigned short bf16;
typedef unsigned v4u __attribute__((ext_vector_type(4)));
typedef float f32x4 __attribute__((ext_vector_type(4)));
typedef float f32x2 __attribute__((ext_vector_type(2)));
typedef float f32x16 __attribute__((ext_vector_type(16)));
typedef short bf16x8 __attribute__((ext_vector_type(8)));
typedef GAS unsigned gu32;
#define LDS_WAIT() asm volatile("s_waitcnt lgkmcnt(0)" ::: "memory")
#define VM_WAIT() asm volatile("s_waitcnt vmcnt(0)" ::: "memory")
__device__ __forceinline__ unsigned f2bf(float f) { unsigned u = __builtin_bit_cast(unsigned, f); return (u + 0x7fffu + ((u >> 16) & 1u)) >> 16; }
__device__ __forceinline__ unsigned pk2(float lo, float hi) { unsigned r; asm("v_cvt_pk_bf16_f32 %0, %1, %2" : "=v"(r) : "v"(lo), "v"(hi)); return r; }
__device__ __forceinline__ float bf_lo(unsigned w) { return __uint_as_float(w << 16); }
__device__ __forceinline__ float bf_hi(unsigned w) { return __uint_as_float(w & 0xffff0000u); }
#define XB_TMO      128
#define XB_XCNT(j)  (256  + 64 * (j))
#define XB_XSUB(j)  (1280 + 64 * (j))
#define XB_XGEN(j)  (2304 + 64 * (j))
#define XB_TOP      3328
#define XB_TOPGEN   3392
#define XCD_BAR_WORDS 3456
#define XB_SPIN_CAP (1u << 18)

__device__ __forceinline__ unsigned xb_ld(unsigned* p)              { return __hip_atomic_load(p, __ATOMIC_RELAXED, __HIP_MEMORY_SCOPE_AGENT); }
__device__ __forceinline__ unsigned xb_add(unsigned* p, unsigned v) { return __hip_atomic_fetch_add(p, v, __ATOMIC_RELAXED, __HIP_MEMORY_SCOPE_AGENT); }
__device__ __forceinline__ unsigned xb_xcc_id() { return (unsigned)__builtin_amdgcn_s_getreg((3 << 11) | 20) & 0xFu; }
#define XB_SPIN(cond, bar) do { unsigned _sp = 0; while (cond) { __builtin_amdgcn_s_sleep(1); \
    if ((++_sp & 255u) == 0u) { if (xb_ld(&(bar)[XB_TMO])) break; if (_sp > XB_SPIN_CAP) { atomicAdd(&(bar)[XB_TMO], 1u); break; } } } } while (0)

struct XcdBarrier {
    unsigned* bar; unsigned x;
    volatile LAS unsigned* st;
};

__device__ __forceinline__ XcdBarrier xcd_barrier_post(unsigned* bar, volatile LAS unsigned* st) {
    XcdBarrier b; b.bar = bar; b.x = xb_xcc_id(); b.st = st;
    if (threadIdx.x == 0) (void)xb_add(&bar[XB_XCNT(b.x)], 1u);
    return b;
}
__device__ __forceinline__ void xcd_barrier_complete(unsigned* bar, unsigned x, unsigned& nloc, unsigned& nx) {
    const unsigned G = gridDim.x * gridDim.y * gridDim.z;
    unsigned sum, cnt, mine, sp = 0u;
    for (;;) {
        sum = 0u; cnt = 0u; mine = 0u;
#pragma unroll
        for (unsigned j = 0; j < 16; ++j) { const unsigned c = xb_ld(&bar[XB_XCNT(j)]); sum += c; cnt += (c > 0u) ? 1u : 0u; mine = (j == x) ? c : mine; }
        if (sum == G) break;
        __builtin_amdgcn_s_sleep(1);
        if ((++sp & 255u) == 0u) { if (xb_ld(&bar[XB_TMO])) break; if (sp > XB_SPIN_CAP) { atomicAdd(&bar[XB_TMO], 1u); break; } }
    }
    nloc = mine > 0u ? mine : 1u; nx = cnt > 0u ? cnt : 1u;
}

__device__ __forceinline__ void xcd_barrier(const XcdBarrier& b) {
    asm volatile("s_waitcnt vmcnt(0)" ::: "memory");
    __syncthreads();
    if (threadIdx.x == 0) {
        unsigned* bar = b.bar;
        __builtin_amdgcn_s_waitcnt(0);
        unsigned nloc = b.st[0], nx = b.st[1];
        if (nloc == 0u) { xcd_barrier_complete(bar, b.x, nloc, nx); b.st[0] = nloc; b.st[1] = nx; }
#if XB_EARLY_WB
        asm volatile("buffer_wbl2 sc1" ::: "memory");
#endif
        const unsigned old = xb_add(&bar[XB_XSUB(b.x)], 1u);
        const unsigned gen = old / nloc;
        if (old + 1u == (gen + 1u) * nloc) {
            __builtin_amdgcn_fence(__ATOMIC_RELEASE, "agent");
            asm volatile("s_waitcnt vmcnt(0)" ::: "memory");
            const unsigned og = xb_add(&bar[XB_TOP], 1u);
            const unsigned tg = og / nx;
            if (og + 1u == (tg + 1u) * nx) xb_add(&bar[XB_TOPGEN], 1u);
            else XB_SPIN(xb_ld(&bar[XB_TOPGEN]) == tg, bar);
            __builtin_amdgcn_fence(__ATOMIC_ACQUIRE, "agent");
            xb_add(&bar[XB_XGEN(b.x)], 1u);
            asm volatile("s_waitcnt vmcnt(0)" ::: "memory");
        } else {
            XB_SPIN(xb_ld(&bar[XB_XGEN(b.x)]) == gen, bar);
            __builtin_amdgcn_fence(__ATOMIC_ACQUIRE, "agent");
            asm volatile("s_waitcnt vmcnt(0)" ::: "memory");
        }
    }
    __syncthreads();
}
struct Args { const float* in[13]; float* out; unsigned char* ws; int ph_lo, ph_hi; };
struct Frame {
    LAS unsigned char* lds; volatile LAS unsigned* MISC; gu32* ctl;
    int tid, lane, wave, vcu, G;
};
#define IN_X(A) ((A).in[0])
#define IN_RELB(A) ((A).in[1])
#define IN_N1G(A) ((A).in[2])
#define IN_WIN(A) ((A).in[3])
#define IN_LNG(A) ((A).in[4])
#define IN_LNB(A) ((A).in[5])
#define IN_SGUW(A) ((A).in[6])
#define IN_SGUB(A) ((A).in[7])
#define IN_WOUT(A) ((A).in[8])
#define IN_N2G(A) ((A).in[9])
#define IN_W1(A) ((A).in[10])
#define IN_W2(A) ((A).in[11])
#define IN_FING(A) ((A).in[12])
#define WSP(A, T, off) ((T*)((A).ws + (off)))
__device__ __forceinline__ float wave_sum(float v) {
#pragma unroll
    for (int o = 1; o < 64; o <<= 1) v += __shfl_xor(v, o);
    return v;
}
__device__ __forceinline__ float wave_max(float v) {
#pragma unroll
    for (int o = 1; o < 64; o <<= 1) v = fmaxf(v, __shfl_xor(v, o));
    return v;
}
struct CvItem { const float* W; const float* gk; bf16* WT; int K, N, nrow0, src0, nvalid, k0; };
__device__ __forceinline__ void cv_issue(float (&v)[32], const CvItem& it, int lane) {
    const bool ok = (lane & 31) < it.nvalid; const float* wp = it.W + (size_t)(it.k0 + (lane >> 5)) * it.N + it.src0 + (lane & 31);
#pragma unroll
    for (int i = 0; i < 32; ++i) v[i] = ok ? __builtin_nontemporal_load(wp + (size_t)(2 * i) * it.N) : 0.f;
}
__device__ __forceinline__ void cv_finish(float (&v)[32], const CvItem& it, LAS float* scr, int lane) {
    if (it.gk) { const float* gp = it.gk + it.k0 + (lane >> 5);
#pragma unroll
        for (int i = 0; i < 32; ++i) v[i] *= gp[2 * i]; }
#pragma unroll
    for (int i = 0; i < 32; ++i) scr[(2 * i + (lane >> 5)) * 33 + (lane & 31)] = v[i];
    LDS_WAIT(); asm volatile("" ::: "memory");
    const int c = lane & 7;
#pragma unroll
    for (int j = 0; j < 4; ++j) { const int n = (lane >> 3) + 8 * j; const LAS float* s = scr + (8 * c) * 33 + n;
        v4u o; o.x = pk2(s[0 * 33], s[1 * 33]); o.y = pk2(s[2 * 33], s[3 * 33]); o.z = pk2(s[4 * 33], s[5 * 33]); o.w = pk2(s[6 * 33], s[7 * 33]);
        *(GAS v4u*)(it.WT + (size_t)(it.nrow0 + n) * it.K + it.k0 + 8 * c) = o; }
    LDS_WAIT(); asm volatile("" ::: "memory");
}
constexpr int CV_KB2 = DM / 64, CV_KB8 = DFF / 64;
constexpr int CV_I_IN = CV_KB2 * (NP / 32), CV_I_OUT = CV_KB2 * (DM / 32), CV_I_1 = CV_KB2 * (DFF / 32), CV_I_2 = CV_KB8 * (DM / 32), CV_I_LATE = CV_I_OUT + CV_I_1 + CV_I_2;
__device__ __forceinline__ CvItem cv_item_in(const Args& A, int r) {
    const int nb = r / CV_KB2, kb = r % CV_KB2, nphys = nb * 32, n0 = pg8::proj_logical_tile(nphys >> 8) * 256 + (nphys & 255); int src0, nvalid;
    if (n0 < 3584) { src0 = n0; nvalid = 32; }
    else if (n0 < 3840) { const int j0 = n0 - 3584; src0 = 3584 + j0; nvalid = 72 - j0; nvalid = nvalid < 0 ? 0 : (nvalid > 32 ? 32 : nvalid); }
    else { src0 = n0 - 3840 + 3656; nvalid = 32; }
    return CvItem{IN_WIN(A), IN_N1G(A), WSP(A, bf16, WS_WIN), DM, DIN, nphys, src0, nvalid, kb * 64};
}
__device__ __forceinline__ CvItem cv_item_late(const Args& A, int r) {
    if (r < CV_I_OUT) { const int nb = r / CV_KB2, kb = r % CV_KB2; return CvItem{IN_WOUT(A), nullptr, WSP(A, bf16, WS_WOUT), DM, DM, nb * 32, nb * 32, 32, kb * 64}; }
    r -= CV_I_OUT;
    if (r < CV_I_1) { const int nb = r / CV_KB2, kb = r % CV_KB2; return CvItem{IN_W1(A), IN_N2G(A), WSP(A, bf16, WS_W1), DM, DFF, nb * 32, nb * 32, 32, kb * 64}; }
    r -= CV_I_1;
    { const int nb = r / CV_KB8, kb = r % CV_KB8; return CvItem{IN_W2(A), nullptr, WSP(A, bf16, WS_W2), DFF, DM, nb * 32, nb * 32, 32, kb * 64}; }
}
__device__ __forceinline__ void p0_prologue(Frame& F, const Args& A, bool late_in_prologue) {
    LAS float* scr = (LAS float*)(F.lds + F.wave * 18432);
    const int gw = F.vcu * NWAVES + F.wave, NGW = F.G * NWAVES, lane = F.lane;
    const int nitems = late_in_prologue ? CV_I_IN + CV_I_LATE : CV_I_IN;
    for (int it = gw; it < nitems; it += 2 * NGW) {
        const CvItem c0 = it < CV_I_IN ? cv_item_in(A, it) : cv_item_late(A, it - CV_I_IN); const int it1 = it + NGW; const bool two = it1 < nitems;
        const CvItem c1 = it1 < CV_I_IN ? cv_item_in(A, it1) : cv_item_late(A, (two ? it1 : it) - CV_I_IN);
        float v0[32], v1[32]; cv_issue(v0, c0, lane); if (two) cv_issue(v1, c1, lane);
        cv_finish(v0, c0, scr, lane); if (two) cv_finish(v1, c1, scr + 2112, lane);
    }
    for (int i = (F.vcu * NWAVES * 64 + F.tid); i < 16 * 128 * 128 / 4; i += F.G * NWAVES * 64) { const int e = i * 4, t = (e >> 7) & 127, s0 = e & 127;
        const f32x4 v = *(const f32x4*)(IN_SGUW(A) + e);
        const unsigned lo = pk2(s0 <= t ? v[0] : 0.f, s0 + 1 <= t ? v[1] : 0.f), hi2 = pk2(s0 + 2 <= t ? v[2] : 0.f, s0 + 3 <= t ? v[3] : 0.f);
        *(unsigned long long*)(WSP(A, bf16, WS_WSB) + e) = (unsigned long long)lo | ((unsigned long long)hi2 << 32); }
    for (int m = gw; m < MTOK; m += NGW) {
        const GAS f32x4* xr = (const GAS f32x4*)(IN_X(A) + (size_t)m * DM) + lane; f32x4 v[8]; float ss = 0.f;
#pragma unroll
        for (int j = 0; j < 8; ++j) { v[j] = __builtin_nontemporal_load(xr + 64 * j); ss += (v[j].x * v[j].x + v[j].y * v[j].y) + (v[j].z * v[j].z + v[j].w * v[j].w); }
        ss = wave_sum(ss);
        const float rs = 1.0f / sqrtf(ss * (1.0f / DM) + EPS);
        GAS unsigned long long* o8 = (GAS unsigned long long*)(WSP(A, bf16, WS_XB) + (size_t)m * DM) + lane;
#pragma unroll
        for (int j = 0; j < 8; ++j) o8[64 * j] = (unsigned long long)pk2(v[j].x * rs, v[j].y * rs) | ((unsigned long long)pk2(v[j].z * rs, v[j].w * rs) << 32);
    }
    if (blockIdx.x == 0) {
        for (int i = F.tid; i < 128 * 16; i += NWAVES * 64) { const int n = i >> 4, h = i & 15; int bk;
            if (n < 16) bk = n; else { bk = 16 + (int)(logf((float)n / 16.0f) / 2.0794415416798357f * 16.0f); bk = bk > 31 ? 31 : bk; }
            WSP(A, float, WS_BTAB)[i] = (IN_RELB(A)[bk * 16 + h] - IN_RELB(A)[31 * 16 + h]) * 1.4426950408889634f; }
    }
}
__device__ __forceinline__ unsigned fkey(float f) { const unsigned u = __float_as_uint(f); return (u & 0x80000000u) ? ~u : (u | 0x80000000u); }
__device__ __forceinline__ int mbcnt64(unsigned long long m) { return __builtin_amdgcn_mbcnt_hi((unsigned)(m >> 32), __builtin_amdgcn_mbcnt_lo((unsigned)m, 0u)); }
__device__ __forceinline__ int wave_sum_i(int x) {
    x += __builtin_amdgcn_update_dpp(0, x, 0xB1, 0xF, 0xF, true);
    x += __builtin_amdgcn_update_dpp(0, x, 0x4E, 0xF, 0xF, true);
    x += __builtin_amdgcn_update_dpp(0, x, 0x141, 0xF, 0xF, true);
    x += __builtin_amdgcn_update_dpp(0, x, 0x140, 0xF, 0xF, true);
    return __builtin_amdgcn_readlane(x, 0) + __builtin_amdgcn_readlane(x, 16) + __builtin_amdgcn_readlane(x, 32) + __builtin_amdgcn_readlane(x, 48);
}
__device__ __forceinline__ unsigned wave_max_u(unsigned x) {
    x = max(x, (unsigned)__builtin_amdgcn_update_dpp(0, (int)x, 0xB1, 0xF, 0xF, true));
    x = max(x, (unsigned)__builtin_amdgcn_update_dpp(0, (int)x, 0x4E, 0xF, 0xF, true));
    x = max(x, (unsigned)__builtin_amdgcn_update_dpp(0, (int)x, 0x141, 0xF, 0xF, true));
    x = max(x, (unsigned)__builtin_amdgcn_update_dpp(0, (int)x, 0x140, 0xF, 0xF, true));
    return max(max((unsigned)__builtin_amdgcn_readlane((int)x, 0), (unsigned)__builtin_amdgcn_readlane((int)x, 16)), max((unsigned)__builtin_amdgcn_readlane((int)x, 32), (unsigned)__builtin_amdgcn_readlane((int)x, 48)));
}
template <int NJ> __device__ __forceinline__ unsigned long long select_query(const LAS unsigned* sk, int lane) {
    unsigned v[NJ];
#pragma unroll
    for (int j = 0; j < NJ; ++j) v[j] = sk[lane + 64 * j];
    unsigned prefix = 0u; bool exact = false; int bit0 = 31;
    auto count_ge = [&](unsigned cand_) -> int { const unsigned cand = __builtin_amdgcn_readfirstlane(cand_); int c0 = 0, c1 = 0, c2 = 0, c3 = 0;
#define CNT_GE8(j0) asm volatile( \
            "v_cmp_le_u32_e32 vcc, %4, %5\n\tv_addc_co_u32_e32 %0, vcc, 0, %0, vcc\n\tv_cmp_le_u32_e32 vcc, %4, %6\n\tv_addc_co_u32_e32 %1, vcc, 0, %1, vcc\n\t" \
            "v_cmp_le_u32_e32 vcc, %4, %7\n\tv_addc_co_u32_e32 %2, vcc, 0, %2, vcc\n\tv_cmp_le_u32_e32 vcc, %4, %8\n\tv_addc_co_u32_e32 %3, vcc, 0, %3, vcc\n\t" \
            "v_cmp_le_u32_e32 vcc, %4, %9\n\tv_addc_co_u32_e32 %0, vcc, 0, %0, vcc\n\tv_cmp_le_u32_e32 vcc, %4, %10\n\tv_addc_co_u32_e32 %1, vcc, 0, %1, vcc\n\t" \
            "v_cmp_le_u32_e32 vcc, %4, %11\n\tv_addc_co_u32_e32 %2, vcc, 0, %2, vcc\n\tv_cmp_le_u32_e32 vcc, %4, %12\n\tv_addc_co_u32_e32 %3, vcc, 0, %3, vcc" \
            : "+v"(c0), "+v"(c1), "+v"(c2), "+v"(c3) : "s"(cand), "v"(v[j0]), "v"(v[j0 + 1]), "v"(v[j0 + 2]), "v"(v[j0 + 3]), "v"(v[j0 + 4]), "v"(v[j0 + 5]), "v"(v[j0 + 6]), "v"(v[j0 + 7]) : "vcc")
#pragma unroll
        for (int j = 0; j < NJ; j += 8) CNT_GE8(j);
#undef CNT_GE8
        return wave_sum_i((c0 + c1) + (c2 + c3)); };
    if (NJ >= 24) {
        unsigned m = v[0];
#pragma unroll
        for (int j = 1; j < NJ; ++j) m = max(m, v[j]);
        unsigned cand = wave_max_u(m) & 0xFF800000u;
        for (int s = 0; s < 4; ++s) {
            const int c = count_ge(cand);
            if (c >= TOPK) { prefix = cand; bit0 = 22; exact = (c == TOPK); break; }
            if (cand < 0x00800000u) break;
            cand -= 0x00800000u;
        }
    }
    if (!exact) for (int bit = bit0; bit >= 0; --bit) {
        const unsigned cand = prefix | (1u << bit);
        const int c = count_ge(cand);
        if (c >= TOPK) { prefix = cand; if (c == TOPK) { exact = true; break; } }
    }
    unsigned mlo = 0u, mhi = 0u;
    if (exact) {
#pragma unroll
        for (int j = 0; j < NJ; ++j) { const unsigned long long bsel = __ballot(v[j] >= prefix); if (lane == j) { mlo = (unsigned)bsel; mhi = (unsigned)(bsel >> 32); } asm volatile("" : "+v"(mlo), "+v"(mhi)); }
    } else {
        int g0 = 0, g1 = 0; const unsigned pfx = __builtin_amdgcn_readfirstlane(prefix);
#define CNT_GT(acc, val) asm volatile("v_cmp_lt_u32_e32 vcc, %1, %2\n\tv_addc_co_u32_e32 %0, vcc, 0, %0, vcc" : "+v"(acc) : "s"(pfx), "v"(val) : "vcc")
#pragma unroll
        for (int j = 0; j < NJ; j += 2) { CNT_GT(g0, v[j]); CNT_GT(g1, v[j + 1]); }
#undef CNT_GT
        int rem = TOPK - wave_sum_i(g0 + g1);
#pragma unroll
        for (int j = 0; j < NJ; ++j) { const unsigned long long eq = __ballot(v[j] == prefix);
            const bool take = (v[j] > prefix) || ((v[j] == prefix) && (mbcnt64(eq) < rem));
            const unsigned long long bsel = __ballot(take); rem -= __builtin_popcountll(eq); rem = rem < 0 ? 0 : rem;
            if (lane == j) { mlo = (unsigned)bsel; mhi = (unsigned)(bsel >> 32); } asm volatile("" : "+v"(mlo), "+v"(mhi)); }
    }
    return (unsigned long long)mlo | ((unsigned long long)mhi << 32);
}
struct IdxFrag { bf16x8 qa[2][4]; float w[2][2][8]; };
__device__ __forceinline__ void idx_load_frag_q(IdxFrag& f, Frame& F, const Args& A, int b, int t0) {
    const int lane = F.lane, rho = lane & 31, half = lane >> 5, blk = rho >> 2;
    const int q4 = (blk >> 2) + 2 * (blk & 1), hd = (rho & 3) + 4 * ((blk >> 1) & 1);
#pragma unroll
    for (int R = 0; R < 2; ++R)
#pragma unroll
        for (int ks = 0; ks < 4; ++ks) f.qa[R][ks] = *(const bf16x8*)(WSP(A, bf16, WS_QI) + ((size_t)(b * SEQ + t0 + 4 * R + q4) * 512 + hd * 64 + ks * 16 + half * 8));
}
__device__ __forceinline__ void idx_load_frag_w(IdxFrag& f, Frame& F, const Args& A, int b, int t0) {
    const int half = F.lane >> 5;
#pragma unroll
    for (int R = 0; R < 2; ++R)
#pragma unroll
        for (int lq = 0; lq < 2; ++lq) { const float* wp = WSP(A, float, WS_WI) + (size_t)(b * SEQ + t0 + 4 * R + 2 * half + lq) * 8; const f32x4 a = *(const f32x4*)wp, c = *(const f32x4*)(wp + 4);
            f.w[R][lq][0] = a[0]; f.w[R][lq][1] = a[1]; f.w[R][lq][2] = a[2]; f.w[R][lq][3] = a[3]; f.w[R][lq][4] = c[0]; f.w[R][lq][5] = c[1]; f.w[R][lq][6] = c[2]; f.w[R][lq][7] = c[3]; }
}
__device__ __forceinline__ void idx_load_frag(IdxFrag& f, Frame& F, const Args& A, int b, int t0) { idx_load_frag_q(f, F, A, b, t0); idx_load_frag_w(f, F, A, b, t0); }
__device__ __forceinline__ float fmac_s(float a, float b, float c) { asm("v_fmac_f32_e32 %0, %1, %2" : "+v"(c) : "v"(a), "v"(b)); return c; }
__device__ __forceinline__ float relu1(float x) { const int i = __builtin_bit_cast(int, x); return __builtin_bit_cast(float, i > 0 ? i : 0); }
template <int V = 0> __device__ __forceinline__ void idx_scores(const IdxFrag& f, Frame& F, const Args& A, int b, int t0, int stride) {
    LAS unsigned* SK = (LAS unsigned*)F.lds;
    const int lane = F.lane, rho = lane & 31, half = lane >> 5;
    const int ntv = (t0 + 8 + 31) >> 5, nta = stride >> 5;
    const bf16* kbase = WSP(A, bf16, WS_KI) + (size_t)(b * (SEQ / 32)) * 2048 + lane * 8;
#define KLOAD(dst, kt_) do { const int kc_ = (kt_) < ntv ? (kt_) : ntv - 1; _Pragma("unroll") for (int ks = 0; ks < 4; ++ks) dst[ks] = *(const bf16x8*)(kbase + (size_t)kc_ * 2048 + ks * 512); } while (0)
#define KMMA(a0, a1, kb_) do { _Pragma("unroll") for (int ks = 0; ks < 4; ++ks) { a0 = __builtin_amdgcn_mfma_f32_32x32x16_bf16(f.qa[0][ks], kb_[ks], a0, 0, 0, 0); a1 = __builtin_amdgcn_mfma_f32_32x32x16_bf16(f.qa[1][ks], kb_[ks], a1, 0, 0, 0); } } while (0)
#define KOUT(a0, a1, kt_) do { if ((kt_) < ntv) { const int key = (kt_) * 32 + rho; \
        _Pragma("unroll") for (int R = 0; R < 2; ++R) _Pragma("unroll") for (int lq = 0; lq < 2; ++lq) { float s = 0.f; \
            _Pragma("unroll") for (int h = 0; h < 8; ++h) s = fmac_s(f.w[R][lq][h], relu1(R == 0 ? a0[lq * 8 + h] : a1[lq * 8 + h]), s); \
            const int ql = 4 * R + 2 * half + lq; SK[ql * stride + key] = (key <= t0 + ql) ? fkey(s) : 0u; } } } while (0)
    bf16x8 kA[4], kB[4], nA[4], nB[4];
    KLOAD(kA, F.wave); KLOAD(kB, F.wave + NWAVES);
    for (int kt = F.wave; kt < ntv; kt += 2 * NWAVES) {
        if (V != 1) { KLOAD(nA, kt + 2 * NWAVES); KLOAD(nB, kt + 3 * NWAVES); }
        f32x16 a0 = {}, a1 = {}, c0 = {}, c1 = {};
        KMMA(a0, a1, kA); KMMA(c0, c1, kB);
        if (V != 2) { KOUT(a0, a1, kt); KOUT(c0, c1, kt + NWAVES); }
        else { SK[(kt * 32 + (lane & 31)) & 4095] = __float_as_uint(a0[0] + a1[3] + c0[5] + c1[7]); }
        if (V != 1) {
#pragma unroll
        for (int ks = 0; ks < 4; ++ks) { kA[ks] = nA[ks]; kB[ks] = nB[ks]; } }
        else { asm volatile("" : "+v"(kA[0]), "+v"(kB[0])); }
    }
#undef KLOAD
#undef KMMA
#undef KOUT
    for (int kt = ntv + F.wave; kt < nta; kt += NWAVES) {
        const int key = kt * 32 + rho;
#pragma unroll
        for (int q = 0; q < 4; ++q) SK[(2 * half + (q & 1) + 4 * (q >> 1)) * stride + key] = 0u;
    }
}
#ifndef IDX_CV2
#define IDX_CV2 1
#endif
constexpr int LM_OFF = 131072;
__device__ __forceinline__ void idx_unit(IdxFrag& fr, Frame& F, const Args& A, int b, int u, int nb_, int nu, int cvi) {
    const int t0 = 8 * u, lane = F.lane, t = t0 + F.wave;
    LAS unsigned long long* LM = (LAS unsigned long long*)(F.lds + LM_OFF);
    { LAS v4u* z = (LAS v4u*)(F.lds + LM_OFF); z[F.tid] = (v4u){0u, 0u, 0u, 0u}; z[F.tid + 512] = (v4u){0u, 0u, 0u, 0u}; }
    unsigned long long word; float cv0[32], cv1[32]; const int cvj = cvi + F.G * NWAVES;
    const bool cva = cvi >= 0 && cvi < CV_I_LATE, cvb = IDX_CV2 && cvi >= 0 && cvj < CV_I_LATE; const CvItem ci0 = cv_item_late(A, cva ? cvi : 0), ci1 = cv_item_late(A, cvb ? cvj : 0);
    if (t0 + 8 <= TOPK) {
        const int nb = t + 1 - 64 * lane; word = nb >= 64 ? ~0ull : (nb > 0 ? ((1ull << nb) - 1ull) : 0ull);
        if (nu >= 32) idx_load_frag_q(fr, F, A, nb_, 8 * nu);
        if (cva) cv_issue(cv0, ci0, lane); if (cvb) cv_issue(cv1, ci1, lane);
        __syncthreads();
    } else {
        const int njc = (t0 + 8 + 511) >> 9, stride = njc * 512;
        idx_scores(fr, F, A, b, t0, stride);
        __syncthreads();
        if (!IDX_CV2) { if (nu >= 32) idx_load_frag_q(fr, F, A, nb_, 8 * nu); }
        if (cva) cv_issue(cv0, ci0, lane); if (cvb) cv_issue(cv1, ci1, lane);
        const LAS unsigned* sk = (const LAS unsigned*)F.lds + F.wave * stride;
        switch (njc) {
            case 1: word = select_query<8>(sk, lane); break;
            case 2: word = select_query<16>(sk, lane); break;
            case 3: word = select_query<24>(sk, lane); break;
            case 4: word = select_query<32>(sk, lane); break;
            case 5: word = select_query<40>(sk, lane); break;
            case 6: word = select_query<48>(sk, lane); break;
            case 7: word = select_query<56>(sk, lane); break;
            default: word = select_query<64>(sk, lane); break;
        }
        if (IDX_CV2) { if (nu >= 32) idx_load_frag_q(fr, F, A, nb_, 8 * nu); }
    }
#if !ATTN_MFMA
    WSP(A, unsigned long long, WS_MASK)[(size_t)(b * SEQ + t) * 64 + lane] = word;
#endif
    const int jmax = (t0 + 7) >> 6;
    if (lane <= jmax) {
        const int sh = 4 * F.wave;
#pragma unroll
        for (int rp = 0; rp < 32; ++rp) { const int c = 32 * (rp >> 4) + (rp & 3) + 8 * ((rp & 15) >> 2);
            const unsigned long long v = (((word >> c) & 1ull) ? (0xFull << sh) : 0ull) | (((word >> (c + 4)) & 1ull) ? (0xFull << (32 + sh)) : 0ull);
            __hip_atomic_fetch_or(&LM[rp * 64 + lane], v, __ATOMIC_RELAXED, __HIP_MEMORY_SCOPE_WORKGROUP); }
    }
    __syncthreads();
    if (cva) cv_finish(cv0, ci0, (LAS float*)(F.lds + F.wave * 16384), lane);
    if (cvb) cv_finish(cv1, ci1, (LAS float*)(F.lds + F.wave * 16384), lane);
    if (nu >= 32) idx_load_frag_w(fr, F, A, nb_, 8 * nu);
    { const int j = F.tid >> 3;
      if (j <= jmax) { const int rp0 = 4 * (F.tid & 7); const unsigned long long w0 = LM[rp0 * 64 + j], w1 = LM[(rp0 + 1) * 64 + j], w2 = LM[(rp0 + 2) * 64 + j], w3 = LM[(rp0 + 3) * 64 + j];
          v4u* d = (v4u*)(WSP(A, unsigned long long, WS_LM) + ((size_t)(b * 512 + u) * 64) * 32) + F.tid * 2;
          d[0] = (v4u){(unsigned)w0, (unsigned)(w0 >> 32), (unsigned)w1, (unsigned)(w1 >> 32)}; d[1] = (v4u){(unsigned)w2, (unsigned)(w2 >> 32), (unsigned)w3, (unsigned)(w3 >> 32)}; } }
    __syncthreads();
}
__device__ __forceinline__ void idx_unit_probe(Frame& F, const Args& A, int b, int u, int mode) {
    const int t0 = 8 * u, lane = F.lane;
    if (t0 + 8 <= TOPK) return;
    const int njc = (t0 + 8 + 511) >> 9, stride = njc * 512;
    IdxFrag fr; idx_load_frag(fr, F, A, b, t0);
    if (mode == 2) idx_scores<1>(fr, F, A, b, t0, stride); else if (mode == 3) idx_scores<2>(fr, F, A, b, t0, stride); else idx_scores(fr, F, A, b, t0, stride);
    __syncthreads();
    if (mode == 1) {
        const LAS unsigned* sk = (const LAS unsigned*)F.lds + F.wave * stride; unsigned long long word;
        switch (njc) {
            case 1: word = select_query<8>(sk, lane); break;
            case 2: word = select_query<16>(sk, lane); break;
            case 3: word = select_query<24>(sk, lane); break;
            case 4: word = select_query<32>(sk, lane); break;
            case 5: word = select_query<40>(sk, lane); break;
            case 6: word = select_query<48>(sk, lane); break;
            case 7: word = select_query<56>(sk, lane); break;
            default: word = select_query<64>(sk, lane); break;
        }
        if (word == 0x123456789abcdef1ull) WSP(A, unsigned long long, WS_MASK)[0] = word;
    }
    __syncthreads();
}
__device__ __forceinline__ void sgu_unit(Frame& F, const Args& A, int b, int c, int g) {
    LAS float* VN = (LAS float*)F.lds;
    LAS float* WT = (LAS float*)(F.lds + 65536);
    LAS float* ST = (LAS float*)(F.lds + 65536 + 66048);
    const int tid = F.tid, m0 = b * SEQ + c * 128, ch0 = g * 128;
    if (tid < 128) { const float* p = WSP(A, float, WS_VST) + (size_t)(m0 + tid) * 64; float s = 0.f, q = 0.f;
#pragma unroll
        for (int i = 0; i < 16; ++i) { const f32x4 v = *(const f32x4*)(p + 4 * i); s += v[0] + v[2]; q += v[1] + v[3]; }
        const float mean = s * (1.0f / 2048.0f), var = q * (1.0f / 2048.0f) - mean * mean;
        ST[2 * tid] = mean; ST[2 * tid + 1] = 1.0f / sqrtf(var + EPS); }
    { const float* Wg = IN_SGUW(A) + (size_t)g * 16384;
#pragma unroll
        for (int i = 0; i < 8; ++i) { const int idx = tid + 512 * i, t = idx >> 5, s0 = (idx & 31) * 4; const f32x4 v = *(const f32x4*)(Wg + t * 128 + s0);
#pragma unroll
            for (int e = 0; e < 4; ++e) WT[t * 129 + s0 + e] = (s0 + e <= t) ? v[e] : 0.f; } }
    __syncthreads();
#pragma unroll
    for (int i = 0; i < 4; ++i) { const int idx = tid + 512 * i, row = idx >> 4, cc = (idx & 15) * 8;
        const v4u raw = *(const v4u*)(WSP(A, bf16, WS_GV) + (size_t)(m0 + row) * 2048 + ch0 + cc);
        const float mean = ST[2 * row], rstd = ST[2 * row + 1];
        const f32x4 g0 = *(const f32x4*)(IN_LNG(A) + ch0 + cc), g1 = *(const f32x4*)(IN_LNG(A) + ch0 + cc + 4), b0 = *(const f32x4*)(IN_LNB(A) + ch0 + cc), b1 = *(const f32x4*)(IN_LNB(A) + ch0 + cc + 4);
        f32x4 o0, o1;
        o0[0] = (bf_lo(raw.x) - mean) * rstd * g0[0] + b0[0]; o0[1] = (bf_hi(raw.x) - mean) * rstd * g0[1] + b0[1];
        o0[2] = (bf_lo(raw.y) - mean) * rstd * g0[2] + b0[2]; o0[3] = (bf_hi(raw.y) - mean) * rstd * g0[3] + b0[3];
        o1[0] = (bf_lo(raw.z) - mean) * rstd * g1[0] + b1[0]; o1[1] = (bf_hi(raw.z) - mean) * rstd * g1[1] + b1[1];
        o1[2] = (bf_lo(raw.w) - mean) * rstd * g1[2] + b1[2]; o1[3] = (bf_hi(raw.w) - mean) * rstd * g1[3] + b1[3];
        *(LAS f32x4*)(VN + row * 128 + cc) = o0; *(LAS f32x4*)(VN + row * 128 + cc + 4) = o1; }
    __syncthreads();
    const int t = tid >> 2, dq = tid & 3, tmax = (F.wave * 16 + 15);
    f32x4 acc[8];
#pragma unroll
    for (int i = 0; i < 8; ++i) acc[i] = (f32x4){0.f, 0.f, 0.f, 0.f};
    for (int s = 0; s <= tmax; ++s) { const float w = WT[t * 129 + s];
#pragma unroll
        for (int i = 0; i < 8; ++i) acc[i] += w * *(const LAS f32x4*)(VN + s * 128 + dq * 32 + 4 * i); }
    const float bs = IN_SGUB(A)[g * 128 + t];
    const size_t off = (size_t)(m0 + t) * 2048 + ch0 + dq * 32;
#pragma unroll
    for (int i = 0; i < 4; ++i) { const v4u gu = *(const v4u*)(WSP(A, bf16, WS_GU) + off + 8 * i), sb = *(const v4u*)(WSP(A, bf16, WS_SGB) + off + 8 * i); const f32x4 a0 = acc[2 * i], a1 = acc[2 * i + 1]; v4u o;
        o.x = pk2(bf_lo(gu.x) * (a0[0] + bs) * bf_lo(sb.x), bf_hi(gu.x) * (a0[1] + bs) * bf_hi(sb.x));
        o.y = pk2(bf_lo(gu.y) * (a0[2] + bs) * bf_lo(sb.y), bf_hi(gu.y) * (a0[3] + bs) * bf_hi(sb.y));
        o.z = pk2(bf_lo(gu.z) * (a1[0] + bs) * bf_lo(sb.z), bf_hi(gu.z) * (a1[1] + bs) * bf_hi(sb.z));
        o.w = pk2(bf_lo(gu.w) * (a1[2] + bs) * bf_lo(sb.w), bf_hi(gu.w) * (a1[3] + bs) * bf_hi(sb.w));
        *(v4u*)(WSP(A, bf16, WS_GU) + off + 8 * i) = o; }
    __syncthreads();
}
__device__ __forceinline__ void attn_gather_phase(Frame& F, const Args& A) {
    asm volatile("; ATTN_BEGIN" ::: "memory");
    const int lane = F.lane, gw = F.vcu * NWAVES + F.wave, NGW = F.G * NWAVES;
    LAS unsigned char* wl = F.lds + F.wave * 8192;
    LAS unsigned short* IDX = (LAS unsigned short*)wl;
    LAS float* QF = (LAS float*)(wl + 512);
    LAS float* PB = (LAS float*)(wl + 2560);
    for (int task = gw; task < MTOK * 4; task += NGW) {
        const int m = task >> 2, g = task & 3, b = m >> 12, t = m & 4095;
        const unsigned long long word = WSP(A, unsigned long long, WS_MASK)[(size_t)m * 64 + lane];
        int cnt = 0;
        for (int j = 0; j <= (t >> 6); ++j) {
            const unsigned lo = __builtin_amdgcn_readlane((unsigned)word, j), hi = __builtin_amdgcn_readlane((unsigned)(word >> 32), j);
            const unsigned long long wj = ((unsigned long long)hi << 32) | lo;
            if ((wj >> lane) & 1ull) IDX[cnt + mbcnt64(wj)] = (unsigned short)(64 * j + lane);
            cnt += __builtin_popcountll(wj);
        }
        { const v4u raw = *(const v4u*)(WSP(A, bf16, WS_Q2) + (((size_t)(b * 4 + g) * SEQ + t) * 4) * 128 + lane * 8);
          f32x4 a = {bf_lo(raw.x), bf_hi(raw.x), bf_lo(raw.y), bf_hi(raw.y)}, c = {bf_lo(raw.z), bf_hi(raw.z), bf_lo(raw.w), bf_hi(raw.w)};
          *(LAS f32x4*)(QF + lane * 8) = a; *(LAS f32x4*)(QF + lane * 8 + 4) = c; }
        LDS_WAIT(); asm volatile("" ::: "memory");
        const bf16* Kg = WSP(A, bf16, WS_K2) + (size_t)(b * 4 + g) * SEQ * 128; const bf16* Vg = WSP(A, bf16, WS_V2) + (size_t)(b * 4 + g) * SEQ * 128;
        float mx[4] = {-3.0e38f, -3.0e38f, -3.0e38f, -3.0e38f};
        for (int i = 0; i < 4; ++i) { const int n = lane + 64 * i;
            if (n < cnt) { const int s = IDX[n]; const bf16* kr = Kg + (size_t)s * 128; float a4[4] = {0.f, 0.f, 0.f, 0.f};
                for (int dd = 0; dd < 16; ++dd) { const v4u kraw = *(const v4u*)(kr + dd * 8);
                    const float k8[8] = {bf_lo(kraw.x), bf_hi(kraw.x), bf_lo(kraw.y), bf_hi(kraw.y), bf_lo(kraw.z), bf_hi(kraw.z), bf_lo(kraw.w), bf_hi(kraw.w)};
#pragma unroll
                    for (int h = 0; h < 4; ++h) { const f32x4 q0 = *(const LAS f32x4*)(QF + h * 128 + dd * 8), q1 = *(const LAS f32x4*)(QF + h * 128 + dd * 8 + 4);
                        a4[h] += (q0[0] * k8[0] + q0[1] * k8[1]) + (q0[2] * k8[2] + q0[3] * k8[3]) + (q1[0] * k8[4] + q1[1] * k8[5]) + (q1[2] * k8[6] + q1[3] * k8[7]); } }
                const int dist = t - s; const float* bt = WSP(A, float, WS_BTAB) + (dist < 127 ? dist : 127) * 16 + g * 4;
#pragma unroll
                for (int h = 0; h < 4; ++h) { const float l = a4[h] + bt[h]; PB[h * 256 + n] = l; mx[h] = fmaxf(mx[h], l); } } }
        float li[4];
#pragma unroll
        for (int h = 0; h < 4; ++h) { mx[h] = wave_max(mx[h]); float sm = 0.f;
            for (int i = 0; i < 4; ++i) { const int n = lane + 64 * i; if (n < cnt) { const float p = __builtin_amdgcn_exp2f(PB[h * 256 + n] - mx[h]); PB[h * 256 + n] = p; sm += p; } }
            li[h] = 1.0f / wave_sum(sm); }
        LDS_WAIT(); asm volatile("" ::: "memory");
        float o[4][2] = {{0.f, 0.f}, {0.f, 0.f}, {0.f, 0.f}, {0.f, 0.f}};
        for (int n = 0; n < cnt; ++n) { const int s = IDX[n]; const unsigned vraw = *(const unsigned*)(Vg + (size_t)s * 128 + 2 * lane); const float v0 = bf_lo(vraw), v1 = bf_hi(vraw);
#pragma unroll
            for (int h = 0; h < 4; ++h) { const float p = PB[h * 256 + n]; o[h][0] += p * v0; o[h][1] += p * v1; } }
#pragma unroll
        for (int h = 0; h < 4; ++h) { const size_t off = (size_t)m * 2048 + (g * 4 + h) * 128 + 2 * lane;
            const unsigned ga = *(const unsigned*)(WSP(A, bf16, WS_SGA) + off), sp = *(const unsigned*)(WSP(A, bf16, WS_GU) + off);
            *(unsigned*)(WSP(A, bf16, WS_MERGED) + off) = pk2(bf_lo(ga) * (o[h][0] * li[h]) + bf_lo(sp), bf_hi(ga) * (o[h][1] * li[h]) + bf_hi(sp)); }
        LDS_WAIT(); asm volatile("" ::: "memory");
    }
    asm volatile("; ATTN_END" ::: "memory");
}
__device__ __forceinline__ void final_norm_phase(Frame& F, const Args& A) {
    const int lane = F.lane, gw = F.vcu * NWAVES + F.wave, NGW = F.G * NWAVES;
    for (int m = gw; m < MTOK; m += NGW) {
        float s = lane < 32 ? WSP(A, float, WS_SSQ3)[(size_t)m * 32 + lane] : 0.f; s = wave_sum(s);
        const float rs = 1.0f / sqrtf(s * (1.0f / DM) + EPS);
        GAS f32x4* xr = (GAS f32x4*)((A).out + (size_t)m * DM) + lane; const GAS f32x4* gr = (const GAS f32x4*)IN_FING(A) + lane;
#pragma unroll
        for (int j = 0; j < 8; ++j) { const f32x4 v = xr[64 * j], g = gr[64 * j]; xr[64 * j] = v * rs * g; }
    }
}
namespace att {
constexpr int D = 128, NW = 8, QBLK = 32, KVBLK = 64, QB = 256, SHM_V = 16384, SHM_K = 16384;
constexpr int NRING = 3;
constexpr int L_V = 0, L_K = NRING * SHM_V, L_WS = L_K + NRING * SHM_K, L_BT = L_WS + NW * 64 * 4, L_OST = L_BT + 2048, L_END = L_OST + NW * 4096;
constexpr int SG_V = 0, SG_WS = 65536, SG_OST = 69632;
constexpr float THR2 = 11.5f;
#define KSWZ(row, colB) ((row) * 256 + ((colB) ^ (((row) & 7) << 4)))
#define SBAR() __builtin_amdgcn_sched_barrier(0)
typedef short s16x4 __attribute__((ext_vector_type(4)));
__device__ __forceinline__ int v_st(int k, int c) { const int kk = (k & ~0xC) | ((k & 4) << 1) | ((k & 8) >> 1); return ((kk >> 3) * 4 + (c >> 5)) * 512 + ((kk & 7) * 32 + (c & 31)) * 2; }
__device__ __forceinline__ int v_rd_base(int lane) { return ((lane & 3) << 3) | (((lane >> 2) & 3) << 6) | (((lane >> 4) & 1) << 5) | (((lane >> 5) & 1) << 8); }
constexpr int v_rd_off(int d0, int ks, int half) { return d0 * 512 + ks * 4096 + half * 2048; }
__device__ __forceinline__ int crow(int r, int hi) { return (r & 3) + 8 * (r >> 2) + 4 * hi; }
__device__ __forceinline__ unsigned cvtpk(float lo, float hi) { unsigned r; asm volatile("v_cvt_pk_bf16_f32 %0, %1, %2" : "=v"(r) : "v"(lo), "v"(hi)); return r; }
typedef unsigned u32x16 __attribute__((ext_vector_type(16)));
template <int OFF> __device__ __forceinline__ u32x16 lm_load(const void* p) { u32x16 v; asm volatile("s_load_dwordx16 %0, %1, %2 glc" : "=&s"(v) : "s"(p), "i"(OFF)); return v; }
__device__ __forceinline__ void lm_wait(u32x16& a, u32x16& b) { asm volatile("s_waitcnt lgkmcnt(0)" : "+s"(a), "+s"(b)); }
__device__ __forceinline__ void lm_apply(f32x16& p, const u32x16& a, const u32x16& b, float neg) {
#pragma unroll
    for (int k = 0; k < 8; ++k) { const unsigned long long mk = (unsigned long long)a[2 * k] | ((unsigned long long)a[2 * k + 1] << 32);
        asm volatile("v_cndmask_b32_e64 %0, %1, %0, %2" : "+v"(p[k]) : "v"(neg), "s"(mk)); }
#pragma unroll
    for (int k = 0; k < 8; ++k) { const unsigned long long mk = (unsigned long long)b[2 * k] | ((unsigned long long)b[2 * k + 1] << 32);
        asm volatile("v_cndmask_b32_e64 %0, %1, %0, %2" : "+v"(p[8 + k]) : "v"(neg), "s"(mk)); }
}
__device__ __forceinline__ void band_bias(f32x16& p0, f32x16& p1, int dq, const LAS float* bt) {
#pragma unroll
    for (int r = 0; r < 16; ++r) { const int c = (r & 3) + 8 * (r >> 2); const unsigned d0 = (unsigned)(dq - c), d1 = (unsigned)(dq - c - 32);
        p0[r] += bt[(d0 < 127u ? d0 : 127u) * 4]; p1[r] += bt[(d1 < 127u ? d1 : 127u) * 4]; }
}
__device__ __forceinline__ float fadd_s(float x, float y) { float r; asm("v_add_f32_e32 %0, %1, %2" : "=v"(r) : "v"(x), "v"(y)); return r; }
__device__ __forceinline__ float fsub_s(float x, float y) { float r; asm("v_sub_f32_e32 %0, %1, %2" : "=v"(r) : "v"(x), "v"(y)); return r; }
__device__ __forceinline__ void partialSM(f32x16& p0, f32x16& p1, float& m_reg, float& mn, float& alpha) {
    float pmax = p0[0];
#pragma unroll
    for (int r = 1; r < 16; ++r) pmax = fmaxf(pmax, p0[r]);
#pragma unroll
    for (int r = 0; r < 16; ++r) pmax = fmaxf(pmax, p1[r]);
    { auto rr = __builtin_amdgcn_permlane32_swap(__float_as_uint(pmax), __float_as_uint(pmax), false, false);
      pmax = fmaxf(__uint_as_float(rr[0]), __uint_as_float(rr[1])); }
    if (__builtin_expect(__all((pmax - m_reg) <= THR2), 1)) { mn = m_reg; alpha = 1.f; }
    else { mn = fmaxf(m_reg, pmax); alpha = __builtin_amdgcn_exp2f(m_reg - mn); m_reg = mn; }
#pragma unroll
    for (int r = 0; r < 16; ++r) { p0[r] = fsub_s(p0[r], mn); p1[r] = fsub_s(p1[r], mn); }
#pragma unroll
    for (int r = 0; r < 16; ++r) p0[r] = __builtin_amdgcn_exp2f(p0[r]);
}
__device__ __forceinline__ void finishSM(f32x16& p0, f32x16& p1, float alpha, float& l_reg, bf16x8& pa0, bf16x8& pa1, bf16x8& pa2, bf16x8& pa3) {
#pragma unroll
    for (int r = 0; r < 16; ++r) p1[r] = __builtin_amdgcn_exp2f(p1[r]);
    float ps = fadd_s(p0[0], p0[1]), ps1 = fadd_s(p0[2], p0[3]), ps2 = fadd_s(p1[0], p1[1]), ps3 = fadd_s(p1[2], p1[3]);
#pragma unroll
    for (int r = 4; r < 16; r += 2) { ps = fadd_s(ps, p0[r]); ps1 = fadd_s(ps1, p0[r + 1]); ps2 = fadd_s(ps2, p1[r]); ps3 = fadd_s(ps3, p1[r + 1]); }
    ps = fadd_s(fadd_s(ps, ps1), fadd_s(ps2, ps3));
    { auto rr = __builtin_amdgcn_permlane32_swap(__float_as_uint(ps), __float_as_uint(ps), false, false);
      ps = __uint_as_float(rr[0]) + __uint_as_float(rr[1]); }
    l_reg = l_reg * alpha + ps;
#define PK4(P, B_, OUT) do { unsigned a0 = cvtpk(P[B_+0], P[B_+1]), a1 = cvtpk(P[B_+2], P[B_+3]);                          \
        unsigned b0 = cvtpk(P[B_+4], P[B_+5]), b1 = cvtpk(P[B_+6], P[B_+7]);                                             \
        auto r0 = __builtin_amdgcn_permlane32_swap(a0, b0, false, false); auto r1 = __builtin_amdgcn_permlane32_swap(a1, b1, false, false); \
        v4u w = {r0[0], r1[0], r0[1], r1[1]}; OUT = *reinterpret_cast<bf16x8*>(&w); } while (0)
    PK4(p0, 0, pa0); PK4(p0, 8, pa1); PK4(p1, 0, pa2); PK4(p1, 8, pa3);
#undef PK4
}
template <int KB>
__device__ __forceinline__ void qkt(f32x16& p0, f32x16& p1, const char* K_lds, int r32, int hi, const bf16x8* qr) {
    p0 = f32x16{}; p1 = f32x16{};
    const char* kb[4];
#pragma unroll
    for (int dd = 0; dd < 4; ++dd) kb[dd] = K_lds + KB * SHM_K + KSWZ(r32, (dd * 16 + hi * 8) * 2);
#pragma unroll
    for (int d0 = 0; d0 < 8; ++d0) { const char* a = kb[d0 & 3] + (d0 >> 2) * 128;
        bf16x8 b0 = *reinterpret_cast<const bf16x8*>(a);
        bf16x8 b1 = *reinterpret_cast<const bf16x8*>(a + 32 * 256);
        p0 = __builtin_amdgcn_mfma_f32_32x32x16_bf16(b0, qr[d0], p0, 0, 0, 0);
        p1 = __builtin_amdgcn_mfma_f32_32x32x16_bf16(b1, qr[d0], p1, 0, 0, 0); }
}
template <int VB>
__device__ __forceinline__ void pv_tile(f32x16* o, int vb0, bf16x8 pa0, bf16x8 pa1, bf16x8 pa2, bf16x8 pa3) {
#define TRRD(dst, off) asm volatile("ds_read_b64_tr_b16 %0, %1 offset:%2" : "=&v"(dst) : "v"(vb0), "i"(off) : "memory")
#define PV_D0(d0) do { s16x4 l0, l1, l2, l3, h0, h1, h2, h3; constexpr int b_ = VB * SHM_V + v_rd_off(d0, 0, 0); \
        TRRD(l0, b_); TRRD(h0, b_ + 2048); TRRD(l1, b_ + 4096); TRRD(h1, b_ + 6144); TRRD(l2, b_ + 8192); TRRD(h2, b_ + 10240); TRRD(l3, b_ + 12288); TRRD(h3, b_ + 14336); \
        asm volatile("s_waitcnt lgkmcnt(0)" ::: "memory"); SBAR();   \
        o[d0] = __builtin_amdgcn_mfma_f32_32x32x16_bf16(pa0, (bf16x8){l0[0], l0[1], l0[2], l0[3], h0[0], h0[1], h0[2], h0[3]}, o[d0], 0, 0, 0);   \
        o[d0] = __builtin_amdgcn_mfma_f32_32x32x16_bf16(pa1, (bf16x8){l1[0], l1[1], l1[2], l1[3], h1[0], h1[1], h1[2], h1[3]}, o[d0], 0, 0, 0);   \
        o[d0] = __builtin_amdgcn_mfma_f32_32x32x16_bf16(pa2, (bf16x8){l2[0], l2[1], l2[2], l2[3], h2[0], h2[1], h2[2], h2[3]}, o[d0], 0, 0, 0);   \
        o[d0] = __builtin_amdgcn_mfma_f32_32x32x16_bf16(pa3, (bf16x8){l3[0], l3[1], l3[2], l3[3], h3[0], h3[1], h3[2], h3[3]}, o[d0], 0, 0, 0); } while (0)
    PV_D0(0); PV_D0(1); PV_D0(2); PV_D0(3);
#undef PV_D0
#undef TRRD
}
struct BlockRef { const bf16* Q; const bf16* K; const bf16* V; const unsigned long long* LMB; int qb; int m0; };
__device__ __forceinline__ bf16x8 ld8(const bf16* p) { return *reinterpret_cast<const bf16x8*>(p); }
#define ROW(p, k0, rr) ((p) + (size_t)((k0) + (rr)) * D + sc)
#define VMW() asm volatile("s_waitcnt vmcnt(0)" ::: "memory")
#define SLOAD_H(Kp, Vp, k0) do { st_v0 = ld8(ROW(Vp, k0, sr)); st_v1 = ld8(ROW(Vp, k0, 32 + sr)); st_k0 = ld8(ROW(Kp, k0, sr)); st_k1 = ld8(ROW(Kp, k0, 32 + sr)); } while (0)
#define SWRITE_H(bf) do { *(bf16x8*)(V_lds + (bf) * SHM_V + vst0) = st_v0; *(bf16x8*)(V_lds + (bf) * SHM_V + vst1) = st_v1; \
                          *(bf16x8*)(K_lds + (bf) * SHM_K + kws) = st_k0; *(bf16x8*)(K_lds + (bf) * SHM_K + kws + 32 * 256) = st_k1; } while (0)
__device__ __forceinline__ void attn_block(const BlockRef& cur, char* lds, int g4, const bf16* SGA, const bf16* SP, bf16* MERGED) {
    const int tid = threadIdx.x, wid = __builtin_amdgcn_readfirstlane(tid >> 6), lane = tid & 63, r32 = lane & 31, hi = lane >> 5;
    const bool lag = wid >= 4;
    const int NT = cur.qb + 1;
    char* V_lds = lds + L_V; char* K_lds = lds + L_K;
    float* ws = (float*)(lds + L_WS) + wid * 64; float* li_l = ws, * al_l = ws + 32;
    const LAS float* bt = (const LAS float*)((LAS char*)(lds + L_BT)) + (r32 & 3);
    const int sr = tid >> 4, sc = (tid & 15) * 8, vst0 = v_st(sr, sc), vst1 = v_st(32 + sr, sc), kws = KSWZ(sr, sc * 2);
    const int vb0 = (int)(uintptr_t)V_lds + v_rd_base(lane);
    const bf16* Kh = cur.K; const bf16* Vh = cur.V;
    const char* lmw = (const char*)(cur.LMB + (size_t)wid * 64 * 32);
    const float NEGINF = -__builtin_inff();
    const int qpos = cur.qb * 64 + wid * 8 + (r32 >> 2);
    const int qlo = cur.qb * 64 + wid * 8;
    bf16x8 qr[8], st_v0, st_v1, st_k0, st_k1;
#pragma unroll
    for (int d0 = 0; d0 < 8; ++d0) qr[d0] = ld8(cur.Q + (size_t)(wid * QBLK + r32) * D + d0 * 16 + hi * 8);
    SLOAD_H(Kh, Vh, 0); VMW(); SWRITE_H(0);
    __syncthreads();
    float m_reg = -1e30f, l_reg = 0; f32x16 o[4] = {};
    bf16x8 pa0, pa1, pa2, pa3;
    u32x16 ma_ = lm_load<0>(lmw), mb_ = lm_load<64>(lmw), mc_ = lm_load<128>(lmw), md_ = lm_load<192>(lmw);
#define STEP(BUF, NBUF_, PBUF_, t) do {                                                                                       \
        if ((t) + 1 < NT) SLOAD_H(Kh, Vh, ((t) + 1) * KVBLK);                                                                 \
        SBAR(); if (lag && (t) > 0) { __builtin_amdgcn_s_setprio(1); pv_tile<PBUF_>(o, vb0, pa0, pa1, pa2, pa3); __builtin_amdgcn_s_setprio(0); } \
        SBAR(); f32x16 p0, p1; __builtin_amdgcn_s_setprio(1); qkt<BUF>(p0, p1, K_lds, r32, hi, qr); __builtin_amdgcn_s_setprio(0);     \
        asm volatile("s_nop 15\n\ts_nop 7" : "+v"(p0), "+v"(p1));     \
        lm_wait(ma_, mb_); lm_wait(mc_, md_); lm_apply(p0, ma_, mb_, NEGINF); lm_apply(p1, mc_, md_, NEGINF);                 \
        { const char* lmp_ = lmw + (size_t)((t) + 1 < NT ? (t) + 1 : (t)) * 256;     \
          ma_ = lm_load<0>(lmp_); mb_ = lm_load<64>(lmp_); mc_ = lm_load<128>(lmp_); md_ = lm_load<192>(lmp_); }                \
        if (qlo - ((t) * KVBLK + KVBLK - 1) < 113) band_bias(p0, p1, qpos - (t) * KVBLK - 4 * hi, bt);                        \
        float mn_, al_; partialSM(p0, p1, m_reg, mn_, al_);                                                                   \
        finishSM(p0, p1, al_, l_reg, pa0, pa1, pa2, pa3);                                                                     \
        if (__any(al_ < 1.f)) { if (hi == 0) al_l[r32] = al_; asm volatile("s_waitcnt lgkmcnt(0)" ::: "memory");              \
            for (int d_ = 0; d_ < 4; ++d_) for (int r = 0; r < 16; ++r) o[d_][r] *= al_l[crow(r, hi)]; }                      \
        SBAR(); if (!lag) { __builtin_amdgcn_s_setprio(1); pv_tile<BUF>(o, vb0, pa0, pa1, pa2, pa3); __builtin_amdgcn_s_setprio(0); } \
        SBAR(); if ((t) + 1 < NT) { VMW(); SWRITE_H(NBUF_); }                                                                 \
        __syncthreads(); } while (0)
    for (int t = 0; t < NT; t += 3) { STEP(0, 1, 2, t); if (t + 1 < NT) STEP(1, 2, 0, t + 1); if (t + 2 < NT) STEP(2, 0, 1, t + 2); }
#undef STEP
    if (lag) { const int lb = (NT - 1) % 3;
        if (lb == 0) pv_tile<0>(o, vb0, pa0, pa1, pa2, pa3); else if (lb == 1) pv_tile<1>(o, vb0, pa0, pa1, pa2, pa3); else pv_tile<2>(o, vb0, pa0, pa1, pa2, pa3); }
    v4u gal[4][2], spl[4][2];
#pragma unroll
    for (int d0 = 0; d0 < 4; ++d0)
#pragma unroll
        for (int i = 0; i < 2; ++i) { const int cid = lane + 64 * i, row = cid >> 2, c8 = (cid & 3) * 8;
            const size_t off = (size_t)(cur.m0 + wid * 8 + (row >> 2)) * 2048 + (g4 * 4 + (row & 3)) * 128 + d0 * 32 + c8;
            gal[d0][i] = __builtin_nontemporal_load((const v4u*)(SGA + off)); spl[d0][i] = __builtin_nontemporal_load((const v4u*)(SP + off)); }
    if (hi == 0) li_l[r32] = l_reg; asm volatile("s_waitcnt lgkmcnt(0)" ::: "memory");
    float rli[16];
#pragma unroll
    for (int r = 0; r < 16; ++r) rli[r] = __builtin_amdgcn_rcpf(li_l[crow(r, hi)]);
    float* ost = (float*)(lds + L_OST) + wid * 1024;
#pragma unroll
    for (int d0 = 0; d0 < 4; ++d0) {
#pragma unroll
        for (int r = 0; r < 16; ++r) ost[crow(r, hi) * 32 + r32] = o[d0][r] * rli[r];
        asm volatile("s_waitcnt lgkmcnt(0)" ::: "memory");
#pragma unroll
        for (int i = 0; i < 2; ++i) { const int cid = lane + 64 * i, row = cid >> 2, c8 = (cid & 3) * 8;
            const f32x4 a = *(const f32x4*)(ost + row * 32 + c8), c = *(const f32x4*)(ost + row * 32 + c8 + 4);
            const size_t off = (size_t)(cur.m0 + wid * 8 + (row >> 2)) * 2048 + (g4 * 4 + (row & 3)) * 128 + d0 * 32 + c8;
            const v4u ga = gal[d0][i], sp = spl[d0][i]; v4u w;
            w.x = pk2(bf_lo(ga.x) * a[0] + bf_lo(sp.x), bf_hi(ga.x) * a[1] + bf_hi(sp.x)); w.y = pk2(bf_lo(ga.y) * a[2] + bf_lo(sp.y), bf_hi(ga.y) * a[3] + bf_hi(sp.y));
            w.z = pk2(bf_lo(ga.z) * c[0] + bf_lo(sp.z), bf_hi(ga.z) * c[1] + bf_hi(sp.z)); w.w = pk2(bf_lo(ga.w) * c[2] + bf_lo(sp.w), bf_hi(ga.w) * c[3] + bf_hi(sp.w));
            pg8::st16_out(MERGED + off, w); }
        asm volatile("s_waitcnt lgkmcnt(0)" ::: "memory");
    }
    __syncthreads();
}
#undef ROW
#undef VMW
#undef SLOAD_H
#undef SWRITE_H
#undef KSWZ
#undef SBAR
}

__device__ __forceinline__ void sgu_pair_unit(Frame& F, const Args& A, unsigned char* lds_generic, int b, int c, int gp, int cvi) {
    using namespace att;
    char* lds = (char*)lds_generic;
    const int tid = F.tid, wid = F.wave, lane = F.lane, r32 = lane & 31, hi = lane >> 5;
    const int m0 = b * SEQ + c * 128;
    LAS float* ST = (LAS float*)(F.lds + SG_WS);
    float cv0[32], cv1[32]; const int cvj = cvi + F.G * NWAVES; const bool cva = cvi >= 0 && cvi < CV_I_LATE, cvb = cvi >= 0 && cvj < CV_I_LATE;
    const CvItem ci0 = cv_item_late(A, cva ? cvi : 0), ci1 = cv_item_late(A, cvb ? cvj : 0);
    if (cva) cv_issue(cv0, ci0, lane); if (cvb) cv_issue(cv1, ci1, lane);
    if (tid < 128) { const float* p = WSP(A, float, WS_VST) + (size_t)(m0 + tid) * 64; float s = 0.f, q = 0.f;
#pragma unroll
        for (int i = 0; i < 16; ++i) { const f32x4 v = *(const f32x4*)(p + 4 * i); s += v[0] + v[2]; q += v[1] + v[3]; }
        const float mean = s * (1.0f / 2048.0f), var = q * (1.0f / 2048.0f) - mean * mean;
        ST[2 * tid] = mean; ST[2 * tid + 1] = 1.0f / sqrtf(var + EPS); }
    __syncthreads();
#pragma unroll
    for (int i = 0; i < 8; ++i) { const int id = tid + 512 * i, grp = id >> 11, s = (id >> 4) & 127, cc = (id & 15) * 8, ch = (2 * gp + grp) * 128 + cc;
        const v4u raw = __builtin_nontemporal_load((const v4u*)(WSP(A, bf16, WS_GV) + (size_t)(m0 + s) * 2048 + ch));
        const float mean = ST[2 * s], rstd = ST[2 * s + 1];
        const f32x4 g0 = *(const f32x4*)(IN_LNG(A) + ch), g1 = *(const f32x4*)(IN_LNG(A) + ch + 4), b0 = *(const f32x4*)(IN_LNB(A) + ch), b1 = *(const f32x4*)(IN_LNB(A) + ch + 4);
        v4u o;
        o.x = pk2((bf_lo(raw.x) - mean) * rstd * g0[0] + b0[0], (bf_hi(raw.x) - mean) * rstd * g0[1] + b0[1]);
        o.y = pk2((bf_lo(raw.y) - mean) * rstd * g0[2] + b0[2], (bf_hi(raw.y) - mean) * rstd * g0[3] + b0[3]);
        o.z = pk2((bf_lo(raw.z) - mean) * rstd * g1[0] + b1[0], (bf_hi(raw.z) - mean) * rstd * g1[1] + b1[1]);
        o.w = pk2((bf_lo(raw.w) - mean) * rstd * g1[2] + b1[2], (bf_hi(raw.w) - mean) * rstd * g1[3] + b1[3]);
        *(v4u*)(lds + SG_V + (grp * 2 + (s >> 6)) * SHM_V + v_st(s & 63, cc)) = o; }
    if (cva) cv_finish(cv0, ci0, (LAS float*)(F.lds + SG_OST + wid * 9728), lane);
    __syncthreads();
    if (cvb) cv_finish(cv1, ci1, (LAS float*)(F.lds + SG_OST + wid * 9728), lane);
    const int grp = wid >> 2, w4 = wid & 3, g = 2 * gp + grp;
    const int vb0 = (int)(uintptr_t)(lds + SG_V) + v_rd_base(lane);
    const bf16* wrow = WSP(A, bf16, WS_WSB) + ((size_t)g * 128 + 32 * w4 + r32) * 128 + 8 * hi;
    f32x16 o[4] = {};
    { const bf16x8 a0 = *(const bf16x8*)(wrow), a1 = *(const bf16x8*)(wrow + 16), a2 = *(const bf16x8*)(wrow + 32), a3 = *(const bf16x8*)(wrow + 48);
      if (grp == 0) pv_tile<0>(o, vb0, a0, a1, a2, a3); else pv_tile<2>(o, vb0, a0, a1, a2, a3); }
    if (w4 >= 2) { const bf16x8 a0 = *(const bf16x8*)(wrow + 64), a1 = *(const bf16x8*)(wrow + 80), a2 = *(const bf16x8*)(wrow + 96), a3 = *(const bf16x8*)(wrow + 112);
      if (grp == 0) pv_tile<1>(o, vb0, a0, a1, a2, a3); else pv_tile<3>(o, vb0, a0, a1, a2, a3); }
    float* ost = (float*)(lds + SG_OST + wid * 9728);
    bf16* GU = WSP(A, bf16, WS_GU); const bf16* SGB = WSP(A, bf16, WS_SGB);
#pragma unroll
    for (int hf = 0; hf < 2; ++hf) {
#pragma unroll
        for (int r = 0; r < 16; ++r) { const int orow = crow(r, hi); ost[orow * 64 + r32] = o[2 * hf][r]; ost[orow * 64 + 32 + r32] = o[2 * hf + 1][r]; }
        asm volatile("s_waitcnt lgkmcnt(0)" ::: "memory");
#pragma unroll
        for (int i = 0; i < 4; ++i) { const int cid = lane + 64 * i, row = cid >> 3, c8 = (cid & 7) * 8, t = 32 * w4 + row;
            const f32x4 a = *(const f32x4*)(ost + row * 64 + c8), cq = *(const f32x4*)(ost + row * 64 + c8 + 4);
            const float bs = IN_SGUB(A)[g * 128 + t];
            const size_t off = (size_t)(m0 + t) * 2048 + g * 128 + hf * 64 + c8;
            const v4u gu = __builtin_nontemporal_load((const v4u*)(GU + off)), sb = __builtin_nontemporal_load((const v4u*)(SGB + off)); v4u w;
#define GS2(GW, SW) pg8::gelu_sig2((pg8::f32x2){bf_lo(GW), bf_hi(GW)}, (pg8::f32x2){bf_lo(SW), bf_hi(SW)})
            const pg8::f32x2 h0 = GS2(gu.x, sb.x), h1 = GS2(gu.y, sb.y), h2 = GS2(gu.z, sb.z), h3 = GS2(gu.w, sb.w);
#undef GS2
            w.x = pk2(h0.x * (a[0] + bs), h0.y * (a[1] + bs)); w.y = pk2(h1.x * (a[2] + bs), h1.y * (a[3] + bs));
            w.z = pk2(h2.x * (cq[0] + bs), h2.y * (cq[1] + bs)); w.w = pk2(h3.x * (cq[2] + bs), h3.y * (cq[3] + bs));
            pg8::st16_out(GU + off, w); }
        asm volatile("s_waitcnt lgkmcnt(0)" ::: "memory");
    }
    __syncthreads();
}
__device__ __forceinline__ void attn_mfma_phase(Frame& F, const Args& A, unsigned char* lds_generic) {
    char* lds = (char*)lds_generic;
    for (int item = F.vcu; item < 256; item += F.G) {
        const int bg = item >> 5, pi = item & 31, b = bg >> 2, g = bg & 3;
        { LAS float* BT = (LAS float*)(F.lds + att::L_BT); const float* src = WSP(A, float, WS_BTAB);
          if (F.tid < 512) BT[F.tid] = src[(F.tid >> 2) * 16 + g * 4 + (F.tid & 3)]; }
        const bf16* Qg = WSP(A, bf16, WS_Q2) + (size_t)bg * SEQ * 4 * 128; const bf16* Kg = WSP(A, bf16, WS_K2) + (size_t)bg * SEQ * 128; const bf16* Vg = WSP(A, bf16, WS_V2) + (size_t)bg * SEQ * 128;
        const unsigned long long* Lb = WSP(A, unsigned long long, WS_LM) + (size_t)b * 512 * 64 * 32;
        const int q1 = 63 - pi;
        att::BlockRef cur{Qg + (size_t)pi * 256 * 128, Kg, Vg, Lb + (size_t)pi * 8 * 64 * 32, pi, b * SEQ + pi * 64};
        const att::BlockRef r1{Qg + (size_t)q1 * 256 * 128, Kg, Vg, Lb + (size_t)q1 * 8 * 64 * 32, q1, b * SEQ + q1 * 64};
        for (int pass = 0; pass < 2; ++pass) {
            att::attn_block(cur, lds, g, WSP(A, bf16, WS_SGA), WSP(A, bf16, WS_GU), WSP(A, bf16, WS_MERGED));
            cur = r1;
        }
    }
}
#ifndef LATE_CONV
#define LATE_CONV 1
#endif
#ifndef SGU_MFMA
#define SGU_MFMA 1
#endif
#ifndef PHASE_MIX
#define PHASE_MIX 1
#endif
#ifndef ATTN_MFMA
#define ATTN_MFMA 1
#endif
__global__ void __launch_bounds__(NWAVES * 64, 2) hybrid_fwd(const Args A) {
    extern __shared__ __attribute__((aligned(16))) unsigned char lds[];
    Frame F;
    F.lds = (LAS unsigned char*)lds;
    F.MISC = (volatile LAS unsigned*)(F.lds + MISC_OFF);
    F.tid = threadIdx.x; F.lane = F.tid & 63; F.wave = __builtin_amdgcn_readfirstlane(F.tid >> 6);
    F.G = gridDim.x; { const int bx = blockIdx.x; F.vcu = (F.G % 8 == 0) ? (bx % 8) * (F.G / 8) + bx / 8 : bx; }
    F.ctl = (gu32*)(A.ws + WS_CTL);
    for (int u = F.tid; u < (LDS_BYTES - LDSCTL_OFF) / 4; u += NWAVES * 64) ((LAS unsigned*)(F.lds + LDSCTL_OFF))[u] = 0u;
    __syncthreads();
    const int lo = A.ph_lo, hi = A.ph_hi;
    const bool one_launch = (hi - lo) > 1;
    XcdBarrier bar; bar.bar = (unsigned*)(F.ctl + CW_BAR); bar.x = 0; bar.st = nullptr;
    if (one_launch) bar = xcd_barrier_post((unsigned*)(F.ctl + CW_BAR), F.MISC + 8);
#define IN(k) (lo <= (k) && (k) < hi)
#define SEAM(k) do { if (IN(k) && IN((k) + 1)) xcd_barrier(bar); } while (0)

    if (IN(0)) { p0_prologue(F, A, !LATE_CONV); } SEAM(0);

    if (IN(1)) {
        pg8::Gemm g{WSP(A, bf16, WS_XB), WSP(A, bf16, WS_WIN), MTOK, NP, DM}; pg8::StaticOrder S; S.init(MTOK, NP, F.G, (int)blockIdx.x);
        pg8::EpiProj E{WSP(A, float, WS_RS1), WSP(A, bf16, WS_Q2), WSP(A, bf16, WS_K2), WSP(A, bf16, WS_V2), WSP(A, bf16, WS_QI), WSP(A, bf16, WS_KI), WSP(A, bf16, WS_GU), WSP(A, bf16, WS_GV), WSP(A, bf16, WS_SGA), WSP(A, bf16, WS_SGB), WSP(A, float, WS_WI), WSP(A, float, WS_VST), QSCALE, IDX_SCALE, WSP(A, bf16, WS_PADD)};
        pg8::gemm_phase<pg8::EpiProj, pg8::StaticOrder, true, true>(F.lds, g, S, E);
    } SEAM(1);

    const bool sgu_first = one_launch && PHASE_MIX && (F.vcu & 1);
#define SGU_PHASE() do { if (IN(3)) { const int gwv = F.vcu * NWAVES + F.wave, NGWV = F.G * NWAVES, nun = (IDX_CV2 ? 2 : 1) * ((F.G == 256) ? 4 : (1024 - F.vcu + F.G - 1) / F.G); int k = 0; \
        for (int i = F.vcu; i < 512; i += F.G, ++k) sgu_pair_unit(F, A, lds, i >> 8, (i >> 3) & 31, i & 7, LATE_CONV ? gwv + (nun + 2 * k) * NGWV : -1); \
        if (LATE_CONV) { for (int it = gwv + (nun + 2 * k) * NGWV; it < CV_I_LATE; it += NGWV) { const CvItem ci = cv_item_late(A, it); float v[32]; cv_issue(v, ci, F.lane); cv_finish(v, ci, (LAS float*)(F.lds + F.wave * 16384), F.lane); } } \
    } } while (0)
    if (sgu_first) SGU_PHASE();
    if (IN(2)) {
        const int w = F.vcu;
        IdxFrag fr; const int nun = (F.G == 256) ? 4 : (1024 - w + F.G - 1) / F.G;
#define UNIT_B(i) ((F.G == 256) ? ((i) >> 1) : ((w + (i) * F.G) >> 9))
#define UNIT_U(i) ((F.G == 256) ? (((i) & 1) ? w : 511 - w) : ((w + (i) * F.G) & 511))
        if (UNIT_U(0) >= 32) idx_load_frag(fr, F, A, UNIT_B(0), 8 * UNIT_U(0));
        const int gwv = F.vcu * NWAVES + F.wave, NGWV = F.G * NWAVES;
        for (int i = 0; i < nun; ++i) idx_unit(fr, F, A, UNIT_B(i), UNIT_U(i), i + 1 < nun ? UNIT_B(i + 1) : 0, i + 1 < nun ? UNIT_U(i + 1) : -1, LATE_CONV ? gwv + (IDX_CV2 ? 2 : 1) * i * NGWV : -1);
#undef UNIT_B
#undef UNIT_U
    }
    if (!sgu_first) SGU_PHASE();
#undef SGU_PHASE
    SEAM(3);

#if ATTN_MFMA
    if (IN(4)) { attn_mfma_phase(F, A, lds); }
    if (one_launch && F.G == 256 && IN(4) && IN(5)) {
        pg8::Gemm g{WSP(A, bf16, WS_MERGED), WSP(A, bf16, WS_WOUT), MTOK, DM, DM}; pg8::StaticOrder S; S.init(MTOK, DM, F.G, (int)blockIdx.x);
        pg8::f32x4 acc5[2][2][4][2];
        { pg8::Unit u5; S.next(0, u5);
          const int wr = F.wave >> 2, wc = F.wave & 3, fr = F.lane & 15, fq = F.lane >> 4;
          const float* xb = IN_X(A) + (size_t)(u5.pm * pg8::BM + wr * 64 + fr) * 2048 + u5.pn * pg8::BM + wc * 32 + 8 * fq;
#pragma unroll
          for (int ai = 0; ai < 2; ++ai)
#pragma unroll
              for (int m = 0; m < 4; ++m)
#pragma unroll
                  for (int bj = 0; bj < 2; ++bj) { const float* p = xb + (size_t)(ai * pg8::HALF + m * 16) * 2048 + 128 * bj;
                      acc5[ai][bj][m][0] = __builtin_nontemporal_load((const pg8::f32x4*)p); acc5[ai][bj][m][1] = __builtin_nontemporal_load((const pg8::f32x4*)(p + 4)); } }
        xcd_barrier(bar);
        pg8::EpiRes<true, false, false, true> E{IN_X(A), (A).out, WSP(A, bf16, WS_H2), WSP(A, float, WS_SSQ2)};
        pg8::gemm_phase<pg8::EpiRes<true, false, false, true>, pg8::StaticOrder, true, true, true>(F.lds, g, S, E, acc5);
    } else {
    SEAM(4);
    if (IN(5)) {
        pg8::Gemm g{WSP(A, bf16, WS_MERGED), WSP(A, bf16, WS_WOUT), MTOK, DM, DM}; pg8::StaticOrder S; S.init(MTOK, DM, F.G, (int)blockIdx.x);
        pg8::EpiRes<true, true> E{IN_X(A), (A).out, WSP(A, bf16, WS_H2), WSP(A, float, WS_SSQ2)};
        pg8::gemm_phase<pg8::EpiRes<true, true>, pg8::StaticOrder, true, true>(F.lds, g, S, E);
    } }
#endif
    SEAM(5);

    if (IN(6)) {
        pg8::Gemm g{WSP(A, bf16, WS_H2), WSP(A, bf16, WS_W1), MTOK, DFF, DM}; pg8::StaticOrder S; S.init(MTOK, DFF, F.G, (int)blockIdx.x);
        pg8::EpiFF1 E{WSP(A, float, WS_SSQ2), WSP(A, bf16, WS_FF), EPS};
        pg8::gemm_phase<pg8::EpiFF1, pg8::StaticOrder, true, true>(F.lds, g, S, E);
    } SEAM(6);

    if (IN(7)) {
        pg8::Gemm g{WSP(A, bf16, WS_FF), WSP(A, bf16, WS_W2), MTOK, DM, DFF}; pg8::StaticOrder S; S.init(MTOK, DM, F.G, (int)blockIdx.x);
        if (one_launch && F.G == 256) {
            struct Hook { const XcdBarrier* b; __device__ __forceinline__ void operator()() const { xcd_barrier(*b); } };
            pg8::EpiResNorm<Hook> E{WSP(A, bf16, WS_H2), (A).out, WSP(A, float, WS_SSQ3), IN_FING(A), EPS, Hook{&bar}};
            pg8::gemm_phase<pg8::EpiResNorm<Hook>, pg8::StaticOrder, false, true>(F.lds, g, S, E);
        } else {
            pg8::EpiRes<false, true> E{(A).out, (A).out, nullptr, WSP(A, float, WS_SSQ3)};
            pg8::gemm_phase<pg8::EpiRes<false, true>, pg8::StaticOrder, true, true>(F.lds, g, S, E);
        }
    }
    if (!(one_launch && F.G == 256)) { SEAM(7); if (IN(8)) { final_norm_phase(F, A); } }
    if (IN(9) || IN(10) || IN(11) || IN(12)) { const int w = F.vcu, md = IN(10) ? 1 : IN(11) ? 2 : IN(12) ? 3 : 0; for (int i = 0; i < 4; ++i) idx_unit_probe(F, A, i >> 1, (i & 1) ? 511 - w : w, md); }
#undef IN
#undef SEAM
}

#ifndef MK_N_LAUNCHES
#define MK_N_LAUNCHES 1
#endif
constexpr int N_PHASES = 9;
#ifndef PROBE_DUP
#define PROBE_DUP (-1)
#endif
#ifndef PROBE_TAIL
#define PROBE_TAIL (-1)
#endif
extern "C" void kernel_launch(void* const* d_in, const int* in_sizes, int n_in, void* d_out, int out_size, void* d_ws, size_t ws_size, hipStream_t stream) {
    static int grid = 0;
    if (grid == 0) {
        if (n_in != 13 || in_sizes[0] != MTOK * DM || out_size != MTOK * DM || ws_size < WS_END) {
            fprintf(stderr, "kernel_launch: shape/workspace mismatch (n_in %d, in0 %d, out %d, ws %zu, need %zu); nothing launched\n", n_in, n_in > 0 ? in_sizes[0] : -1, out_size, ws_size, (size_t)WS_END); grid = -1; return; }
        int dev = 0, cus = 0, per_cu = 0;
        if (hipGetDevice(&dev) != hipSuccess || hipDeviceGetAttribute(&cus, hipDeviceAttributeMultiprocessorCount, dev) != hipSuccess) { fprintf(stderr, "kernel_launch: device query failed\n"); grid = -1; return; }
        if (hipFuncSetAttribute((const void*)hybrid_fwd, hipFuncAttributeMaxDynamicSharedMemorySize, LDS_BYTES) != hipSuccess) { fprintf(stderr, "kernel_launch: hipFuncSetAttribute failed\n"); grid = -1; return; }
        if (hipOccupancyMaxActiveBlocksPerMultiprocessor(&per_cu, (const void*)hybrid_fwd, NWAVES * 64, LDS_BYTES) != hipSuccess || per_cu < 1) { fprintf(stderr, "kernel_launch: occupancy query says %d blocks per CU\n", per_cu); }
        (void)hipGetLastError();
        grid = cus;
        fprintf(stderr, "kernel_launch: grid %d, occupancy %d, ws %zu\n", grid, per_cu, ws_size);
    }
    if (grid < 0) return;
    (void)hipMemsetAsync((char*)d_ws + WS_CTL, 0, CTL_ZERO_BYTES, stream);
    Args a{};
    for (int i = 0; i < 13; ++i) a.in[i] = (const float*)d_in[i];
    a.out = (float*)d_out; a.ws = (unsigned char*)d_ws;
    if (MK_N_LAUNCHES == 1) { a.ph_lo = 0; a.ph_hi = N_PHASES; hipLaunchKernelGGL(hybrid_fwd, dim3(grid), dim3(NWAVES * 64), LDS_BYTES, stream, a); }
    else { for (int p = 0; p < N_PHASES; ++p) { a.ph_lo = p; a.ph_hi = p + 1; for (int r = 0; r < (p == PROBE_DUP ? 2 : 1); ++r) hipLaunchKernelGGL(hybrid_fwd, dim3(grid), dim3(NWAVES * 64), LDS_BYTES, stream, a);
               if (p == 2 && PROBE_DUP >= 9) { a.ph_lo = PROBE_DUP; a.ph_hi = PROBE_DUP + 1; hipLaunchKernelGGL(hybrid_fwd, dim3(grid), dim3(NWAVES * 64), LDS_BYTES, stream, a); } }
           if (PROBE_TAIL >= 0) { a.ph_lo = PROBE_TAIL; a.ph_hi = PROBE_TAIL + 1; hipLaunchKernelGGL(hybrid_fwd, dim3(grid), dim3(NWAVES * 64), LDS_BYTES, stream, a); } }
}
```

```cpp
#include <hip/hip_runtime.h>
#include <hip/hip_bf16.h>
#include <cstdio>
#include <cstdint>
namespace pg8 {
#define PG8_LAS __attribute__((address_space(3)))
typedef unsigned short bf16_t;
typedef short bf16x8 __attribute__((ext_vector_type(8)));
typedef float f32x4 __attribute__((ext_vector_type(4)));
typedef unsigned u32x4 __attribute__((ext_vector_type(4)));
constexpr int BM = 256, BK = 64, HALF = 128, HTB = HALF * BK * 2  , STAGE_BYTES = 8 * HTB, NXCD = 8, WGM = 8;

__host__ __device__ __forceinline__ int lds_byte(int r, int c) { const int st = (r >> 4) * 2 + (c >> 5), rr = r & 15, cc = c & 31, ob = rr * 64 + cc * 2; return st * 1024 + (ob ^ (((ob >> 9) & 1) << 5)); }
__host__ __device__ __forceinline__ void stage_rc(int b, int& R, int& C) { const int st = b / 1024, sb = b % 1024, swz = sb ^ (((sb >> 9) & 1) << 5); R = (st >> 1) * 16 + swz / 64; C = (st & 1) * 32 + (swz % 64) / 2; }
__host__ __device__ __forceinline__ int perm32(int rho) { const int n = rho >> 4, i = rho & 15; return 8 * (i >> 2) + 4 * n + (i & 3); }

struct Unit { int pm, pn; };
struct Gemm { const bf16_t* A; const bf16_t* Bt; int M, N, K; };

struct StaticOrder {
    int nM, nN, nwg, G, c;
    __host__ __device__ void init(int M, int N, int G_, int c_) { nM = M / BM; nN = N / BM; nwg = nM * nN; G = G_; c = c_; }
    __host__ __device__ __forceinline__ bool next(int i, Unit& u) const {
        const long L = (long)i * G + c; if (L >= nwg) return false;
        int wgid = (int)L; { const int q = nwg / NXCD, r = nwg % NXCD, xcd = wgid % NXCD, off = wgid / NXCD; wgid = (xcd < r ? xcd * (q + 1) : r * (q + 1) + (xcd - r) * q) + off; }
        const int nig = WGM * nN, gid = wgid / nig, fm = gid * WGM, gsz = (nM - fm) < WGM ? (nM - fm) : WGM;
        u.pm = fm + ((wgid % nig) % gsz); u.pn = (wgid % nig) / gsz; return true;
    }
    __device__ __forceinline__ void a_ready(const Unit&) const {}
    __device__ __forceinline__ void done(const Unit&) const {}
};

__device__ __forceinline__ unsigned cvt_pk_bf16(float lo, float hi) { unsigned r; asm volatile("v_cvt_pk_bf16_f32 %0, %1, %2" : "=v"(r) : "v"(lo), "v"(hi)); return r; }
typedef float f32x2 __attribute__((ext_vector_type(2)));
constexpr float LOG2E_F = 1.4426950408889634f;
__device__ __forceinline__ float gelu_tanh(float x) {
    const float u = x * (1.0f + 0.044715f * x * x);
    const float e = __builtin_amdgcn_exp2f(u * (-2.0f * 0.7978845608028654f * LOG2E_F));
    return x * __builtin_amdgcn_rcpf(1.0f + e);
}
__device__ __forceinline__ float sigmoid_f(float x) { return __builtin_amdgcn_rcpf(1.0f + __builtin_amdgcn_exp2f(-x * LOG2E_F)); }
__device__ __forceinline__ f32x2 gelu2(f32x2 x) {
    const f32x2 t = (x * x) * 0.044715f + 1.0f, u = (x * t) * (-2.0f * 0.7978845608028654f * LOG2E_F);
    f32x2 e; e.x = __builtin_amdgcn_exp2f(u.x); e.y = __builtin_amdgcn_exp2f(u.y); e = e + 1.0f;
    f32x2 r; r.x = __builtin_amdgcn_rcpf(e.x); r.y = __builtin_amdgcn_rcpf(e.y); return x * r;
}
__device__ __forceinline__ f32x2 sigmoid2(f32x2 x) {
    const f32x2 u = x * (-LOG2E_F); f32x2 e; e.x = __builtin_amdgcn_exp2f(u.x); e.y = __builtin_amdgcn_exp2f(u.y); e = e + 1.0f;
    f32x2 r; r.x = __builtin_amdgcn_rcpf(e.x); r.y = __builtin_amdgcn_rcpf(e.y); return r;
}
__device__ __forceinline__ f32x2 gelu_sig2(f32x2 u, f32x2 g) {
    const f32x2 t = (u * u) * 0.044715f + 1.0f, a = (u * t) * (-2.0f * 0.7978845608028654f * LOG2E_F), b = g * (-LOG2E_F);
    f32x2 e, f; e.x = __builtin_amdgcn_exp2f(a.x); e.y = __builtin_amdgcn_exp2f(a.y); f.x = __builtin_amdgcn_exp2f(b.x); f.y = __builtin_amdgcn_exp2f(b.y);
    const f32x2 d = (e + 1.0f) * (f + 1.0f); f32x2 r; r.x = __builtin_amdgcn_rcpf(d.x); r.y = __builtin_amdgcn_rcpf(d.y); return u * r;
}
__device__ __forceinline__ void gelu4(f32x4& v) { const f32x2 a = gelu2((f32x2){v[0], v[1]}), b = gelu2((f32x2){v[2], v[3]}); v = (f32x4){a.x, a.y, b.x, b.y}; }
__device__ __forceinline__ void sigmoid4(f32x4& v) { const f32x2 a = sigmoid2((f32x2){v[0], v[1]}), b = sigmoid2((f32x2){v[2], v[3]}); v = (f32x4){a.x, a.y, b.x, b.y}; }
#ifndef WT_STORES
#define WT_STORES 0
#endif
__device__ __forceinline__ void st16_out(void* p, u32x4 w) {
#if WT_STORES
    asm volatile("global_store_dwordx4 %0, %1, off sc1\n\ts_nop 1" :: "v"(p), "v"(w) : "memory");
#else
    *(u32x4*)p = w;
#endif
}
__device__ __forceinline__ void st_bf16x8(bf16_t* p, f32x4 v0, f32x4 v1) { u32x4 w; w.x = cvt_pk_bf16(v0[0], v0[1]); w.y = cvt_pk_bf16(v0[2], v0[3]); w.z = cvt_pk_bf16(v1[0], v1[1]); w.w = cvt_pk_bf16(v1[2], v1[3]); st16_out(p, w); }
__device__ __forceinline__ void st_bf16x8_nt(bf16_t* p, f32x4 v0, f32x4 v1) { u32x4 w; w.x = cvt_pk_bf16(v0[0], v0[1]); w.y = cvt_pk_bf16(v0[2], v0[3]); w.z = cvt_pk_bf16(v1[0], v1[1]); w.w = cvt_pk_bf16(v1[2], v1[3]); __builtin_nontemporal_store(w, (u32x4*)p); }
__device__ __forceinline__ float hsum8(f32x4 a, f32x4 b) { return ((a[0] + a[1]) + (a[2] + a[3])) + ((b[0] + b[1]) + (b[2] + b[3])); }
__device__ __forceinline__ float hsq8(f32x4 a, f32x4 b) { return ((a[0] * a[0] + a[1] * a[1]) + (a[2] * a[2] + a[3] * a[3])) + ((b[0] * b[0] + b[1] * b[1]) + (b[2] * b[2] + b[3] * b[3])); }

__host__ __device__ __forceinline__ int proj_logical_tile(int pn) { const int g = pn >> 2, w = pn & 3; return (g % 3 == 2) ? (g / 3) * 4 + w : 15 + (g - g / 3) * 4 + w; }
struct EpiProj {
    static constexpr bool PERM = true, AFTER_DRAIN = false;
    static constexpr int NST = 16;
    const float* rs1; bf16_t *Q2, *K2, *V2, *QI, *KI, *GU, *GV, *SGA, *SGB; float* WI; float* VST; float qscale, iscale; bf16_t* PADD;
    __device__ __forceinline__ void operator()(const f32x4 (&acc)[2][2][4][2], const Unit& u, int wr, int wc, int fr, int fq) const {
        const int pn = proj_logical_tile(u.pn), row0 = u.pm * BM + wr * 64 + fr, cl0 = wc * 32 + 8 * fq;
#pragma unroll
        for (int ai = 0; ai < 2; ++ai)
#pragma unroll
            for (int m = 0; m < 4; ++m) {
                const int r = row0 + ai * HALF + m * 16; const int b = r >> 12, t = r & 4095;
                float ssum = 0.f, ssq = 0.f;
#pragma unroll
                for (int bj = 0; bj < 2; ++bj) {
                    f32x4 v0 = acc[ai][bj][m][0], v1 = acc[ai][bj][m][1];
                    if (pn < 8) { const int head = 2 * pn + bj, g = head >> 2, h = head & 3; v0 = v0 * qscale; v1 = v1 * qscale;
                        st_bf16x8_nt(Q2 + ((((size_t)(b * 4 + g) * 4096 + t) * 4 + h) * 128 + cl0), v0, v1); }
                    else if (pn < 10) { const int g = 2 * (pn - 8) + bj; st_bf16x8_nt(K2 + (((size_t)(b * 4 + g) * 4096 + t) * 128 + cl0), v0, v1); }
                    else if (pn < 12) { const int g = 2 * (pn - 10) + bj; st_bf16x8_nt(V2 + (((size_t)(b * 4 + g) * 4096 + t) * 128 + cl0), v0, v1); }
                    else if (pn < 14) { st_bf16x8(QI + ((size_t)r * 512 + 256 * (pn - 12) + 128 * bj + cl0), v0, v1); }
                    else if (pn == 14) { const int cl = 128 * bj + cl0;
                        st_bf16x8(cl < 64 ? KI + ((((size_t)(r >> 5) * 4 + (cl >> 4)) * 64 + ((cl >> 3) & 1) * 32 + (r & 31)) * 8) : PADD + ((size_t)r * 256 + cl), v0, v1);
                        if (cl == 64) { *(f32x4*)(WI + (size_t)r * 8) = v0 * iscale; *(f32x4*)(WI + (size_t)r * 8 + 4) = v1 * iscale; } }
                    else if (pn < 23) { st_bf16x8(GU + ((size_t)r * 2048 + 256 * (pn - 15) + 128 * bj + cl0), v0, v1); }
                    else if (pn < 31) { gelu4(v0); gelu4(v1);
                        ssum += hsum8(v0, v1); ssq += hsq8(v0, v1);
                        st_bf16x8(GV + ((size_t)r * 2048 + 256 * (pn - 23) + 128 * bj + cl0), v0, v1); }
                    else if (pn < 39) { sigmoid4(v0); sigmoid4(v1);
                        st_bf16x8_nt(SGA + ((size_t)r * 2048 + 256 * (pn - 31) + 128 * bj + cl0), v0, v1); }
                    else { st_bf16x8(SGB + ((size_t)r * 2048 + 256 * (pn - 39) + 128 * bj + cl0), v0, v1); }
                }
                if (pn >= 23 && pn < 31) {
                    ssum += __shfl_xor(ssum, 16); ssum += __shfl_xor(ssum, 32); ssq += __shfl_xor(ssq, 16); ssq += __shfl_xor(ssq, 32);
                    if (fq == 0) { f32x2 o = {ssum, ssq}; *(f32x2*)(VST + ((size_t)r * 32 + (pn - 23) * 4 + wc) * 2) = o; }
                }
            }
    }
};
template <bool H2, bool F32OUT, bool RESBF = false, bool NORES = false> struct EpiRes {
    static constexpr bool PERM = true, AFTER_DRAIN = false;
    static constexpr int NST = 0;
    const void* res; float* out; bf16_t* h2; float* ssq;
    __device__ __forceinline__ void operator()(const f32x4 (&acc)[2][2][4][2], const Unit& u, int wr, int wc, int fr, int fq) const {
        const int row0 = u.pm * BM + wr * 64 + fr, c00 = u.pn * BM + wc * 32 + 8 * fq;
#pragma unroll
        for (int ai = 0; ai < 2; ++ai)
#pragma unroll
            for (int m = 0; m < 4; ++m) {
                const int r = row0 + ai * HALF + m * 16; float q = 0.f;
#pragma unroll
                for (int bj = 0; bj < 2; ++bj) { const size_t off = (size_t)r * 2048 + c00 + 128 * bj; f32x4 r0, r1;
                    if (NORES) { r0 = (f32x4){0.f, 0.f, 0.f, 0.f}; r1 = r0; }
                    else if (RESBF) { const u32x4 rw = *(const u32x4*)((const bf16_t*)res + off);
                        r0 = (f32x4){__uint_as_float(rw.x << 16), __uint_as_float(rw.x & 0xffff0000u), __uint_as_float(rw.y << 16), __uint_as_float(rw.y & 0xffff0000u)};
                        r1 = (f32x4){__uint_as_float(rw.z << 16), __uint_as_float(rw.z & 0xffff0000u), __uint_as_float(rw.w << 16), __uint_as_float(rw.w & 0xffff0000u)}; }
                    else { r0 = __builtin_nontemporal_load((const f32x4*)((const float*)res + off)); r1 = __builtin_nontemporal_load((const f32x4*)((const float*)res + off + 4)); }
                    const f32x4 v0 = acc[ai][bj][m][0] + r0, v1 = acc[ai][bj][m][1] + r1;
                    if (F32OUT) { *(f32x4*)(out + off) = v0; *(f32x4*)(out + off + 4) = v1; } q += hsq8(v0, v1);
                    if (H2) st_bf16x8(h2 + off, v0, v1); }
                q += __shfl_xor(q, 16); q += __shfl_xor(q, 32);
                if (fq == 0) ssq[(size_t)r * 32 + u.pn * 4 + wc] = q;
            }
    }
};
struct EpiFF1 {
    static constexpr bool PERM = true, AFTER_DRAIN = false;
    static constexpr int NST = 16;
    const float* ssq2; bf16_t* FF; float eps;
    __device__ __forceinline__ void operator()(const f32x4 (&acc)[2][2][4][2], const Unit& u, int wr, int wc, int fr, int fq) const {
        const int row0 = u.pm * BM + wr * 64 + fr, c00 = u.pn * BM + wc * 32 + 8 * fq;
#pragma unroll
        for (int ai = 0; ai < 2; ++ai)
#pragma unroll
            for (int m = 0; m < 4; ++m) {
                const int r = row0 + ai * HALF + m * 16;
                float s = hsum8(*(const f32x4*)(ssq2 + (size_t)r * 32 + 8 * fq), *(const f32x4*)(ssq2 + (size_t)r * 32 + 8 * fq + 4));
                s += __shfl_xor(s, 16); s += __shfl_xor(s, 32);
                const float rs = __builtin_amdgcn_rsqf(s * (1.0f / 2048.0f) + eps);
#pragma unroll
                for (int bj = 0; bj < 2; ++bj) { f32x4 v0 = acc[ai][bj][m][0] * rs, v1 = acc[ai][bj][m][1] * rs;
                    for (int e = 0; e < 4; ++e) { const float a = fmaxf(v0[e], 0.f), c = fmaxf(v1[e], 0.f); v0[e] = a * a; v1[e] = c * c; }
                    st_bf16x8(FF + ((size_t)r * 8192 + c00 + 128 * bj), v0, v1); }
            }
    }
};

template <class Hook> struct EpiResNorm {
    static constexpr bool PERM = true, AFTER_DRAIN = true;
    static constexpr int NST = 0;
    const bf16_t* res; float* out; float* ssq; const float* gain; float eps; Hook hook;
    __device__ __forceinline__ void fused(f32x4 (&acc)[2][2][4][2], const Unit& u, int wr, int wc, int fr, int fq, PG8_LAS unsigned char* lds, int wid, int lane) const {
        const int row0 = u.pm * BM + wr * 64 + fr, c00 = u.pn * BM + wc * 32 + 8 * fq;
#pragma unroll
        for (int ai = 0; ai < 2; ++ai)
#pragma unroll
            for (int m = 0; m < 4; ++m) {
                const int r = row0 + ai * HALF + m * 16; float q = 0.f;
#pragma unroll
                for (int bj = 0; bj < 2; ++bj) { const size_t off = (size_t)r * 2048 + c00 + 128 * bj;
                    const u32x4 rw = __builtin_nontemporal_load((const u32x4*)(res + off));
                    acc[ai][bj][m][0] += (f32x4){__uint_as_float(rw.x << 16), __uint_as_float(rw.x & 0xffff0000u), __uint_as_float(rw.y << 16), __uint_as_float(rw.y & 0xffff0000u)};
                    acc[ai][bj][m][1] += (f32x4){__uint_as_float(rw.z << 16), __uint_as_float(rw.z & 0xffff0000u), __uint_as_float(rw.w << 16), __uint_as_float(rw.w & 0xffff0000u)};
                    q += hsq8(acc[ai][bj][m][0], acc[ai][bj][m][1]); }
                q += __shfl_xor(q, 16); q += __shfl_xor(q, 32);
                if (fq == 0) ssq[(size_t)r * 32 + u.pn * 4 + wc] = q;
            }
        hook();
        f32x4 g0[2], g1[2];
#pragma unroll
        for (int bj = 0; bj < 2; ++bj) { g0[bj] = *(const f32x4*)(gain + c00 + 128 * bj); g1[bj] = *(const f32x4*)(gain + c00 + 128 * bj + 4); }
#pragma unroll
        for (int ai = 0; ai < 2; ++ai)
#pragma unroll
            for (int m = 0; m < 4; ++m) {
                const int r = row0 + ai * HALF + m * 16;
                float s = hsum8(*(const f32x4*)(ssq + (size_t)r * 32 + 8 * fq), *(const f32x4*)(ssq + (size_t)r * 32 + 8 * fq + 4));
                s += __shfl_xor(s, 16); s += __shfl_xor(s, 32);
                const float rs = 1.0f / sqrtf(s * (1.0f / 2048.0f) + eps);
#pragma unroll
                for (int bj = 0; bj < 2; ++bj) { const size_t off = (size_t)r * 2048 + c00 + 128 * bj;
                    *(f32x4*)(out + off) = acc[ai][bj][m][0] * rs * g0[bj]; *(f32x4*)(out + off + 4) = acc[ai][bj][m][1] * rs * g1[bj]; }
            }
    }
};
template <class Epi, class Sched, bool ALIGN_EPI = false, bool SP2 = false, bool ACC_IN = false>
__device__ __forceinline__ void gemm_phase(PG8_LAS unsigned char* lds, const Gemm g, const Sched& S, const Epi& E, const f32x4 (*acc0)[2][4][2] = nullptr) {
    const int tid = threadIdx.x, wid = __builtin_amdgcn_readfirstlane(tid >> 6), lane = tid & 63, wr = wid >> 2, wc = wid & 3, fr = lane & 15, fq = lane >> 4;
    const int K = g.K, nt = K / BK;
    unsigned voffA[2], voffB[2];
#pragma unroll
    for (int i = 0; i < 2; ++i) { int R, C; stage_rc(tid * 16 + i * 8192, R, C); const int Rb = Epi::PERM ? ((R & ~31) + perm32(R & 31)) : R;
        voffA[i] = (unsigned)(R * K + C) * 2u; voffB[i] = (unsigned)(Rb * K + C) * 2u; }
    const size_t kstep = (size_t)(BK * 2);
    const size_t hstep = (size_t)HALF * K * 2;
    const size_t tstep = 2 * hstep;
    const unsigned ldsw = (unsigned)wid * 1024u;
    const int aoff = lds_byte(wr * 64 + fr, fq * 8), boff = lds_byte(wc * 32 + fr, fq * 8);
#define PG8_SA(b, h) (((b) * 2 + (h)) * HTB)
#define PG8_SB(b, h) ((4 + (b) * 2 + (h)) * HTB)
#define PG8_STAGE(bufoff, gbase, voff) do { _Pragma("unroll") for (int _i = 0; _i < 2; ++_i) \
        __builtin_amdgcn_global_load_lds((const unsigned*)((const char*)(gbase) + (voff)[_i]), (PG8_LAS unsigned*)(lds + (bufoff) + ldsw + _i * 8192), 16, 0, 0); } while (0)
#define PG8_LDA(dst, b, h) do { _Pragma("unroll") for (int m = 0; m < 4; ++m) _Pragma("unroll") for (int k = 0; k < 2; ++k) dst[m][k] = *(const PG8_LAS bf16x8*)(lds + PG8_SA(b, h) + aoff + m * 2048 + k * 1024); } while (0)
#define PG8_LDB(dst, b, h) do { _Pragma("unroll") for (int n = 0; n < 2; ++n) _Pragma("unroll") for (int k = 0; k < 2; ++k) dst[n][k] = *(const PG8_LAS bf16x8*)(lds + PG8_SB(b, h) + boff + n * 2048 + k * 1024); } while (0)
#define PG8_MMA(ai, bj, At, Bt) do { __builtin_amdgcn_s_setprio(1); _Pragma("unroll") for (int m = 0; m < 4; ++m) _Pragma("unroll") for (int n = 0; n < 2; ++n) _Pragma("unroll") for (int k = 0; k < 2; ++k) \
        acc[ai][bj][m][n] = __builtin_amdgcn_mfma_f32_16x16x32_bf16(Bt[n][k], At[m][k], acc[ai][bj][m][n], 0, 0, 0); __builtin_amdgcn_s_setprio(0); } while (0)
#define PG8_WAIT_V(n) asm volatile("s_waitcnt vmcnt(" #n ")" ::: "memory")
#define PG8_WAIT_L(n) asm volatile("s_waitcnt lgkmcnt(" #n ")" ::: "memory")
#define PG8_BAR __builtin_amdgcn_s_barrier()
#define PG8_SCHED __builtin_amdgcn_sched_barrier(0)
    Unit cur, nxt; int ui = 0;
    if (!S.next(0, cur)) return;
    f32x4 acc[2][2][4][2];
#pragma unroll
    for (int a = 0; a < 2; ++a)
#pragma unroll
        for (int b = 0; b < 2; ++b)
#pragma unroll
            for (int m = 0; m < 4; ++m)
#pragma unroll
                for (int n = 0; n < 2; ++n) acc[a][b][m][n] = ACC_IN ? acc0[a][b][m][n] : (f32x4){0.f, 0.f, 0.f, 0.f};
    bf16x8 At[4][2], B0[2][2], B1[2][2];
    const char* cA = (const char*)g.A + (size_t)cur.pm * tstep; const char* cB = (const char*)g.Bt + (size_t)cur.pn * tstep;
    S.a_ready(cur);
    if constexpr (SP2) {
        PG8_STAGE(PG8_SB(0, 0), cB, voffB); PG8_STAGE(PG8_SB(0, 1), cB + hstep, voffB); PG8_STAGE(PG8_SA(0, 0), cA, voffA); PG8_STAGE(PG8_SA(0, 1), cA + hstep, voffA);
        if (wr == 1) PG8_BAR;
        PG8_WAIT_V(2); PG8_BAR;
        PG8_STAGE(PG8_SB(1, 0), cB + kstep, voffB); PG8_STAGE(PG8_SA(1, 0), cA + kstep, voffA); PG8_STAGE(PG8_SB(1, 1), cB + hstep + kstep, voffB);
        if constexpr (Epi::NST > 0) PG8_WAIT_V(0); else PG8_WAIT_V(6);
        PG8_BAR;
    } else {
        PG8_STAGE(PG8_SB(0, 0), cB, voffB); PG8_STAGE(PG8_SA(0, 0), cA, voffA); PG8_STAGE(PG8_SB(0, 1), cB + hstep, voffB); PG8_STAGE(PG8_SA(0, 1), cA + hstep, voffA);
        if (wr == 1) PG8_BAR;
        PG8_WAIT_V(4); PG8_BAR;
        PG8_STAGE(PG8_SB(1, 0), cB + kstep, voffB); PG8_STAGE(PG8_SA(1, 0), cA + kstep, voffA); PG8_STAGE(PG8_SB(1, 1), cB + hstep + kstep, voffB);
        PG8_WAIT_V(6); PG8_BAR;
    }
    for (;;) {
        const bool has_next = S.next(ui + 1, nxt);
        const char* nA = has_next ? (const char*)g.A + (size_t)nxt.pm * tstep : cA; const char* nB = has_next ? (const char*)g.Bt + (size_t)nxt.pn * tstep : cB;
        for (int t = 0; t < nt; t += 2) {
            const bool last = (t == nt - 2);
            const char* a1 = cA + (size_t)(t + 1) * kstep;
            const char* a2 = last ? nA : cA + (size_t)(t + 2) * kstep; const char* b2 = last ? nB : cB + (size_t)(t + 2) * kstep;
            const char* a3 = a2 + kstep; const char* b3 = b2 + kstep;
            if (last && has_next) S.a_ready(nxt);
            if constexpr (SP2) {
#define PG8_KPAIR(WV01) do { \
            PG8_LDB(B0, 0, 0); PG8_LDB(B1, 0, 1); PG8_SCHED; PG8_LDA(At, 0, 0); PG8_STAGE(PG8_SA(1, 1), a1 + hstep, voffA); \
            WV01; PG8_WAIT_L(0); PG8_BAR; PG8_MMA(0, 0, At, B0); PG8_MMA(0, 1, At, B1); PG8_BAR; PG8_SCHED; \
            PG8_LDA(At, 0, 1); PG8_STAGE(PG8_SB(0, 0), b2, voffB); PG8_STAGE(PG8_SB(0, 1), b2 + hstep, voffB); PG8_STAGE(PG8_SA(0, 0), a2, voffA); \
            WV01; PG8_WAIT_L(0); PG8_BAR; PG8_MMA(1, 0, At, B0); PG8_MMA(1, 1, At, B1); PG8_BAR; PG8_SCHED; \
            PG8_LDB(B0, 1, 0); PG8_LDB(B1, 1, 1); PG8_SCHED; PG8_LDA(At, 1, 0); PG8_STAGE(PG8_SA(0, 1), a2 + hstep, voffA); \
            PG8_WAIT_V(8); PG8_WAIT_L(0); PG8_BAR; PG8_MMA(0, 0, At, B0); PG8_MMA(0, 1, At, B1); PG8_BAR; PG8_SCHED; \
            PG8_LDA(At, 1, 1); PG8_STAGE(PG8_SB(1, 0), b3, voffB); PG8_STAGE(PG8_SB(1, 1), b3 + hstep, voffB); PG8_STAGE(PG8_SA(1, 0), a3, voffA); \
            PG8_WAIT_V(8); PG8_WAIT_L(0); PG8_BAR; PG8_MMA(1, 0, At, B0); PG8_MMA(1, 1, At, B1); PG8_BAR; PG8_SCHED; } while (0)
            if constexpr (Epi::NST > 0) PG8_KPAIR(asm volatile("s_cmp_eq_u32 %0, 0\n\ts_cbranch_scc1 .Lpg8rl%=\n\ts_waitcnt vmcnt(8)\n.Lpg8rl%=:\n\ts_waitcnt vmcnt(%1)" :: "s"(t), "n"(8 + Epi::NST) : "memory", "scc"));
            else PG8_KPAIR(PG8_WAIT_V(8));
#undef PG8_KPAIR
            } else {
            PG8_LDB(B0, 0, 0); PG8_SCHED; PG8_LDA(At, 0, 0); PG8_STAGE(PG8_SA(1, 1), a1 + hstep, voffA);
            PG8_WAIT_L(8); PG8_BAR; PG8_WAIT_L(0); PG8_MMA(0, 0, At, B0); PG8_BAR; PG8_SCHED;
            PG8_LDB(B1, 0, 1); PG8_STAGE(PG8_SB(0, 0), b2, voffB);
            PG8_BAR; PG8_WAIT_L(0); PG8_MMA(0, 1, At, B1); PG8_BAR;
            PG8_LDA(At, 0, 1); PG8_STAGE(PG8_SA(0, 0), a2, voffA);
            PG8_BAR; PG8_WAIT_L(0); PG8_MMA(1, 0, At, B0); PG8_BAR; PG8_SCHED;
            PG8_STAGE(PG8_SB(0, 1), b2 + hstep, voffB);
            PG8_WAIT_V(6); PG8_BAR; PG8_MMA(1, 1, At, B1); PG8_BAR;
            PG8_LDB(B0, 1, 0); PG8_SCHED; PG8_LDA(At, 1, 0); PG8_STAGE(PG8_SA(0, 1), a2 + hstep, voffA);
            PG8_WAIT_L(8); PG8_BAR; PG8_WAIT_L(0); PG8_MMA(0, 0, At, B0); PG8_BAR; PG8_SCHED;
            PG8_LDB(B1, 1, 1); PG8_STAGE(PG8_SB(1, 0), b3, voffB);
            PG8_BAR; PG8_WAIT_L(0); PG8_MMA(0, 1, At, B1); PG8_BAR;
            PG8_LDA(At, 1, 1); PG8_STAGE(PG8_SA(1, 0), a3, voffA);
            PG8_BAR; PG8_WAIT_L(0); PG8_MMA(1, 0, At, B0); PG8_BAR; PG8_SCHED;
            PG8_STAGE(PG8_SB(1, 1), b3 + hstep, voffB);
            PG8_WAIT_V(6); PG8_BAR; PG8_MMA(1, 1, At, B1); PG8_BAR;
            }
        }
        if constexpr (ALIGN_EPI) { if (wr == 0) PG8_BAR; }
        if constexpr (!Epi::AFTER_DRAIN) { E(acc, cur, wr, wc, fr, fq); S.done(cur); }
        if (!has_next) break;
#pragma unroll
        for (int a = 0; a < 2; ++a)
#pragma unroll
            for (int b = 0; b < 2; ++b)
#pragma unroll
                for (int m = 0; m < 4; ++m)
#pragma unroll
                    for (int n = 0; n < 2; ++n) acc[a][b][m][n] = (f32x4){0.f, 0.f, 0.f, 0.f};
        cur = nxt; cA = nA; cB = nB; ++ui;
        if constexpr (ALIGN_EPI) { if (wr == 1) PG8_BAR; }
    }
    PG8_WAIT_V(0);
    if constexpr (!ALIGN_EPI) { if (wr == 0) PG8_BAR; }
    PG8_BAR;
    if constexpr (Epi::AFTER_DRAIN) { E.fused(acc, cur, wr, wc, fr, fq, lds, wid, lane); S.done(cur); }
#undef PG8_SA
#undef PG8_SB
#undef PG8_STAGE
#undef PG8_LDA
#undef PG8_LDB
#undef PG8_MMA
#undef PG8_WAIT_V
#undef PG8_WAIT_L
#undef PG8_BAR
#undef PG8_SCHED
}
}
#ifndef ATTN_MFMA
#define ATTN_MFMA 1
#endif
constexpr int NWAVES = 8;
constexpr int BATCH = 2, SEQ = 4096, DM = 2048, MTOK = BATCH * SEQ;
constexpr int NH = 16, HD = 128, NKV = 4;
constexpr int IH = 8, ID = 64, TOPK = 256;
constexpr int DFF = 8192, DIN = 11848, NP = 12032;
constexpr float EPS = 1e-6f;
constexpr float QSCALE = 0.08838834764831845f * 1.4426950408889634f;
constexpr float IDX_SCALE = 0.35355339059327373f * 0.125f;

constexpr size_t MiB = 1u << 20;
constexpr size_t WS_CTL = 0, CTL_ZERO_BYTES = 64 * 1024;
constexpr size_t WS_RS1 = 1 * MiB;
constexpr size_t WS_BTAB = 1 * MiB + 64 * 1024;
constexpr size_t WS_WI = 1 * MiB + 256 * 1024;
constexpr size_t WS_WSB = 1 * MiB + 512 * 1024;
constexpr size_t WS_VST = 2 * MiB;
constexpr size_t WS_SSQ2 = 4 * MiB, WS_SSQ3 = 5 * MiB;
constexpr size_t WS_KI = 6 * MiB;
constexpr size_t WS_WIN = 8 * MiB;
constexpr size_t WS_WOUT = 56 * MiB;
constexpr size_t WS_W1 = 64 * MiB;
constexpr size_t WS_W2 = 96 * MiB;
constexpr size_t WS_XB = 128 * MiB;
constexpr size_t WS_MASK = 160 * MiB;
constexpr size_t WS_Q2 = 164 * MiB;
constexpr size_t WS_K2 = 196 * MiB, WS_V2 = 204 * MiB;
constexpr size_t WS_QI = 212 * MiB;
constexpr size_t WS_GU = 220 * MiB, WS_GV = 252 * MiB, WS_SGA = 284 * MiB, WS_SGB = 316 * MiB;
constexpr size_t WS_MERGED = WS_GV;
constexpr size_t WS_H2 = 164 * MiB;
constexpr size_t WS_FF = 196 * MiB;
constexpr size_t WS_LM = 348 * MiB;
constexpr size_t WS_PADD = 364 * MiB;
constexpr size_t WS_END = 368 * MiB;
static_assert(WS_WIN + (size_t)NP * DM * 2 <= WS_WOUT && WS_FF + (size_t)MTOK * DFF * 2 <= WS_LM, "d_ws map");
constexpr int CW_BAR = 1024;

#ifndef XB_EARLY_WB
#define XB_EARLY_WB 0
#endif
constexpr int RING_BYTES = 147456;
constexpr int LDSCTL_OFF = RING_BYTES, MISC_OFF = LDSCTL_OFF + 320;
constexpr int LDS_BYTES = RING_BYTES + 1024;

#define GAS __attribute__((address_space(1)))
#define LAS __attribute__((address_space(3)))
typedef unsigned short bf16;
typedef unsigned v4u __attribute__((ext_vector_type(4)));
typedef float f32x4 __attribute__((ext_vector_type(4)));
typedef float f32x2 __attribute__((ext_vector_type(2)));
typedef float f32x16 __attribute__((ext_vector_type(16)));
typedef short bf16x8 __attribute__((ext_vector_type(8)));
typedef GAS unsigned gu32;
#define LDS_WAIT() asm volatile("s_waitcnt lgkmcnt(0)" ::: "memory")
#define VM_WAIT() asm volatile("s_waitcnt vmcnt(0)" ::: "memory")
__device__ __forceinline__ unsigned f2bf(float f) { unsigned u = __builtin_bit_cast(unsigned, f); return (u + 0x7fffu + ((u >> 16) & 1u)) >> 16; }
__device__ __forceinline__ unsigned pk2(float lo, float hi) { unsigned r; asm("v_cvt_pk_bf16_f32 %0, %1, %2" : "=v"(r) : "v"(lo), "v"(hi)); return r; }
__device__ __forceinline__ float bf_lo(unsigned w) { return __uint_as_float(w << 16); }
__device__ __forceinline__ float bf_hi(unsigned w) { return __uint_as_float(w & 0xffff0000u); }
#define XB_TMO      128
#define XB_XCNT(j)  (256  + 64 * (j))
#define XB_XSUB(j)  (1280 + 64 * (j))
#define XB_XGEN(j)  (2304 + 64 * (j))
#define XB_TOP      3328
#define XB_TOPGEN   3392
#define XCD_BAR_WORDS 3456
#define XB_SPIN_CAP (1u << 18)

__device__ __forceinline__ unsigned xb_ld(unsigned* p)              { return __hip_atomic_load(p, __ATOMIC_RELAXED, __HIP_MEMORY_SCOPE_AGENT); }
__device__ __forceinline__ unsigned xb_add(unsigned* p, unsigned v) { return __hip_atomic_fetch_add(p, v, __ATOMIC_RELAXED, __HIP_MEMORY_SCOPE_AGENT); }
__device__ __forceinline__ unsigned xb_xcc_id() { return (unsigned)__builtin_amdgcn_s_getreg((3 << 11) | 20) & 0xFu; }
#define XB_SPIN(cond, bar) do { unsigned _sp = 0; while (cond) { __builtin_amdgcn_s_sleep(1); \
    if ((++_sp & 255u) == 0u) { if (xb_ld(&(bar)[XB_TMO])) break; if (_sp > XB_SPIN_CAP) { atomicAdd(&(bar)[XB_TMO], 1u); break; } } } } while (0)

struct XcdBarrier {
    unsigned* bar; unsigned x;
    volatile LAS unsigned* st;
};

__device__ __forceinline__ XcdBarrier xcd_barrier_post(unsigned* bar, volatile LAS unsigned* st) {
    XcdBarrier b; b.bar = bar; b.x = xb_xcc_id(); b.st = st;
    if (threadIdx.x == 0) (void)xb_add(&bar[XB_XCNT(b.x)], 1u);
    return b;
}
__device__ __forceinline__ void xcd_barrier_complete(unsigned* bar, unsigned x, unsigned& nloc, unsigned& nx) {
    const unsigned G = gridDim.x * gridDim.y * gridDim.z;
    unsigned sum, cnt, mine, sp = 0u;
    for (;;) {
        sum = 0u; cnt = 0u; mine = 0u;
#pragma unroll
        for (unsigned j = 0; j < 16; ++j) { const unsigned c = xb_ld(&bar[XB_XCNT(j)]); sum += c; cnt += (c > 0u) ? 1u : 0u; mine = (j == x) ? c : mine; }
        if (sum == G) break;
        __builtin_amdgcn_s_sleep(1);
        if ((++sp & 255u) == 0u) { if (xb_ld(&bar[XB_TMO])) break; if (sp > XB_SPIN_CAP) { atomicAdd(&bar[XB_TMO], 1u); break; } }
    }
    nloc = mine > 0u ? mine : 1u; nx = cnt > 0u ? cnt : 1u;
}

__device__ __forceinline__ void xcd_barrier(const XcdBarrier& b) {
    asm volatile("s_waitcnt vmcnt(0)" ::: "memory");
    __syncthreads();
    if (threadIdx.x == 0) {
        unsigned* bar = b.bar;
        __builtin_amdgcn_s_waitcnt(0);
        unsigned nloc = b.st[0], nx = b.st[1];
        if (nloc == 0u) { xcd_barrier_complete(bar, b.x, nloc, nx); b.st[0] = nloc; b.st[1] = nx; }
#if XB_EARLY_WB
        asm volatile("buffer_wbl2 sc1" ::: "memory");
#endif
        const unsigned old = xb_add(&bar[XB_XSUB(b.x)], 1u);
        const unsigned gen = old / nloc;
        if (old + 1u == (gen + 1u) * nloc) {
            __builtin_amdgcn_fence(__ATOMIC_RELEASE, "agent");
            asm volatile("s_waitcnt vmcnt(0)" ::: "memory");
            const unsigned og = xb_add(&bar[XB_TOP], 1u);
            const unsigned tg = og / nx;
            if (og + 1u == (tg + 1u) * nx) xb_add(&bar[XB_TOPGEN], 1u);
            else XB_SPIN(xb_ld(&bar[XB_TOPGEN]) == tg, bar);
            __builtin_amdgcn_fence(__ATOMIC_ACQUIRE, "agent");
            xb_add(&bar[XB_XGEN(b.x)], 1u);
            asm volatile("s_waitcnt vmcnt(0)" ::: "memory");
        } else {
            XB_SPIN(xb_ld(&bar[XB_XGEN(b.x)]) == gen, bar);
            __builtin_amdgcn_fence(__ATOMIC_ACQUIRE, "agent");
            asm volatile("s_waitcnt vmcnt(0)" ::: "memory");
        }
    }
    __syncthreads();
}
struct Args { const float* in[13]; float* out; unsigned char* ws; int ph_lo, ph_hi; };
struct Frame {
    LAS unsigned char* lds; volatile LAS unsigned* MISC; gu32* ctl;
    int tid, lane, wave, vcu, G;
};
#define IN_X(A) ((A).in[0])
#define IN_RELB(A) ((A).in[1])
#define IN_N1G(A) ((A).in[2])
#define IN_WIN(A) ((A).in[3])
#define IN_LNG(A) ((A).in[4])
#define IN_LNB(A) ((A).in[5])
#define IN_SGUW(A) ((A).in[6])
#define IN_SGUB(A) ((A).in[7])
#define IN_WOUT(A) ((A).in[8])
#define IN_N2G(A) ((A).in[9])
#define IN_W1(A) ((A).in[10])
#define IN_W2(A) ((A).in[11])
#define IN_FING(A) ((A).in[12])
#define WSP(A, T, off) ((T*)((A).ws + (off)))
__device__ __forceinline__ float wave_sum(float v) {
#pragma unroll
    for (int o = 1; o < 64; o <<= 1) v += __shfl_xor(v, o);
    return v;
}
__device__ __forceinline__ float wave_max(float v) {
#pragma unroll
    for (int o = 1; o < 64; o <<= 1) v = fmaxf(v, __shfl_xor(v, o));
    return v;
}
struct CvItem { const float* W; const float* gk; bf16* WT; int K, N, nrow0, src0, nvalid, k0; };
__device__ __forceinline__ void cv_issue(float (&v)[32], const CvItem& it, int lane) {
    const bool ok = (lane & 31) < it.nvalid; const float* wp = it.W + (size_t)(it.k0 + (lane >> 5)) * it.N + it.src0 + (lane & 31);
#pragma unroll
    for (int i = 0; i < 32; ++i) v[i] = ok ? __builtin_nontemporal_load(wp + (size_t)(2 * i) * it.N) : 0.f;
}
__device__ __forceinline__ void cv_finish(float (&v)[32], const CvItem& it, LAS float* scr, int lane) {
    if (it.gk) { const float* gp = it.gk + it.k0 + (lane >> 5);
#pragma unroll
        for (int i = 0; i < 32; ++i) v[i] *= gp[2 * i]; }
#pragma unroll
    for (int i = 0; i < 32; ++i) scr[(2 * i + (lane >> 5)) * 33 + (lane & 31)] = v[i];
    LDS_WAIT(); asm volatile("" ::: "memory");
    const int c = lane & 7;
#pragma unroll
    for (int j = 0; j < 4; ++j) { const int n = (lane >> 3) + 8 * j; const LAS float* s = scr + (8 * c) * 33 + n;
        v4u o; o.x = pk2(s[0 * 33], s[1 * 33]); o.y = pk2(s[2 * 33], s[3 * 33]); o.z = pk2(s[4 * 33], s[5 * 33]); o.w = pk2(s[6 * 33], s[7 * 33]);
        *(GAS v4u*)(it.WT + (size_t)(it.nrow0 + n) * it.K + it.k0 + 8 * c) = o; }
    LDS_WAIT(); asm volatile("" ::: "memory");
}
constexpr int CV_KB2 = DM / 64, CV_KB8 = DFF / 64;
constexpr int CV_I_IN = CV_KB2 * (NP / 32), CV_I_OUT = CV_KB2 * (DM / 32), CV_I_1 = CV_KB2 * (DFF / 32), CV_I_2 = CV_KB8 * (DM / 32), CV_I_LATE = CV_I_OUT + CV_I_1 + CV_I_2;
__device__ __forceinline__ CvItem cv_item_in(const Args& A, int r) {
    const int nb = r / CV_KB2, kb = r % CV_KB2, nphys = nb * 32, n0 = pg8::proj_logical_tile(nphys >> 8) * 256 + (nphys & 255); int src0, nvalid;
    if (n0 < 3584) { src0 = n0; nvalid = 32; }
    else if (n0 < 3840) { const int j0 = n0 - 3584; src0 = 3584 + j0; nvalid = 72 - j0; nvalid = nvalid < 0 ? 0 : (nvalid > 32 ? 32 : nvalid); }
    else { src0 = n0 - 3840 + 3656; nvalid = 32; }
    return CvItem{IN_WIN(A), IN_N1G(A), WSP(A, bf16, WS_WIN), DM, DIN, nphys, src0, nvalid, kb * 64};
}
__device__ __forceinline__ CvItem cv_item_late(const Args& A, int r) {
    if (r < CV_I_OUT) { const int nb = r / CV_KB2, kb = r % CV_KB2; return CvItem{IN_WOUT(A), nullptr, WSP(A, bf16, WS_WOUT), DM, DM, nb * 32, nb * 32, 32, kb * 64}; }
    r -= CV_I_OUT;
    if (r < CV_I_1) { const int nb = r / CV_KB2, kb = r % CV_KB2; return CvItem{IN_W1(A), IN_N2G(A), WSP(A, bf16, WS_W1), DM, DFF, nb * 32, nb * 32, 32, kb * 64}; }
    r -= CV_I_1;
    { const int nb = r / CV_KB8, kb = r % CV_KB8; return CvItem{IN_W2(A), nullptr, WSP(A, bf16, WS_W2), DFF, DM, nb * 32, nb * 32, 32, kb * 64}; }
}
__device__ __forceinline__ void p0_prologue(Frame& F, const Args& A, bool late_in_prologue) {
    LAS float* scr = (LAS float*)(F.lds + F.wave * 18432);
    const int gw = F.vcu * NWAVES + F.wave, NGW = F.G * NWAVES, lane = F.lane;
    const int nitems = late_in_prologue ? CV_I_IN + CV_I_LATE : CV_I_IN;
    for (int it = gw; it < nitems; it += 2 * NGW) {
        const CvItem c0 = it < CV_I_IN ? cv_item_in(A, it) : cv_item_late(A, it - CV_I_IN); const int it1 = it + NGW; const bool two = it1 < nitems;
        const CvItem c1 = it1 < CV_I_IN ? cv_item_in(A, it1) : cv_item_late(A, (two ? it1 : it) - CV_I_IN);
        float v0[32], v1[32]; cv_issue(v0, c0, lane); if (two) cv_issue(v1, c1, lane);
        cv_finish(v0, c0, scr, lane); if (two) cv_finish(v1, c1, scr + 2112, lane);
    }
    for (int i = (F.vcu * NWAVES * 64 + F.tid); i < 16 * 128 * 128 / 4; i += F.G * NWAVES * 64) { const int e = i * 4, t = (e >> 7) & 127, s0 = e & 127;
        const f32x4 v = *(const f32x4*)(IN_SGUW(A) + e);
        const unsigned lo = pk2(s0 <= t ? v[0] : 0.f, s0 + 1 <= t ? v[1] : 0.f), hi2 = pk2(s0 + 2 <= t ? v[2] : 0.f, s0 + 3 <= t ? v[3] : 0.f);
        *(unsigned long long*)(WSP(A, bf16, WS_WSB) + e) = (unsigned long long)lo | ((unsigned long long)hi2 << 32); }
    for (int m = gw; m < MTOK; m += NGW) {
        const GAS f32x4* xr = (const GAS f32x4*)(IN_X(A) + (size_t)m * DM) + lane; f32x4 v[8]; float ss = 0.f;
#pragma unroll
        for (int j = 0; j < 8; ++j) { v[j] = __builtin_nontemporal_load(xr + 64 * j); ss += (v[j].x * v[j].x + v[j].y * v[j].y) + (v[j].z * v[j].z + v[j].w * v[j].w); }
        ss = wave_sum(ss);
        const float rms = sqrtf(ss * (1.0f / DM) + EPS), rs = 1.0f / rms;
        if (lane == 0) WSP(A, float, WS_RS1)[m] = rms;
        GAS unsigned long long* o8 = (GAS unsigned long long*)(WSP(A, bf16, WS_XB) + (size_t)m * DM) + lane;
#pragma unroll
        for (int j = 0; j < 8; ++j) o8[64 * j] = (unsigned long long)pk2(v[j].x * rs, v[j].y * rs) | ((unsigned long long)pk2(v[j].z * rs, v[j].w * rs) << 32);
    }
    if (blockIdx.x == 0) {
        for (int i = F.tid; i < 128 * 16; i += NWAVES * 64) { const int n = i >> 4, h = i & 15; int bk;
            if (n < 16) bk = n; else { bk = 16 + (int)(logf((float)n / 16.0f) / 2.0794415416798357f * 16.0f); bk = bk > 31 ? 31 : bk; }
            WSP(A, float, WS_BTAB)[i] = (IN_RELB(A)[bk * 16 + h] - IN_RELB(A)[31 * 16 + h]) * 1.4426950408889634f; }
    }
}
__device__ __forceinline__ unsigned fkey(float f) { const unsigned u = __float_as_uint(f); return (u & 0x80000000u) ? ~u : (u | 0x80000000u); }
__device__ __forceinline__ int mbcnt64(unsigned long long m) { return __builtin_amdgcn_mbcnt_hi((unsigned)(m >> 32), __builtin_amdgcn_mbcnt_lo((unsigned)m, 0u)); }
__device__ __forceinline__ int wave_sum_i(int x) {
    x += __builtin_amdgcn_update_dpp(0, x, 0xB1, 0xF, 0xF, true);
    x += __builtin_amdgcn_update_dpp(0, x, 0x4E, 0xF, 0xF, true);
    x += __builtin_amdgcn_update_dpp(0, x, 0x141, 0xF, 0xF, true);
    x += __builtin_amdgcn_update_dpp(0, x, 0x140, 0xF, 0xF, true);
    return __builtin_amdgcn_readlane(x, 0) + __builtin_amdgcn_readlane(x, 16) + __builtin_amdgcn_readlane(x, 32) + __builtin_amdgcn_readlane(x, 48);
}
__device__ __forceinline__ unsigned wave_max_u(unsigned x) {
    x = max(x, (unsigned)__builtin_amdgcn_update_dpp(0, (int)x, 0xB1, 0xF, 0xF, true));
    x = max(x, (unsigned)__builtin_amdgcn_update_dpp(0, (int)x, 0x4E, 0xF, 0xF, true));
    x = max(x, (unsigned)__builtin_amdgcn_update_dpp(0, (int)x, 0x141, 0xF, 0xF, true));
    x = max(x, (unsigned)__builtin_amdgcn_update_dpp(0, (int)x, 0x140, 0xF, 0xF, true));
    return max(max((unsigned)__builtin_amdgcn_readlane((int)x, 0), (unsigned)__builtin_amdgcn_readlane((int)x, 16)), max((unsigned)__builtin_amdgcn_readlane((int)x, 32), (unsigned)__builtin_amdgcn_readlane((int)x, 48)));
}
template <int NJ> __device__ __forceinline__ unsigned long long select_query(const LAS unsigned* sk, int lane) {
    unsigned v[NJ];
#pragma unroll
    for (int j = 0; j < NJ; ++j) v[j] = sk[lane + 64 * j];
    unsigned prefix = 0u; bool exact = false; int bit0 = 31;
    auto count_ge = [&](unsigned cand_) -> int { const unsigned cand = __builtin_amdgcn_readfirstlane(cand_); int c0 = 0, c1 = 0, c2 = 0, c3 = 0;
#define CNT_GE8(j0) asm volatile( \
            "v_cmp_le_u32_e32 vcc, %4, %5\n\tv_addc_co_u32_e32 %0, vcc, 0, %0, vcc\n\tv_cmp_le_u32_e32 vcc, %4, %6\n\tv_addc_co_u32_e32 %1, vcc, 0, %1, vcc\n\t" \
            "v_cmp_le_u32_e32 vcc, %4, %7\n\tv_addc_co_u32_e32 %2, vcc, 0, %2, vcc\n\tv_cmp_le_u32_e32 vcc, %4, %8\n\tv_addc_co_u32_e32 %3, vcc, 0, %3, vcc\n\t" \
            "v_cmp_le_u32_e32 vcc, %4, %9\n\tv_addc_co_u32_e32 %0, vcc, 0, %0, vcc\n\tv_cmp_le_u32_e32 vcc, %4, %10\n\tv_addc_co_u32_e32 %1, vcc, 0, %1, vcc\n\t" \
            "v_cmp_le_u32_e32 vcc, %4, %11\n\tv_addc_co_u32_e32 %2, vcc, 0, %2, vcc\n\tv_cmp_le_u32_e32 vcc, %4, %12\n\tv_addc_co_u32_e32 %3, vcc, 0, %3, vcc" \
            : "+v"(c0), "+v"(c1), "+v"(c2), "+v"(c3) : "s"(cand), "v"(v[j0]), "v"(v[j0 + 1]), "v"(v[j0 + 2]), "v"(v[j0 + 3]), "v"(v[j0 + 4]), "v"(v[j0 + 5]), "v"(v[j0 + 6]), "v"(v[j0 + 7]) : "vcc")
#pragma unroll
        for (int j = 0; j < NJ; j += 8) CNT_GE8(j);
#undef CNT_GE8
        return wave_sum_i((c0 + c1) + (c2 + c3)); };
    if (NJ >= 24) {
        unsigned m = v[0];
#pragma unroll
        for (int j = 1; j < NJ; ++j) m = max(m, v[j]);
        unsigned cand = wave_max_u(m) & 0xFF800000u;
        for (int s = 0; s < 4; ++s) {
            const int c = count_ge(cand);
            if (c >= TOPK) { prefix = cand; bit0 = 22; exact = (c == TOPK); break; }
            if (cand < 0x00800000u) break;
            cand -= 0x00800000u;
        }
    }
    if (!exact) for (int bit = bit0; bit >= 0; --bit) {
        const unsigned cand = prefix | (1u << bit);
        const int c = count_ge(cand);
        if (c >= TOPK) { prefix = cand; if (c == TOPK) { exact = true; break; } }
    }
    unsigned mlo = 0u, mhi = 0u;
    if (exact) {
#pragma unroll
        for (int j = 0; j < NJ; ++j) { const unsigned long long bsel = __ballot(v[j] >= prefix); if (lane == j) { mlo = (unsigned)bsel; mhi = (unsigned)(bsel >> 32); } asm volatile("" : "+v"(mlo), "+v"(mhi)); }
    } else {
        int g0 = 0, g1 = 0; const unsigned pfx = __builtin_amdgcn_readfirstlane(prefix);
#define CNT_GT(acc, val) asm volatile("v_cmp_lt_u32_e32 vcc, %1, %2\n\tv_addc_co_u32_e32 %0, vcc, 0, %0, vcc" : "+v"(acc) : "s"(pfx), "v"(val) : "vcc")
#pragma unroll
        for (int j = 0; j < NJ; j += 2) { CNT_GT(g0, v[j]); CNT_GT(g1, v[j + 1]); }
#undef CNT_GT
        int rem = TOPK - wave_sum_i(g0 + g1);
#pragma unroll
        for (int j = 0; j < NJ; ++j) { const unsigned long long eq = __ballot(v[j] == prefix);
            const bool take = (v[j] > prefix) || ((v[j] == prefix) && (mbcnt64(eq) < rem));
            const unsigned long long bsel = __ballot(take); rem -= __builtin_popcountll(eq); rem = rem < 0 ? 0 : rem;
            if (lane == j) { mlo = (unsigned)bsel; mhi = (unsigned)(bsel >> 32); } asm volatile("" : "+v"(mlo), "+v"(mhi)); }
    }
    return (unsigned long long)mlo | ((unsigned long long)mhi << 32);
}
struct IdxFrag { bf16x8 qa[2][4]; float w[2][2][8]; };
__device__ __forceinline__ void idx_load_frag_q(IdxFrag& f, Frame& F, const Args& A, int b, int t0) {
    const int lane = F.lane, rho = lane & 31, half = lane >> 5, blk = rho >> 2;
    const int q4 = (blk >> 2) + 2 * (blk & 1), hd = (rho & 3) + 4 * ((blk >> 1) & 1);
#pragma unroll
    for (int R = 0; R < 2; ++R)
#pragma unroll
        for (int ks = 0; ks < 4; ++ks) f.qa[R][ks] = *(const bf16x8*)(WSP(A, bf16, WS_QI) + ((size_t)(b * SEQ + t0 + 4 * R + q4) * 512 + hd * 64 + ks * 16 + half * 8));
}
__device__ __forceinline__ void idx_load_frag_w(IdxFrag& f, Frame& F, const Args& A, int b, int t0) {
    const int half = F.lane >> 5;
#pragma unroll
    for (int R = 0; R < 2; ++R)
#pragma unroll
        for (int lq = 0; lq < 2; ++lq) { const float* wp = WSP(A, float, WS_WI) + (size_t)(b * SEQ + t0 + 4 * R + 2 * half + lq) * 8; const f32x4 a = *(const f32x4*)wp, c = *(const f32x4*)(wp + 4);
            f.w[R][lq][0] = a[0]; f.w[R][lq][1] = a[1]; f.w[R][lq][2] = a[2]; f.w[R][lq][3] = a[3]; f.w[R][lq][4] = c[0]; f.w[R][lq][5] = c[1]; f.w[R][lq][6] = c[2]; f.w[R][lq][7] = c[3]; }
}
__device__ __forceinline__ void idx_load_frag(IdxFrag& f, Frame& F, const Args& A, int b, int t0) { idx_load_frag_q(f, F, A, b, t0); idx_load_frag_w(f, F, A, b, t0); }
__device__ __forceinline__ float fmac_s(float a, float b, float c) { asm("v_fmac_f32_e32 %0, %1, %2" : "+v"(c) : "v"(a), "v"(b)); return c; }
__device__ __forceinline__ float relu1(float x) { const int i = __builtin_bit_cast(int, x); return __builtin_bit_cast(float, i > 0 ? i : 0); }
template <int V = 0> __device__ __forceinline__ void idx_scores(const IdxFrag& f, Frame& F, const Args& A, int b, int t0, int stride) {
    LAS unsigned* SK = (LAS unsigned*)F.lds;
    const int lane = F.lane, rho = lane & 31, half = lane >> 5;
    const int ntv = (t0 + 8 + 31) >> 5, nta = stride >> 5;
    const bf16* kbase = WSP(A, bf16, WS_KI) + (size_t)(b * (SEQ / 32)) * 2048 + lane * 8;
#define KLOAD(dst, kt_) do { const int kc_ = (kt_) < ntv ? (kt_) : ntv - 1; _Pragma("unroll") for (int ks = 0; ks < 4; ++ks) dst[ks] = *(const bf16x8*)(kbase + (size_t)kc_ * 2048 + ks * 512); } while (0)
#define KMMA(a0, a1, kb_) do { _Pragma("unroll") for (int ks = 0; ks < 4; ++ks) { a0 = __builtin_amdgcn_mfma_f32_32x32x16_bf16(f.qa[0][ks], kb_[ks], a0, 0, 0, 0); a1 = __builtin_amdgcn_mfma_f32_32x32x16_bf16(f.qa[1][ks], kb_[ks], a1, 0, 0, 0); } } while (0)
#define KOUT(a0, a1, kt_) do { if ((kt_) < ntv) { const int key = (kt_) * 32 + rho; \
        _Pragma("unroll") for (int R = 0; R < 2; ++R) _Pragma("unroll") for (int lq = 0; lq < 2; ++lq) { float s = 0.f; \
            _Pragma("unroll") for (int h = 0; h < 8; ++h) s = fmac_s(f.w[R][lq][h], relu1(R == 0 ? a0[lq * 8 + h] : a1[lq * 8 + h]), s); \
            const int ql = 4 * R + 2 * half + lq; SK[ql * stride + key] = (key <= t0 + ql) ? fkey(s) : 0u; } } } while (0)
    bf16x8 kA[4], kB[4], nA[4], nB[4];
    KLOAD(kA, F.wave); KLOAD(kB, F.wave + NWAVES);
    for (int kt = F.wave; kt < ntv; kt += 2 * NWAVES) {
        if (V != 1) { KLOAD(nA, kt + 2 * NWAVES); KLOAD(nB, kt + 3 * NWAVES); }
        f32x16 a0 = {}, a1 = {}, c0 = {}, c1 = {};
        KMMA(a0, a1, kA); KMMA(c0, c1, kB);
        if (V != 2) { KOUT(a0, a1, kt); KOUT(c0, c1, kt + NWAVES); }
        else { SK[(kt * 32 + (lane & 31)) & 4095] = __float_as_uint(a0[0] + a1[3] + c0[5] + c1[7]); }
        if (V != 1) {
#pragma unroll
        for (int ks = 0; ks < 4; ++ks) { kA[ks] = nA[ks]; kB[ks] = nB[ks]; } }
        else { asm volatile("" : "+v"(kA[0]), "+v"(kB[0])); }
    }
#undef KLOAD
#undef KMMA
#undef KOUT
    for (int kt = ntv + F.wave; kt < nta; kt += NWAVES) {
        const int key = kt * 32 + rho;
#pragma unroll
        for (int q = 0; q < 4; ++q) SK[(2 * half + (q & 1) + 4 * (q >> 1)) * stride + key] = 0u;
    }
}
#ifndef IDX_CV2
#define IDX_CV2 1
#endif
constexpr int LM_OFF = 131072;
__device__ __forceinline__ void idx_unit(IdxFrag& fr, Frame& F, const Args& A, int b, int u, int nb_, int nu, int cvi) {
    const int t0 = 8 * u, lane = F.lane, t = t0 + F.wave;
    LAS unsigned long long* LM = (LAS unsigned long long*)(F.lds + LM_OFF);
    { LAS v4u* z = (LAS v4u*)(F.lds + LM_OFF); z[F.tid] = (v4u){0u, 0u, 0u, 0u}; z[F.tid + 512] = (v4u){0u, 0u, 0u, 0u}; }
    unsigned long long word; float cv0[32], cv1[32]; const int cvj = cvi + F.G * NWAVES;
    const bool cva = cvi >= 0 && cvi < CV_I_LATE, cvb = IDX_CV2 && cvi >= 0 && cvj < CV_I_LATE; const CvItem ci0 = cv_item_late(A, cva ? cvi : 0), ci1 = cv_item_late(A, cvb ? cvj : 0);
    if (t0 + 8 <= TOPK) {
        const int nb = t + 1 - 64 * lane; word = nb >= 64 ? ~0ull : (nb > 0 ? ((1ull << nb) - 1ull) : 0ull);
        if (nu >= 32) idx_load_frag_q(fr, F, A, nb_, 8 * nu);
        if (cva) cv_issue(cv0, ci0, lane); if (cvb) cv_issue(cv1, ci1, lane);
        __syncthreads();
    } else {
        const int njc = (t0 + 8 + 511) >> 9, stride = njc * 512;
        idx_scores(fr, F, A, b, t0, stride);
        __syncthreads();
        if (!IDX_CV2) { if (nu >= 32) idx_load_frag_q(fr, F, A, nb_, 8 * nu); }
        if (cva) cv_issue(cv0, ci0, lane); if (cvb) cv_issue(cv1, ci1, lane);
        const LAS unsigned* sk = (const LAS unsigned*)F.lds + F.wave * stride;
        switch (njc) {
            case 1: word = select_query<8>(sk, lane); break;
            case 2: word = select_query<16>(sk, lane); break;
            case 3: word = select_query<24>(sk, lane); break;
            case 4: word = select_query<32>(sk, lane); break;
            case 5: word = select_query<40>(sk, lane); break;
            case 6: word = select_query<48>(sk, lane); break;
            case 7: word = select_query<56>(sk, lane); break;
            default: word = select_query<64>(sk, lane); break;
        }
        if (IDX_CV2) { if (nu >= 32) idx_load_frag_q(fr, F, A, nb_, 8 * nu); }
    }
#if !ATTN_MFMA
    WSP(A, unsigned long long, WS_MASK)[(size_t)(b * SEQ + t) * 64 + lane] = word;
#endif
    const int jmax = (t0 + 7) >> 6;
    if (lane <= jmax) {
        const int sh = 4 * F.wave;
#pragma unroll
        for (int rp = 0; rp < 32; ++rp) { const int c = 32 * (rp >> 4) + (rp & 3) + 8 * ((rp & 15) >> 2);
            const unsigned long long v = (((word >> c) & 1ull) ? (0xFull << sh) : 0ull) | (((word >> (c + 4)) & 1ull) ? (0xFull << (32 + sh)) : 0ull);
            __hip_atomic_fetch_or(&LM[rp * 64 + lane], v, __ATOMIC_RELAXED, __HIP_MEMORY_SCOPE_WORKGROUP); }
    }
    __syncthreads();
    if (cva) cv_finish(cv0, ci0, (LAS float*)(F.lds + F.wave * 16384), lane);
    if (cvb) cv_finish(cv1, ci1, (LAS float*)(F.lds + F.wave * 16384), lane);
    if (nu >= 32) idx_load_frag_w(fr, F, A, nb_, 8 * nu);
    { const int j = F.tid >> 3;
      if (j <= jmax) { const int rp0 = 4 * (F.tid & 7); const unsigned long long w0 = LM[rp0 * 64 + j], w1 = LM[(rp0 + 1) * 64 + j], w2 = LM[(rp0 + 2) * 64 + j], w3 = LM[(rp0 + 3) * 64 + j];
          v4u* d = (v4u*)(WSP(A, unsigned long long, WS_LM) + ((size_t)(b * 512 + u) * 64) * 32) + F.tid * 2;
          d[0] = (v4u){(unsigned)w0, (unsigned)(w0 >> 32), (unsigned)w1, (unsigned)(w1 >> 32)}; d[1] = (v4u){(unsigned)w2, (unsigned)(w2 >> 32), (unsigned)w3, (unsigned)(w3 >> 32)}; } }
    __syncthreads();
}
__device__ __forceinline__ void idx_unit_probe(Frame& F, const Args& A, int b, int u, int mode) {
    const int t0 = 8 * u, lane = F.lane;
    if (t0 + 8 <= TOPK) return;
    const int njc = (t0 + 8 + 511) >> 9, stride = njc * 512;
    IdxFrag fr; idx_load_frag(fr, F, A, b, t0);
    if (mode == 2) idx_scores<1>(fr, F, A, b, t0, stride); else if (mode == 3) idx_scores<2>(fr, F, A, b, t0, stride); else idx_scores(fr, F, A, b, t0, stride);
    __syncthreads();
    if (mode == 1) {
        const LAS unsigned* sk = (const LAS unsigned*)F.lds + F.wave * stride; unsigned long long word;
        switch (njc) {
            case 1: word = select_query<8>(sk, lane); break;
            case 2: word = select_query<16>(sk, lane); break;
            case 3: word = select_query<24>(sk, lane); break;
            case 4: word = select_query<32>(sk, lane); break;
            case 5: word = select_query<40>(sk, lane); break;
            case 6: word = select_query<48>(sk, lane); break;
            case 7: word = select_query<56>(sk, lane); break;
            default: word = select_query<64>(sk, lane); break;
        }
        if (word == 0x123456789abcdef1ull) WSP(A, unsigned long long, WS_MASK)[0] = word;
    }
    __syncthreads();
}
__device__ __forceinline__ void sgu_unit(Frame& F, const Args& A, int b, int c, int g) {
    LAS float* VN = (LAS float*)F.lds;
    LAS float* WT = (LAS float*)(F.lds + 65536);
    LAS float* ST = (LAS float*)(F.lds + 65536 + 66048);
    const int tid = F.tid, m0 = b * SEQ + c * 128, ch0 = g * 128;
    if (tid < 128) { const float* p = WSP(A, float, WS_VST) + (size_t)(m0 + tid) * 64; float s = 0.f, q = 0.f;
#pragma unroll
        for (int i = 0; i < 16; ++i) { const f32x4 v = *(const f32x4*)(p + 4 * i); s += v[0] + v[2]; q += v[1] + v[3]; }
        const float mean = s * (1.0f / 2048.0f), var = q * (1.0f / 2048.0f) - mean * mean;
        ST[2 * tid] = mean; ST[2 * tid + 1] = 1.0f / sqrtf(var + EPS); }
    { const float* Wg = IN_SGUW(A) + (size_t)g * 16384;
#pragma unroll
        for (int i = 0; i < 8; ++i) { const int idx = tid + 512 * i, t = idx >> 5, s0 = (idx & 31) * 4; const f32x4 v = *(const f32x4*)(Wg + t * 128 + s0);
#pragma unroll
            for (int e = 0; e < 4; ++e) WT[t * 129 + s0 + e] = (s0 + e <= t) ? v[e] : 0.f; } }
    __syncthreads();
#pragma unroll
    for (int i = 0; i < 4; ++i) { const int idx = tid + 512 * i, row = idx >> 4, cc = (idx & 15) * 8;
        const v4u raw = *(const v4u*)(WSP(A, bf16, WS_GV) + (size_t)(m0 + row) * 2048 + ch0 + cc);
        const float mean = ST[2 * row], rstd = ST[2 * row + 1];
        const f32x4 g0 = *(const f32x4*)(IN_LNG(A) + ch0 + cc), g1 = *(const f32x4*)(IN_LNG(A) + ch0 + cc + 4), b0 = *(const f32x4*)(IN_LNB(A) + ch0 + cc), b1 = *(const f32x4*)(IN_LNB(A) + ch0 + cc + 4);
        f32x4 o0, o1;
        o0[0] = (bf_lo(raw.x) - mean) * rstd * g0[0] + b0[0]; o0[1] = (bf_hi(raw.x) - mean) * rstd * g0[1] + b0[1];
        o0[2] = (bf_lo(raw.y) - mean) * rstd * g0[2] + b0[2]; o0[3] = (bf_hi(raw.y) - mean) * rstd * g0[3] + b0[3];
        o1[0] = (bf_lo(raw.z) - mean) * rstd * g1[0] + b1[0]; o1[1] = (bf_hi(raw.z) - mean) * rstd * g1[1] + b1[1];
        o1[2] = (bf_lo(raw.w) - mean) * rstd * g1[2] + b1[2]; o1[3] = (bf_hi(raw.w) - mean) * rstd * g1[3] + b1[3];
        *(LAS f32x4*)(VN + row * 128 + cc) = o0; *(LAS f32x4*)(VN + row * 128 + cc + 4) = o1; }
    __syncthreads();
    const int t = tid >> 2, dq = tid & 3, tmax = (F.wave * 16 + 15);
    f32x4 acc[8];
#pragma unroll
    for (int i = 0; i < 8; ++i) acc[i] = (f32x4){0.f, 0.f, 0.f, 0.f};
    for (int s = 0; s <= tmax; ++s) { const float w = WT[t * 129 + s];
#pragma unroll
        for (int i = 0; i < 8; ++i) acc[i] += w * *(const LAS f32x4*)(VN + s * 128 + dq * 32 + 4 * i); }
    const float bs = IN_SGUB(A)[g * 128 + t];
    const size_t off = (size_t)(m0 + t) * 2048 + ch0 + dq * 32;
#pragma unroll
    for (int i = 0; i < 4; ++i) { const v4u gu = *(const v4u*)(WSP(A, bf16, WS_GU) + off + 8 * i), sb = *(const v4u*)(WSP(A, bf16, WS_SGB) + off + 8 * i); const f32x4 a0 = acc[2 * i], a1 = acc[2 * i + 1]; v4u o;
        o.x = pk2(bf_lo(gu.x) * (a0[0] + bs) * bf_lo(sb.x), bf_hi(gu.x) * (a0[1] + bs) * bf_hi(sb.x));
        o.y = pk2(bf_lo(gu.y) * (a0[2] + bs) * bf_lo(sb.y), bf_hi(gu.y) * (a0[3] + bs) * bf_hi(sb.y));
        o.z = pk2(bf_lo(gu.z) * (a1[0] + bs) * bf_lo(sb.z), bf_hi(gu.z) * (a1[1] + bs) * bf_hi(sb.z));
        o.w = pk2(bf_lo(gu.w) * (a1[2] + bs) * bf_lo(sb.w), bf_hi(gu.w) * (a1[3] + bs) * bf_hi(sb.w));
        *(v4u*)(WSP(A, bf16, WS_GU) + off + 8 * i) = o; }
    __syncthreads();
}
__device__ __forceinline__ void attn_gather_phase(Frame& F, const Args& A) {
    asm volatile("; ATTN_BEGIN" ::: "memory");
    const int lane = F.lane, gw = F.vcu * NWAVES + F.wave, NGW = F.G * NWAVES;
    LAS unsigned char* wl = F.lds + F.wave * 8192;
    LAS unsigned short* IDX = (LAS unsigned short*)wl;
    LAS float* QF = (LAS float*)(wl + 512);
    LAS float* PB = (LAS float*)(wl + 2560);
    for (int task = gw; task < MTOK * 4; task += NGW) {
        const int m = task >> 2, g = task & 3, b = m >> 12, t = m & 4095;
        const unsigned long long word = WSP(A, unsigned long long, WS_MASK)[(size_t)m * 64 + lane];
        int cnt = 0;
        for (int j = 0; j <= (t >> 6); ++j) {
            const unsigned lo = __builtin_amdgcn_readlane((unsigned)word, j), hi = __builtin_amdgcn_readlane((unsigned)(word >> 32), j);
            const unsigned long long wj = ((unsigned long long)hi << 32) | lo;
            if ((wj >> lane) & 1ull) IDX[cnt + mbcnt64(wj)] = (unsigned short)(64 * j + lane);
            cnt += __builtin_popcountll(wj);
        }
        { const v4u raw = *(const v4u*)(WSP(A, bf16, WS_Q2) + (((size_t)(b * 4 + g) * SEQ + t) * 4) * 128 + lane * 8);
          f32x4 a = {bf_lo(raw.x), bf_hi(raw.x), bf_lo(raw.y), bf_hi(raw.y)}, c = {bf_lo(raw.z), bf_hi(raw.z), bf_lo(raw.w), bf_hi(raw.w)};
          *(LAS f32x4*)(QF + lane * 8) = a; *(LAS f32x4*)(QF + lane * 8 + 4) = c; }
        LDS_WAIT(); asm volatile("" ::: "memory");
        const bf16* Kg = WSP(A, bf16, WS_K2) + (size_t)(b * 4 + g) * SEQ * 128; const bf16* Vg = WSP(A, bf16, WS_V2) + (size_t)(b * 4 + g) * SEQ * 128;
        float mx[4] = {-3.0e38f, -3.0e38f, -3.0e38f, -3.0e38f};
        for (int i = 0; i < 4; ++i) { const int n = lane + 64 * i;
            if (n < cnt) { const int s = IDX[n]; const bf16* kr = Kg + (size_t)s * 128; float a4[4] = {0.f, 0.f, 0.f, 0.f};
                for (int dd = 0; dd < 16; ++dd) { const v4u kraw = *(const v4u*)(kr + dd * 8);
                    const float k8[8] = {bf_lo(kraw.x), bf_hi(kraw.x), bf_lo(kraw.y), bf_hi(kraw.y), bf_lo(kraw.z), bf_hi(kraw.z), bf_lo(kraw.w), bf_hi(kraw.w)};
#pragma unroll
                    for (int h = 0; h < 4; ++h) { const f32x4 q0 = *(const LAS f32x4*)(QF + h * 128 + dd * 8), q1 = *(const LAS f32x4*)(QF + h * 128 + dd * 8 + 4);
                        a4[h] += (q0[0] * k8[0] + q0[1] * k8[1]) + (q0[2] * k8[2] + q0[3] * k8[3]) + (q1[0] * k8[4] + q1[1] * k8[5]) + (q1[2] * k8[6] + q1[3] * k8[7]); } }
                const int dist = t - s; const float* bt = WSP(A, float, WS_BTAB) + (dist < 127 ? dist : 127) * 16 + g * 4;
#pragma unroll
                for (int h = 0; h < 4; ++h) { const float l = a4[h] + bt[h]; PB[h * 256 + n] = l; mx[h] = fmaxf(mx[h], l); } } }
        float li[4];
#pragma unroll
        for (int h = 0; h < 4; ++h) { mx[h] = wave_max(mx[h]); float sm = 0.f;
            for (int i = 0; i < 4; ++i) { const int n = lane + 64 * i; if (n < cnt) { const float p = __builtin_amdgcn_exp2f(PB[h * 256 + n] - mx[h]); PB[h * 256 + n] = p; sm += p; } }
            li[h] = 1.0f / wave_sum(sm); }
        LDS_WAIT(); asm volatile("" ::: "memory");
        float o[4][2] = {{0.f, 0.f}, {0.f, 0.f}, {0.f, 0.f}, {0.f, 0.f}};
        for (int n = 0; n < cnt; ++n) { const int s = IDX[n]; const unsigned vraw = *(const unsigned*)(Vg + (size_t)s * 128 + 2 * lane); const float v0 = bf_lo(vraw), v1 = bf_hi(vraw);
#pragma unroll
            for (int h = 0; h < 4; ++h) { const float p = PB[h * 256 + n]; o[h][0] += p * v0; o[h][1] += p * v1; } }
#pragma unroll
        for (int h = 0; h < 4; ++h) { const size_t off = (size_t)m * 2048 + (g * 4 + h) * 128 + 2 * lane;
            const unsigned ga = *(const unsigned*)(WSP(A, bf16, WS_SGA) + off), sp = *(const unsigned*)(WSP(A, bf16, WS_GU) + off);
            *(unsigned*)(WSP(A, bf16, WS_MERGED) + off) = pk2(bf_lo(ga) * (o[h][0] * li[h]) + bf_lo(sp), bf_hi(ga) * (o[h][1] * li[h]) + bf_hi(sp)); }
        LDS_WAIT(); asm volatile("" ::: "memory");
    }
    asm volatile("; ATTN_END" ::: "memory");
}
__device__ __forceinline__ void final_norm_phase(Frame& F, const Args& A) {
    const int lane = F.lane, gw = F.vcu * NWAVES + F.wave, NGW = F.G * NWAVES;
    for (int m = gw; m < MTOK; m += NGW) {
        float s = lane < 32 ? WSP(A, float, WS_SSQ3)[(size_t)m * 32 + lane] : 0.f; s = wave_sum(s);
        const float rs = 1.0f / sqrtf(s * (1.0f / DM) + EPS);
        GAS f32x4* xr = (GAS f32x4*)((A).out + (size_t)m * DM) + lane; const GAS f32x4* gr = (const GAS f32x4*)IN_FING(A) + lane;
#pragma unroll
        for (int j = 0; j < 8; ++j) { const f32x4 v = xr[64 * j], g = gr[64 * j]; xr[64 * j] = v * rs * g; }
    }
}
namespace att {
constexpr int D = 128, NW = 8, QBLK = 32, KVBLK = 64, QB = 256, SHM_V = 16384, SHM_K = 16384;
constexpr int NRING = 3;
constexpr int L_V = 0, L_K = NRING * SHM_V, L_WS = L_K + NRING * SHM_K, L_BT = L_WS + NW * 64 * 4, L_OST = L_BT + 2048, L_END = L_OST + NW * 4096;
constexpr int SG_V = 0, SG_WS = 65536, SG_OST = 69632;
constexpr float THR2 = 11.5f;
#define KSWZ(row, colB) ((row) * 256 + ((colB) ^ (((row) & 7) << 4)))
#define SBAR() __builtin_amdgcn_sched_barrier(0)
typedef short s16x4 __attribute__((ext_vector_type(4)));
__device__ __forceinline__ int v_st(int k, int c) { const int kk = (k & ~0xC) | ((k & 4) << 1) | ((k & 8) >> 1); return ((kk >> 3) * 4 + (c >> 5)) * 512 + ((kk & 7) * 32 + (c & 31)) * 2; }
__device__ __forceinline__ int v_rd_base(int lane) { return ((lane & 3) << 3) | (((lane >> 2) & 3) << 6) | (((lane >> 4) & 1) << 5) | (((lane >> 5) & 1) << 8); }
constexpr int v_rd_off(int d0, int ks, int half) { return d0 * 512 + ks * 4096 + half * 2048; }
__device__ __forceinline__ int crow(int r, int hi) { return (r & 3) + 8 * (r >> 2) + 4 * hi; }
__device__ __forceinline__ unsigned cvtpk(float lo, float hi) { unsigned r; asm volatile("v_cvt_pk_bf16_f32 %0, %1, %2" : "=v"(r) : "v"(lo), "v"(hi)); return r; }
typedef unsigned u32x16 __attribute__((ext_vector_type(16)));
template <int OFF> __device__ __forceinline__ u32x16 lm_load(const void* p) { u32x16 v; asm volatile("s_load_dwordx16 %0, %1, %2 glc" : "=&s"(v) : "s"(p), "i"(OFF)); return v; }
__device__ __forceinline__ void lm_wait(u32x16& a, u32x16& b) { asm volatile("s_waitcnt lgkmcnt(0)" : "+s"(a), "+s"(b)); }
__device__ __forceinline__ void lm_apply(f32x16& p, const u32x16& a, const u32x16& b, float neg) {
#pragma unroll
    for (int k = 0; k < 8; ++k) { const unsigned long long mk = (unsigned long long)a[2 * k] | ((unsigned long long)a[2 * k + 1] << 32);
        asm volatile("v_cndmask_b32_e64 %0, %1, %0, %2" : "+v"(p[k]) : "v"(neg), "s"(mk)); }
#pragma unroll
    for (int k = 0; k < 8; ++k) { const unsigned long long mk = (unsigned long long)b[2 * k] | ((unsigned long long)b[2 * k + 1] << 32);
        asm volatile("v_cndmask_b32_e64 %0, %1, %0, %2" : "+v"(p[8 + k]) : "v"(neg), "s"(mk)); }
}
__device__ __forceinline__ void band_bias(f32x16& p0, f32x16& p1, int dq, const LAS float* bt) {
#pragma unroll
    for (int r = 0; r < 16; ++r) { const int c = (r & 3) + 8 * (r >> 2); const unsigned d0 = (unsigned)(dq - c), d1 = (unsigned)(dq - c - 32);
        p0[r] += bt[(d0 < 127u ? d0 : 127u) * 4]; p1[r] += bt[(d1 < 127u ? d1 : 127u) * 4]; }
}
__device__ __forceinline__ float fadd_s(float x, float y) { float r; asm("v_add_f32_e32 %0, %1, %2" : "=v"(r) : "v"(x), "v"(y)); return r; }
__device__ __forceinline__ float fsub_s(float x, float y) { float r; asm("v_sub_f32_e32 %0, %1, %2" : "=v"(r) : "v"(x), "v"(y)); return r; }
__device__ __forceinline__ void partialSM(f32x16& p0, f32x16& p1, float& m_reg, float& mn, float& alpha) {
    float pmax = p0[0];
#pragma unroll
    for (int r = 1; r < 16; ++r) pmax = fmaxf(pmax, p0[r]);
#pragma unroll
    for (int r = 0; r < 16; ++r) pmax = fmaxf(pmax, p1[r]);
    { auto rr = __builtin_amdgcn_permlane32_swap(__float_as_uint(pmax), __float_as_uint(pmax), false, false);
      pmax = fmaxf(__uint_as_float(rr[0]), __uint_as_float(rr[1])); }
    if (__builtin_expect(__all((pmax - m_reg) <= THR2), 1)) { mn = m_reg; alpha = 1.f; }
    else { mn = fmaxf(m_reg, pmax); alpha = __builtin_amdgcn_exp2f(m_reg - mn); m_reg = mn; }
#pragma unroll
    for (int r = 0; r < 16; ++r) { p0[r] = fsub_s(p0[r], mn); p1[r] = fsub_s(p1[r], mn); }
#pragma unroll
    for (int r = 0; r < 16; ++r) p0[r] = __builtin_amdgcn_exp2f(p0[r]);
}
__device__ __forceinline__ void finishSM(f32x16& p0, f32x16& p1, float alpha, float& l_reg, bf16x8& pa0, bf16x8& pa1, bf16x8& pa2, bf16x8& pa3) {
#pragma unroll
    for (int r = 0; r < 16; ++r) p1[r] = __builtin_amdgcn_exp2f(p1[r]);
    float ps = fadd_s(p0[0], p0[1]), ps1 = fadd_s(p0[2], p0[3]), ps2 = fadd_s(p1[0], p1[1]), ps3 = fadd_s(p1[2], p1[3]);
#pragma unroll
    for (int r = 4; r < 16; r += 2) { ps = fadd_s(ps, p0[r]); ps1 = fadd_s(ps1, p0[r + 1]); ps2 = fadd_s(ps2, p1[r]); ps3 = fadd_s(ps3, p1[r + 1]); }
    ps = fadd_s(fadd_s(ps, ps1), fadd_s(ps2, ps3));
    { auto rr = __builtin_amdgcn_permlane32_swap(__float_as_uint(ps), __float_as_uint(ps), false, false);
      ps = __uint_as_float(rr[0]) + __uint_as_float(rr[1]); }
    l_reg = l_reg * alpha + ps;
#define PK4(P, B_, OUT) do { unsigned a0 = cvtpk(P[B_+0], P[B_+1]), a1 = cvtpk(P[B_+2], P[B_+3]);                          \
        unsigned b0 = cvtpk(P[B_+4], P[B_+5]), b1 = cvtpk(P[B_+6], P[B_+7]);                                             \
        auto r0 = __builtin_amdgcn_permlane32_swap(a0, b0, false, false); auto r1 = __builtin_amdgcn_permlane32_swap(a1, b1, false, false); \
        v4u w = {r0[0], r1[0], r0[1], r1[1]}; OUT = *reinterpret_cast<bf16x8*>(&w); } while (0)
    PK4(p0, 0, pa0); PK4(p0, 8, pa1); PK4(p1, 0, pa2); PK4(p1, 8, pa3);
#undef PK4
}
template <int KB>
__device__ __forceinline__ void qkt(f32x16& p0, f32x16& p1, const char* K_lds, int r32, int hi, const bf16x8* qr) {
    p0 = f32x16{}; p1 = f32x16{};
    const char* kb[4];
#pragma unroll
    for (int dd = 0; dd < 4; ++dd) kb[dd] = K_lds + KB * SHM_K + KSWZ(r32, (dd * 16 + hi * 8) * 2);
#pragma unroll
    for (int d0 = 0; d0 < 8; ++d0) { const char* a = kb[d0 & 3] + (d0 >> 2) * 128;
        bf16x8 b0 = *reinterpret_cast<const bf16x8*>(a);
        bf16x8 b1 = *reinterpret_cast<const bf16x8*>(a + 32 * 256);
        p0 = __builtin_amdgcn_mfma_f32_32x32x16_bf16(b0, qr[d0], p0, 0, 0, 0);
        p1 = __builtin_amdgcn_mfma_f32_32x32x16_bf16(b1, qr[d0], p1, 0, 0, 0); }
}
template <int VB>
__device__ __forceinline__ void pv_tile(f32x16* o, int vb0, bf16x8 pa0, bf16x8 pa1, bf16x8 pa2, bf16x8 pa3) {
#define TRRD(dst, off) asm volatile("ds_read_b64_tr_b16 %0, %1 offset:%2" : "=&v"(dst) : "v"(vb0), "i"(off) : "memory")
#define PV_D0(d0) do { s16x4 l0, l1, l2, l3, h0, h1, h2, h3; constexpr int b_ = VB * SHM_V + v_rd_off(d0, 0, 0); \
        TRRD(l0, b_); TRRD(h0, b_ + 2048); TRRD(l1, b_ + 4096); TRRD(h1, b_ + 6144); TRRD(l2, b_ + 8192); TRRD(h2, b_ + 10240); TRRD(l3, b_ + 12288); TRRD(h3, b_ + 14336); \
        asm volatile("s_waitcnt lgkmcnt(0)" ::: "memory"); SBAR();   \
        o[d0] = __builtin_amdgcn_mfma_f32_32x32x16_bf16(pa0, (bf16x8){l0[0], l0[1], l0[2], l0[3], h0[0], h0[1], h0[2], h0[3]}, o[d0], 0, 0, 0);   \
        o[d0] = __builtin_amdgcn_mfma_f32_32x32x16_bf16(pa1, (bf16x8){l1[0], l1[1], l1[2], l1[3], h1[0], h1[1], h1[2], h1[3]}, o[d0], 0, 0, 0);   \
        o[d0] = __builtin_amdgcn_mfma_f32_32x32x16_bf16(pa2, (bf16x8){l2[0], l2[1], l2[2], l2[3], h2[0], h2[1], h2[2], h2[3]}, o[d0], 0, 0, 0);   \
        o[d0] = __builtin_amdgcn_mfma_f32_32x32x16_bf16(pa3, (bf16x8){l3[0], l3[1], l3[2], l3[3], h3[0], h3[1], h3[2], h3[3]}, o[d0], 0, 0, 0); } while (0)
    PV_D0(0); PV_D0(1); PV_D0(2); PV_D0(3);
#undef PV_D0
#undef TRRD
}
struct BlockRef { const bf16* Q; const bf16* K; const bf16* V; const unsigned long long* LMB; int qb; int m0; };
__device__ __forceinline__ bf16x8 ld8(const bf16* p) { return *reinterpret_cast<const bf16x8*>(p); }
#define ROW(p, k0, rr) ((p) + (size_t)((k0) + (rr)) * D + sc)
#define VMW() asm volatile("s_waitcnt vmcnt(0)" ::: "memory")
#define SLOAD_H(Kp, Vp, k0) do { st_v0 = ld8(ROW(Vp, k0, sr)); st_v1 = ld8(ROW(Vp, k0, 32 + sr)); st_k0 = ld8(ROW(Kp, k0, sr)); st_k1 = ld8(ROW(Kp, k0, 32 + sr)); } while (0)
#define SWRITE_H(bf) do { *(bf16x8*)(V_lds + (bf) * SHM_V + vst0) = st_v0; *(bf16x8*)(V_lds + (bf) * SHM_V + vst1) = st_v1; \
                          *(bf16x8*)(K_lds + (bf) * SHM_K + kws) = st_k0; *(bf16x8*)(K_lds + (bf) * SHM_K + kws + 32 * 256) = st_k1; } while (0)
__device__ __forceinline__ void attn_block(const BlockRef& cur, char* lds, int g4, const bf16* SGA, const bf16* SP, bf16* MERGED) {
    const int tid = threadIdx.x, wid = __builtin_amdgcn_readfirstlane(tid >> 6), lane = tid & 63, r32 = lane & 31, hi = lane >> 5;
    const bool lag = wid >= 4;
    const int NT = cur.qb + 1;
    char* V_lds = lds + L_V; char* K_lds = lds + L_K;
    float* ws = (float*)(lds + L_WS) + wid * 64; float* li_l = ws, * al_l = ws + 32;
    const LAS float* bt = (const LAS float*)((LAS char*)(lds + L_BT)) + (r32 & 3);
    const int sr = tid >> 4, sc = (tid & 15) * 8, vst0 = v_st(sr, sc), vst1 = v_st(32 + sr, sc), kws = KSWZ(sr, sc * 2);
    const int vb0 = (int)(uintptr_t)V_lds + v_rd_base(lane);
    const bf16* Kh = cur.K; const bf16* Vh = cur.V;
    const char* lmw = (const char*)(cur.LMB + (size_t)wid * 64 * 32);
    const float NEGINF = -__builtin_inff();
    const int qpos = cur.qb * 64 + wid * 8 + (r32 >> 2);
    const int qlo = cur.qb * 64 + wid * 8;
    bf16x8 qr[8], st_v0, st_v1, st_k0, st_k1;
#pragma unroll
    for (int d0 = 0; d0 < 8; ++d0) qr[d0] = ld8(cur.Q + (size_t)(wid * QBLK + r32) * D + d0 * 16 + hi * 8);
    SLOAD_H(Kh, Vh, 0); VMW(); SWRITE_H(0);
    __syncthreads();
    float m_reg = -1e30f, l_reg = 0; f32x16 o[4] = {};
    bf16x8 pa0, pa1, pa2, pa3;
    u32x16 ma_ = lm_load<0>(lmw), mb_ = lm_load<64>(lmw), mc_ = lm_load<128>(lmw), md_ = lm_load<192>(lmw);
#define STEP(BUF, NBUF_, PBUF_, t) do {                                                                                       \
        if ((t) + 1 < NT) SLOAD_H(Kh, Vh, ((t) + 1) * KVBLK);                                                                 \
        SBAR(); if (lag && (t) > 0) { __builtin_amdgcn_s_setprio(1); pv_tile<PBUF_>(o, vb0, pa0, pa1, pa2, pa3); __builtin_amdgcn_s_setprio(0); } \
        SBAR(); f32x16 p0, p1; __builtin_amdgcn_s_setprio(1); qkt<BUF>(p0, p1, K_lds, r32, hi, qr); __builtin_amdgcn_s_setprio(0);     \
        asm volatile("s_nop 15\n\ts_nop 7" : "+v"(p0), "+v"(p1));     \
        lm_wait(ma_, mb_); lm_wait(mc_, md_); lm_apply(p0, ma_, mb_, NEGINF); lm_apply(p1, mc_, md_, NEGINF);                 \
        { const char* lmp_ = lmw + (size_t)((t) + 1 < NT ? (t) + 1 : (t)) * 256;     \
          ma_ = lm_load<0>(lmp_); mb_ = lm_load<64>(lmp_); mc_ = lm_load<128>(lmp_); md_ = lm_load<192>(lmp_); }                \
        if (qlo - ((t) * KVBLK + KVBLK - 1) < 113) band_bias(p0, p1, qpos - (t) * KVBLK - 4 * hi, bt);                        \
        float mn_, al_; partialSM(p0, p1, m_reg, mn_, al_);                                                                   \
        finishSM(p0, p1, al_, l_reg, pa0, pa1, pa2, pa3);                                                                     \
        if (__any(al_ < 1.f)) { if (hi == 0) al_l[r32] = al_; asm volatile("s_waitcnt lgkmcnt(0)" ::: "memory");              \
            for (int d_ = 0; d_ < 4; ++d_) for (int r = 0; r < 16; ++r) o[d_][r] *= al_l[crow(r, hi)]; }                      \
        SBAR(); if (!lag) { __builtin_amdgcn_s_setprio(1); pv_tile<BUF>(o, vb0, pa0, pa1, pa2, pa3); __builtin_amdgcn_s_setprio(0); } \
        SBAR(); if ((t) + 1 < NT) { VMW(); SWRITE_H(NBUF_); }                                                                 \
        __syncthreads(); } while (0)
    for (int t = 0; t < NT; t += 3) { STEP(0, 1, 2, t); if (t + 1 < NT) STEP(1, 2, 0, t + 1); if (t + 2 < NT) STEP(2, 0, 1, t + 2); }
#undef STEP
    if (lag) { const int lb = (NT - 1) % 3;
        if (lb == 0) pv_tile<0>(o, vb0, pa0, pa1, pa2, pa3); else if (lb == 1) pv_tile<1>(o, vb0, pa0, pa1, pa2, pa3); else pv_tile<2>(o, vb0, pa0, pa1, pa2, pa3); }
    v4u gal[4][2], spl[4][2];
#pragma unroll
    for (int d0 = 0; d0 < 4; ++d0)
#pragma unroll
        for (int i = 0; i < 2; ++i) { const int cid = lane + 64 * i, row = cid >> 2, c8 = (cid & 3) * 8;
            const size_t off = (size_t)(cur.m0 + wid * 8 + (row >> 2)) * 2048 + (g4 * 4 + (row & 3)) * 128 + d0 * 32 + c8;
            gal[d0][i] = __builtin_nontemporal_load((const v4u*)(SGA + off)); spl[d0][i] = __builtin_nontemporal_load((const v4u*)(SP + off)); }
    if (hi == 0) li_l[r32] = l_reg; asm volatile("s_waitcnt lgkmcnt(0)" ::: "memory");
    float rli[16];
#pragma unroll
    for (int r = 0; r < 16; ++r) rli[r] = __builtin_amdgcn_rcpf(li_l[crow(r, hi)]);
    float* ost = (float*)(lds + L_OST) + wid * 1024;
#pragma unroll
    for (int d0 = 0; d0 < 4; ++d0) {
#pragma unroll
        for (int r = 0; r < 16; ++r) ost[crow(r, hi) * 32 + r32] = o[d0][r] * rli[r];
        asm volatile("s_waitcnt lgkmcnt(0)" ::: "memory");
#pragma unroll
        for (int i = 0; i < 2; ++i) { const int cid = lane + 64 * i, row = cid >> 2, c8 = (cid & 3) * 8;
            const f32x4 a = *(const f32x4*)(ost + row * 32 + c8), c = *(const f32x4*)(ost + row * 32 + c8 + 4);
            const size_t off = (size_t)(cur.m0 + wid * 8 + (row >> 2)) * 2048 + (g4 * 4 + (row & 3)) * 128 + d0 * 32 + c8;
            const v4u ga = gal[d0][i], sp = spl[d0][i]; v4u w;
            w.x = pk2(bf_lo(ga.x) * a[0] + bf_lo(sp.x), bf_hi(ga.x) * a[1] + bf_hi(sp.x)); w.y = pk2(bf_lo(ga.y) * a[2] + bf_lo(sp.y), bf_hi(ga.y) * a[3] + bf_hi(sp.y));
            w.z = pk2(bf_lo(ga.z) * c[0] + bf_lo(sp.z), bf_hi(ga.z) * c[1] + bf_hi(sp.z)); w.w = pk2(bf_lo(ga.w) * c[2] + bf_lo(sp.w), bf_hi(ga.w) * c[3] + bf_hi(sp.w));
            pg8::st16_out(MERGED + off, w); }
        asm volatile("s_waitcnt lgkmcnt(0)" ::: "memory");
    }
    __syncthreads();
}
#undef ROW
#undef VMW
#undef SLOAD_H
#undef SWRITE_H
#undef KSWZ
#undef SBAR
}

__device__ __forceinline__ void sgu_pair_unit(Frame& F, const Args& A, unsigned char* lds_generic, int b, int c, int gp, int cvi) {
    using namespace att;
    char* lds = (char*)lds_generic;
    const int tid = F.tid, wid = F.wave, lane = F.lane, r32 = lane & 31, hi = lane >> 5;
    const int m0 = b * SEQ + c * 128;
    LAS float* ST = (LAS float*)(F.lds + SG_WS);
    float cv0[32], cv1[32]; const int cvj = cvi + F.G * NWAVES; const bool cva = cvi >= 0 && cvi < CV_I_LATE, cvb = cvi >= 0 && cvj < CV_I_LATE;
    const CvItem ci0 = cv_item_late(A, cva ? cvi : 0), ci1 = cv_item_late(A, cvb ? cvj : 0);
    if (cva) cv_issue(cv0, ci0, lane); if (cvb) cv_issue(cv1, ci1, lane);
    if (tid < 128) { const float* p = WSP(A, float, WS_VST) + (size_t)(m0 + tid) * 64; float s = 0.f, q = 0.f;
#pragma unroll
        for (int i = 0; i < 16; ++i) { const f32x4 v = *(const f32x4*)(p + 4 * i); s += v[0] + v[2]; q += v[1] + v[3]; }
        const float mean = s * (1.0f / 2048.0f), var = q * (1.0f / 2048.0f) - mean * mean;
        ST[2 * tid] = mean; ST[2 * tid + 1] = 1.0f / sqrtf(var + EPS); }
    __syncthreads();
#pragma unroll
    for (int i = 0; i < 8; ++i) { const int id = tid + 512 * i, grp = id >> 11, s = (id >> 4) & 127, cc = (id & 15) * 8, ch = (2 * gp + grp) * 128 + cc;
        const v4u raw = __builtin_nontemporal_load((const v4u*)(WSP(A, bf16, WS_GV) + (size_t)(m0 + s) * 2048 + ch));
        const float mean = ST[2 * s], rstd = ST[2 * s + 1];
        const f32x4 g0 = *(const f32x4*)(IN_LNG(A) + ch), g1 = *(const f32x4*)(IN_LNG(A) + ch + 4), b0 = *(const f32x4*)(IN_LNB(A) + ch), b1 = *(const f32x4*)(IN_LNB(A) + ch + 4);
        v4u o;
        o.x = pk2((bf_lo(raw.x) - mean) * rstd * g0[0] + b0[0], (bf_hi(raw.x) - mean) * rstd * g0[1] + b0[1]);
        o.y = pk2((bf_lo(raw.y) - mean) * rstd * g0[2] + b0[2], (bf_hi(raw.y) - mean) * rstd * g0[3] + b0[3]);
        o.z = pk2((bf_lo(raw.z) - mean) * rstd * g1[0] + b1[0], (bf_hi(raw.z) - mean) * rstd * g1[1] + b1[1]);
        o.w = pk2((bf_lo(raw.w) - mean) * rstd * g1[2] + b1[2], (bf_hi(raw.w) - mean) * rstd * g1[3] + b1[3]);
        *(v4u*)(lds + SG_V + (grp * 2 + (s >> 6)) * SHM_V + v_st(s & 63, cc)) = o; }
    if (cva) cv_finish(cv0, ci0, (LAS float*)(F.lds + SG_OST + wid * 9728), lane);
    __syncthreads();
    if (cvb) cv_finish(cv1, ci1, (LAS float*)(F.lds + SG_OST + wid * 9728), lane);
    const int grp = wid >> 2, w4 = wid & 3, g = 2 * gp + grp;
    const int vb0 = (int)(uintptr_t)(lds + SG_V) + v_rd_base(lane);
    const bf16* wrow = WSP(A, bf16, WS_WSB) + ((size_t)g * 128 + 32 * w4 + r32) * 128 + 8 * hi;
    f32x16 o[4] = {};
    { const bf16x8 a0 = *(const bf16x8*)(wrow), a1 = *(const bf16x8*)(wrow + 16), a2 = *(const bf16x8*)(wrow + 32), a3 = *(const bf16x8*)(wrow + 48);
      if (grp == 0) pv_tile<0>(o, vb0, a0, a1, a2, a3); else pv_tile<2>(o, vb0, a0, a1, a2, a3); }
    if (w4 >= 2) { const bf16x8 a0 = *(const bf16x8*)(wrow + 64), a1 = *(const bf16x8*)(wrow + 80), a2 = *(const bf16x8*)(wrow + 96), a3 = *(const bf16x8*)(wrow + 112);
      if (grp == 0) pv_tile<1>(o, vb0, a0, a1, a2, a3); else pv_tile<3>(o, vb0, a0, a1, a2, a3); }
    float* ost = (float*)(lds + SG_OST + wid * 9728);
    bf16* GU = WSP(A, bf16, WS_GU); const bf16* SGB = WSP(A, bf16, WS_SGB);
#pragma unroll
    for (int hf = 0; hf < 2; ++hf) {
#pragma unroll
        for (int r = 0; r < 16; ++r) { const int orow = crow(r, hi); ost[orow * 64 + r32] = o[2 * hf][r]; ost[orow * 64 + 32 + r32] = o[2 * hf + 1][r]; }
        asm volatile("s_waitcnt lgkmcnt(0)" ::: "memory");
#pragma unroll
        for (int i = 0; i < 4; ++i) { const int cid = lane + 64 * i, row = cid >> 3, c8 = (cid & 7) * 8, t = 32 * w4 + row;
            const f32x4 a = *(const f32x4*)(ost + row * 64 + c8), cq = *(const f32x4*)(ost + row * 64 + c8 + 4);
            const float bs = IN_SGUB(A)[g * 128 + t];
            const size_t off = (size_t)(m0 + t) * 2048 + g * 128 + hf * 64 + c8;
            const v4u gu = __builtin_nontemporal_load((const v4u*)(GU + off)), sb = __builtin_nontemporal_load((const v4u*)(SGB + off)); v4u w;
#define GS2(GW, SW) pg8::gelu_sig2((pg8::f32x2){bf_lo(GW), bf_hi(GW)}, (pg8::f32x2){bf_lo(SW), bf_hi(SW)})
            const pg8::f32x2 h0 = GS2(gu.x, sb.x), h1 = GS2(gu.y, sb.y), h2 = GS2(gu.z, sb.z), h3 = GS2(gu.w, sb.w);
#undef GS2
            w.x = pk2(h0.x * (a[0] + bs), h0.y * (a[1] + bs)); w.y = pk2(h1.x * (a[2] + bs), h1.y * (a[3] + bs));
            w.z = pk2(h2.x * (cq[0] + bs), h2.y * (cq[1] + bs)); w.w = pk2(h3.x * (cq[2] + bs), h3.y * (cq[3] + bs));
            pg8::st16_out(GU + off, w); }
        asm volatile("s_waitcnt lgkmcnt(0)" ::: "memory");
    }
    __syncthreads();
}
__device__ __forceinline__ void attn_mfma_phase(Frame& F, const Args& A, unsigned char* lds_generic) {
    char* lds = (char*)lds_generic;
    for (int item = F.vcu; item < 256; item += F.G) {
        const int bg = item >> 5, pi = item & 31, b = bg >> 2, g = bg & 3;
        { LAS float* BT = (LAS float*)(F.lds + att::L_BT); const float* src = WSP(A, float, WS_BTAB);
          if (F.tid < 512) BT[F.tid] = src[(F.tid >> 2) * 16 + g * 4 + (F.tid & 3)]; }
        const bf16* Qg = WSP(A, bf16, WS_Q2) + (size_t)bg * SEQ * 4 * 128; const bf16* Kg = WSP(A, bf16, WS_K2) + (size_t)bg * SEQ * 128; const bf16* Vg = WSP(A, bf16, WS_V2) + (size_t)bg * SEQ * 128;
        const unsigned long long* Lb = WSP(A, unsigned long long, WS_LM) + (size_t)b * 512 * 64 * 32;
        const int q1 = 63 - pi;
        att::BlockRef cur{Qg + (size_t)pi * 256 * 128, Kg, Vg, Lb + (size_t)pi * 8 * 64 * 32, pi, b * SEQ + pi * 64};
        const att::BlockRef r1{Qg + (size_t)q1 * 256 * 128, Kg, Vg, Lb + (size_t)q1 * 8 * 64 * 32, q1, b * SEQ + q1 * 64};
        for (int pass = 0; pass < 2; ++pass) {
            att::attn_block(cur, lds, g, WSP(A, bf16, WS_SGA), WSP(A, bf16, WS_GU), WSP(A, bf16, WS_MERGED));
            cur = r1;
        }
    }
}
#ifndef LATE_CONV
#define LATE_CONV 1
#endif
#ifndef SGU_MFMA
#define SGU_MFMA 1
#endif
#ifndef PHASE_MIX
#define PHASE_MIX 1
#endif
#ifndef ATTN_MFMA
#define ATTN_MFMA 1
#endif
__global__ void __launch_bounds__(NWAVES * 64, 2) hybrid_fwd(const Args A) {
    extern __shared__ __attribute__((aligned(16))) unsigned char lds[];
    Frame F;
    F.lds = (LAS unsigned char*)lds;
    F.MISC = (volatile LAS unsigned*)(F.lds + MISC_OFF);
    F.tid = threadIdx.x; F.lane = F.tid & 63; F.wave = __builtin_amdgcn_readfirstlane(F.tid >> 6);
    F.G = gridDim.x; { const int bx = blockIdx.x; F.vcu = (F.G % 8 == 0) ? (bx % 8) * (F.G / 8) + bx / 8 : bx; }
    F.ctl = (gu32*)(A.ws + WS_CTL);
    for (int u = F.tid; u < (LDS_BYTES - LDSCTL_OFF) / 4; u += NWAVES * 64) ((LAS unsigned*)(F.lds + LDSCTL_OFF))[u] = 0u;
    __syncthreads();
    const int lo = A.ph_lo, hi = A.ph_hi;
    const bool one_launch = (hi - lo) > 1;
    XcdBarrier bar; bar.bar = (unsigned*)(F.ctl + CW_BAR); bar.x = 0; bar.st = nullptr;
    if (one_launch) bar = xcd_barrier_post((unsigned*)(F.ctl + CW_BAR), F.MISC + 8);
#define IN(k) (lo <= (k) && (k) < hi)
#define SEAM(k) do { if (IN(k) && IN((k) + 1)) xcd_barrier(bar); } while (0)

    if (IN(0)) { p0_prologue(F, A, !LATE_CONV); } SEAM(0);

    if (IN(1)) {
        pg8::Gemm g{WSP(A, bf16, WS_XB), WSP(A, bf16, WS_WIN), MTOK, NP, DM}; pg8::StaticOrder S; S.init(MTOK, NP, F.G, (int)blockIdx.x);
        pg8::EpiProj E{WSP(A, float, WS_RS1), WSP(A, bf16, WS_Q2), WSP(A, bf16, WS_K2), WSP(A, bf16, WS_V2), WSP(A, bf16, WS_QI), WSP(A, bf16, WS_KI), WSP(A, bf16, WS_GU), WSP(A, bf16, WS_GV), WSP(A, bf16, WS_SGA), WSP(A, bf16, WS_SGB), WSP(A, float, WS_WI), WSP(A, float, WS_VST), QSCALE, IDX_SCALE, WSP(A, bf16, WS_PADD)};
        pg8::gemm_phase<pg8::EpiProj, pg8::StaticOrder, true, true>(F.lds, g, S, E);
    } SEAM(1);

    const bool sgu_first = one_launch && PHASE_MIX && (F.vcu & 1);
#define SGU_PHASE() do { if (IN(3)) { const int gwv = F.vcu * NWAVES + F.wave, NGWV = F.G * NWAVES, nun = (IDX_CV2 ? 2 : 1) * ((F.G == 256) ? 4 : (1024 - F.vcu + F.G - 1) / F.G); int k = 0; \
        for (int i = F.vcu; i < 512; i += F.G, ++k) sgu_pair_unit(F, A, lds, i >> 8, (i >> 3) & 31, i & 7, LATE_CONV ? gwv + (nun + 2 * k) * NGWV : -1); \
        if (LATE_CONV) { for (int it = gwv + (nun + 2 * k) * NGWV; it < CV_I_LATE; it += NGWV) { const CvItem ci = cv_item_late(A, it); float v[32]; cv_issue(v, ci, F.lane); cv_finish(v, ci, (LAS float*)(F.lds + F.wave * 16384), F.lane); } } \
    } } while (0)
    if (sgu_first) SGU_PHASE();
    if (IN(2)) {
        const int w = F.vcu;
        IdxFrag fr; const int nun = (F.G == 256) ? 4 : (1024 - w + F.G - 1) / F.G;
#define UNIT_B(i) ((F.G == 256) ? ((i) >> 1) : ((w + (i) * F.G) >> 9))
#define UNIT_U(i) ((F.G == 256) ? (((i) & 1) ? w : 511 - w) : ((w + (i) * F.G) & 511))
        if (UNIT_U(0) >= 32) idx_load_frag(fr, F, A, UNIT_B(0), 8 * UNIT_U(0));
        const int gwv = F.vcu * NWAVES + F.wave, NGWV = F.G * NWAVES;
        for (int i = 0; i < nun; ++i) idx_unit(fr, F, A, UNIT_B(i), UNIT_U(i), i + 1 < nun ? UNIT_B(i + 1) : 0, i + 1 < nun ? UNIT_U(i + 1) : -1, LATE_CONV ? gwv + (IDX_CV2 ? 2 : 1) * i * NGWV : -1);
#undef UNIT_B
#undef UNIT_U
    }
    if (!sgu_first) SGU_PHASE();
#undef SGU_PHASE
    SEAM(3);

#if ATTN_MFMA
    if (IN(4)) { attn_mfma_phase(F, A, lds); }
    if (one_launch && F.G == 256 && IN(4) && IN(5)) {
        pg8::Gemm g{WSP(A, bf16, WS_MERGED), WSP(A, bf16, WS_WOUT), MTOK, DM, DM}; pg8::StaticOrder S; S.init(MTOK, DM, F.G, (int)blockIdx.x);
        pg8::f32x4 acc5[2][2][4][2];
        { pg8::Unit u5; S.next(0, u5);
          const int wr = F.wave >> 2, wc = F.wave & 3, fr = F.lane & 15, fq = F.lane >> 4;
          const int r0 = u5.pm * pg8::BM + wr * 64 + fr; const bf16* xb = WSP(A, bf16, WS_XB) + (size_t)r0 * 2048 + u5.pn * pg8::BM + wc * 32 + 8 * fq; const float* rm = WSP(A, float, WS_RS1) + r0;
#pragma unroll
          for (int ai = 0; ai < 2; ++ai)
#pragma unroll
              for (int m = 0; m < 4; ++m) { const float inv = rm[ai * pg8::HALF + m * 16];
#pragma unroll
                  for (int bj = 0; bj < 2; ++bj) { const pg8::u32x4 rw = __builtin_nontemporal_load((const pg8::u32x4*)(xb + (size_t)(ai * pg8::HALF + m * 16) * 2048 + 128 * bj));
                      acc5[ai][bj][m][0] = (pg8::f32x4){__uint_as_float(rw.x << 16) * inv, __uint_as_float(rw.x & 0xffff0000u) * inv, __uint_as_float(rw.y << 16) * inv, __uint_as_float(rw.y & 0xffff0000u) * inv};
                      acc5[ai][bj][m][1] = (pg8::f32x4){__uint_as_float(rw.z << 16) * inv, __uint_as_float(rw.z & 0xffff0000u) * inv, __uint_as_float(rw.w << 16) * inv, __uint_as_float(rw.w & 0xffff0000u) * inv}; } } }
        xcd_barrier(bar);
        pg8::EpiRes<true, false, false, true> E{IN_X(A), (A).out, WSP(A, bf16, WS_H2), WSP(A, float, WS_SSQ2)};
        pg8::gemm_phase<pg8::EpiRes<true, false, false, true>, pg8::StaticOrder, true, true, true>(F.lds, g, S, E, acc5);
    } else {
    SEAM(4);
    if (IN(5)) {
        pg8::Gemm g{WSP(A, bf16, WS_MERGED), WSP(A, bf16, WS_WOUT), MTOK, DM, DM}; pg8::StaticOrder S; S.init(MTOK, DM, F.G, (int)blockIdx.x);
        pg8::EpiRes<true, true> E{IN_X(A), (A).out, WSP(A, bf16, WS_H2), WSP(A, float, WS_SSQ2)};
        pg8::gemm_phase<pg8::EpiRes<true, true>, pg8::StaticOrder, true, true>(F.lds, g, S, E);
    } }
#endif
    SEAM(5);

    if (IN(6)) {
        pg8::Gemm g{WSP(A, bf16, WS_H2), WSP(A, bf16, WS_W1), MTOK, DFF, DM}; pg8::StaticOrder S; S.init(MTOK, DFF, F.G, (int)blockIdx.x);
        pg8::EpiFF1 E{WSP(A, float, WS_SSQ2), WSP(A, bf16, WS_FF), EPS};
        pg8::gemm_phase<pg8::EpiFF1, pg8::StaticOrder, true, true>(F.lds, g, S, E);
    } SEAM(6);

    if (IN(7)) {
        pg8::Gemm g{WSP(A, bf16, WS_FF), WSP(A, bf16, WS_W2), MTOK, DM, DFF}; pg8::StaticOrder S; S.init(MTOK, DM, F.G, (int)blockIdx.x);
        if (one_launch && F.G == 256) {
            struct Hook { const XcdBarrier* b; __device__ __forceinline__ void operator()() const { xcd_barrier(*b); } };
            pg8::EpiResNorm<Hook> E{WSP(A, bf16, WS_H2), (A).out, WSP(A, float, WS_SSQ3), IN_FING(A), EPS, Hook{&bar}};
            pg8::gemm_phase<pg8::EpiResNorm<Hook>, pg8::StaticOrder, false, true>(F.lds, g, S, E);
        } else {
            pg8::EpiRes<false, true> E{(A).out, (A).out, nullptr, WSP(A, float, WS_SSQ3)};
            pg8::gemm_phase<pg8::EpiRes<false, true>, pg8::StaticOrder, true, true>(F.lds, g, S, E);
        }
    }
    if (!(one_launch && F.G == 256)) { SEAM(7); if (IN(8)) { final_norm_phase(F, A); } }
    if (IN(9) || IN(10) || IN(11) || IN(12)) { const int w = F.vcu, md = IN(10) ? 1 : IN(11) ? 2 : IN(12) ? 3 : 0; for (int i = 0; i < 4; ++i) idx_unit_probe(F, A, i >> 1, (i & 1) ? 511 - w : w, md); }
#undef IN
#undef SEAM
}

#ifndef MK_N_LAUNCHES
#define MK_N_LAUNCHES 1
#endif
constexpr int N_PHASES = 9;
#ifndef PROBE_DUP
#define PROBE_DUP (-1)
#endif
#ifndef PROBE_TAIL
#define PROBE_TAIL (-1)
#endif
extern "C" void kernel_launch(void* const* d_in, const int* in_sizes, int n_in, void* d_out, int out_size, void* d_ws, size_t ws_size, hipStream_t stream) {
    static int grid = 0;
    if (grid == 0) {
        if (n_in != 13 || in_sizes[0] != MTOK * DM || out_size != MTOK * DM || ws_size < WS_END) {
            fprintf(stderr, "kernel_launch: shape/workspace mismatch (n_in %d, in0 %d, out %d, ws %zu, need %zu); nothing launched\n", n_in, n_in > 0 ? in_sizes[0] : -1, out_size, ws_size, (size_t)WS_END); grid = -1; return; }
        int dev = 0, cus = 0, per_cu = 0;
        if (hipGetDevice(&dev) != hipSuccess || hipDeviceGetAttribute(&cus, hipDeviceAttributeMultiprocessorCount, dev) != hipSuccess) { fprintf(stderr, "kernel_launch: device query failed\n"); grid = -1; return; }
        if (hipFuncSetAttribute((const void*)hybrid_fwd, hipFuncAttributeMaxDynamicSharedMemorySize, LDS_BYTES) != hipSuccess) { fprintf(stderr, "kernel_launch: hipFuncSetAttribute failed\n"); grid = -1; return; }
        if (hipOccupancyMaxActiveBlocksPerMultiprocessor(&per_cu, (const void*)hybrid_fwd, NWAVES * 64, LDS_BYTES) != hipSuccess || per_cu < 1) { fprintf(stderr, "kernel_launch: occupancy query says %d blocks per CU\n", per_cu); }
        (void)hipGetLastError();
        grid = cus;
        fprintf(stderr, "kernel_launch: grid %d, occupancy %d, ws %zu\n", grid, per_cu, ws_size);
    }
    if (grid < 0) return;
    (void)hipMemsetAsync((char*)d_ws + WS_CTL, 0, CTL_ZERO_BYTES, stream);
    Args a{};
    for (int i = 0; i < 13; ++i) a.in[i] = (const float*)d_in[i];
    a.out = (float*)d_out; a.ws = (unsigned char*)d_ws;
    if (MK_N_LAUNCHES == 1) { a.ph_lo = 0; a.ph_hi = N_PHASES; hipLaunchKernelGGL(hybrid_fwd, dim3(grid), dim3(NWAVES * 64), LDS_BYTES, stream, a); }
    else { for (int p = 0; p < N_PHASES; ++p) { a.ph_lo = p; a.ph_hi = p + 1; for (int r = 0; r < (p == PROBE_DUP ? 2 : 1); ++r) hipLaunchKernelGGL(hybrid_fwd, dim3(grid), dim3(NWAVES * 64), LDS_BYTES, stream, a);
               if (p == 2 && PROBE_DUP >= 9) { a.ph_lo = PROBE_DUP; a.ph_hi = PROBE_DUP + 1; hipLaunchKernelGGL(hybrid_fwd, dim3(grid), dim3(NWAVES * 64), LDS_BYTES, stream, a); } }
           if (PROBE_TAIL >= 0) { a.ph_lo = PROBE_TAIL; a.ph_hi = PROBE_TAIL + 1; hipLaunchKernelGGL(hybrid_fwd, dim3(grid), dim3(NWAVES * 64), LDS_BYTES, stream, a); } }
}
```
